# Optimizing an MI355X kernel written in HIP

```python
import math
import jax, jax.numpy as jnp
from jax import lax
import numpy as np

D_MODEL = 1024
BATCH = 8
SEQ = 2048
DEPTH = 1
DEC_BATCH = 128
DEC_SEQ = 1
PAST_LEN = 16384
PAGE_SIZE = 128

RMS_EPS = 1e-6
SC_DIM = D_MODEL
SC_WIDTH = 3
SSM_D_INNER = 2 * D_MODEL
SSM_HEAD_DIM = 64
SSM_HEADS = SSM_D_INNER // SSM_HEAD_DIM
SSM_STATE = 128
SSM_GROUPS = 4
SSM_CONV = 4
SSM_CHUNK = 128
SSM_CONV_DIM = SSM_D_INNER + 2 * SSM_GROUPS * SSM_STATE
MEM_LEN = 256
ATTN_HEADS = 4
ATTN_HEAD_DIM = D_MODEL // ATTN_HEADS
ATTN_DIM = ATTN_HEADS * ATTN_HEAD_DIM
N_BRANCHES = 3
FFN_HIDDEN = ((8 * D_MODEL // 3 + 255) // 256) * 256
IN_SIZES = (SC_DIM, SC_DIM, SC_DIM, SSM_D_INNER, SSM_CONV_DIM, SSM_HEADS, ATTN_DIM, N_BRANCHES * D_MODEL)
IN_COLS = sum(IN_SIZES)

kernel_name = 'hybrid_gated_conv_ssd_memattn_step'


def rmsnorm(x, w, eps=RMS_EPS):
    xf = x.astype(jnp.float32)
    y = xf * lax.rsqrt(jnp.mean(xf * xf, axis=-1, keepdims=True) + eps)
    return (y * w.astype(jnp.float32)).astype(x.dtype)


def group_rmsnorm(x, w, groups, eps=RMS_EPS):
    xf = x.astype(jnp.float32)
    shp = xf.shape
    xg = xf.reshape(shp[:-1] + (groups, shp[-1] // groups))
    xg = xg * lax.rsqrt(jnp.mean(xg * xg, axis=-1, keepdims=True) + eps)
    return (xg.reshape(shp) * w.astype(jnp.float32)).astype(x.dtype)


def causal_depthwise_conv(u, hist, w):
    width = w.shape[0]
    seq = u.shape[1]
    full = jnp.concatenate([hist.astype(u.dtype), u], axis=1)
    out = full[:, 0:seq] * w[0]
    for k in range(1, width):
        out = out + full[:, k:k + seq] * w[k]
    return out, full[:, seq:]


def ssd_chunked(xs, dt, a, bm, cm, s0):
    bsz, seq, nh, hd = xs.shape
    ng, ns = bm.shape[2], bm.shape[3]
    hpg = nh // ng
    q = SSM_CHUNK
    nc = seq // q
    f32 = jnp.float32
    xdt = (xs.astype(f32) * dt[..., None]).reshape(bsz, nc, q, ng, hpg, hd)
    br = bm.astype(f32).reshape(bsz, nc, q, ng, ns)
    cr = cm.astype(f32).reshape(bsz, nc, q, ng, ns)
    acum = jnp.cumsum((dt * a).reshape(bsz, nc, q, ng, hpg), axis=2)
    causal = jnp.tril(jnp.ones((q, q), dtype=bool))[:, :, None, None]
    seg = acum[:, :, :, None] - acum[:, :, None, :]
    lmat = jnp.exp(jnp.where(causal, seg, -jnp.inf))
    cb = jnp.einsum('bcign,bcjgn->bcijg', cr, br)
    y_diag = jnp.einsum('bcijg,bcijgh,bcjghp->bcighp', cb, lmat, xdt)
    decay_states = jnp.exp(acum[:, :, -1:] - acum)
    chunk_states = jnp.einsum('bcjgn,bcjgh,bcjghp->bcghpn', br, decay_states, xdt)
    chunk_decay = jnp.exp(acum[:, :, -1])

    def carry_step(s, inp):
        st, dec = inp
        return s * dec[..., None, None] + st, s

    s_init = s0.astype(f32).reshape(bsz, ng, hpg, hd, ns)
    s_final, s_prev = lax.scan(carry_step, s_init,
                               (jnp.moveaxis(chunk_states, 1, 0), jnp.moveaxis(chunk_decay, 1, 0)))
    s_prev = jnp.moveaxis(s_prev, 0, 1)
    y_off = jnp.einsum('bcign,bcghpn,bcigh->bcighp', cr, s_prev, jnp.exp(acum))
    y = (y_diag + y_off).reshape(bsz, seq, nh, hd)
    return y.astype(xs.dtype), s_final.reshape(bsz, nh, hd, ns).astype(s0.dtype)


def ssd_recurrent(xs, dt, a, bm, cm, s0):
    hpg = xs.shape[2] // bm.shape[2]
    f32 = jnp.float32

    def step(s, inp):
        xt, dtt, bt, ct = inp
        bh = jnp.repeat(bt, hpg, axis=1)
        ch = jnp.repeat(ct, hpg, axis=1)
        s = s * jnp.exp(dtt * a)[..., None, None] + (dtt[..., None] * xt)[..., None] * bh[:, :, None, :]
        return s, jnp.einsum('bhpn,bhn->bhp', s, ch)

    seqs = (jnp.moveaxis(xs.astype(f32), 1, 0), jnp.moveaxis(dt.astype(f32), 1, 0),
            jnp.moveaxis(bm.astype(f32), 1, 0), jnp.moveaxis(cm.astype(f32), 1, 0))
    s_final, ys = lax.scan(step, s0.astype(f32), seqs)
    return jnp.moveaxis(ys, 0, 1).astype(xs.dtype), s_final.astype(s0.dtype)


def mixer_block(xn, mem_k, mem_v, sc_hist, ssm_hist, ssm_s0, ssd_fn,
                w_in, sc_conv_w, w_sc_out, ssm_conv_w, ssm_conv_b, ssm_dt_bias, ssm_a_log, ssm_d,
                ssm_norm_w, w_ssm_out, w_attn_o, w_merge_o):
    bsz, seq, _ = xn.shape
    splits = [int(v) for v in np.cumsum(IN_SIZES)[:-1]]
    sc_b, sc_c, sc_x, z, xbc, dt_raw, q, gates = jnp.split(xn @ w_in, splits, axis=-1)
    conv_u, sc_new = causal_depthwise_conv(sc_c * sc_x, sc_hist, sc_conv_w)
    y_a = (sc_b * conv_u) @ w_sc_out
    xbc_c, ssm_conv_new = causal_depthwise_conv(xbc, ssm_hist, ssm_conv_w)
    xbc_c = jax.nn.silu(xbc_c + ssm_conv_b)
    xs, bm, cm = jnp.split(xbc_c, [SSM_D_INNER, SSM_D_INNER + SSM_GROUPS * SSM_STATE], axis=-1)
    xs = xs.reshape(bsz, seq, SSM_HEADS, SSM_HEAD_DIM)
    bm = bm.reshape(bsz, seq, SSM_GROUPS, SSM_STATE)
    cm = cm.reshape(bsz, seq, SSM_GROUPS, SSM_STATE)
    dt = jax.nn.softplus(dt_raw.astype(jnp.float32) + ssm_dt_bias.astype(jnp.float32))
    a = -jnp.exp(ssm_a_log.astype(jnp.float32))
    y_ssd, ssm_new = ssd_fn(xs, dt, a, bm, cm, ssm_s0)
    y_ssd = (y_ssd + ssm_d[:, None] * xs).reshape(bsz, seq, SSM_D_INNER) * jax.nn.silu(z)
    y_b = group_rmsnorm(y_ssd, ssm_norm_w, SSM_GROUPS) @ w_ssm_out
    qh = q.reshape(bsz, seq, ATTN_HEADS, ATTN_HEAD_DIM)
    scores = jnp.einsum('blhd,bmhd->bhlm', qh, mem_k).astype(jnp.float32) * (ATTN_HEAD_DIM ** -0.5)
    probs = jax.nn.softmax(scores, axis=-1).astype(mem_v.dtype)
    y_c = jnp.einsum('bhlm,bmhd->blhd', probs, mem_v).reshape(bsz, seq, ATTN_DIM) @ w_attn_o
    g_a, g_b, g_c = jnp.split(jax.nn.sigmoid(gates), N_BRANCHES, axis=-1)
    merged = g_a * y_a + g_b * y_b + g_c * y_c
    return merged @ w_merge_o, (sc_new, ssm_conv_new, ssm_new)


def swiglu(xn, w_gate, w_up, w_down):
    return (jax.nn.silu(xn @ w_gate) * (xn @ w_up)) @ w_down


def setup_inputs(seed: int = 0) -> dict:
    key = jax.random.key(seed)
    ks = jax.random.split(key, 32)
    f32 = jnp.float32

    def nrm(k, shape, scale):
        return jax.random.normal(k, shape, f32) * scale

    dt0 = jnp.exp(jax.random.uniform(ks[13], (DEPTH, SSM_HEADS), f32) * (math.log(0.1) - math.log(0.001)) + math.log(0.001))
    return {
        'x_prompt': nrm(ks[0], (BATCH, SEQ, D_MODEL), 1.0),
        'x_sample': nrm(ks[1], (DEC_BATCH, DEC_SEQ, D_MODEL), 1.0),
        'mem_prompt': nrm(ks[2], (BATCH, MEM_LEN, D_MODEL), 1.0),
        'cache_mem_k': nrm(ks[3], (DEPTH, DEC_BATCH, MEM_LEN, ATTN_HEADS, ATTN_HEAD_DIM), 1.0),
        'cache_mem_v': nrm(ks[4], (DEPTH, DEC_BATCH, MEM_LEN, ATTN_HEADS, ATTN_HEAD_DIM), 1.0),
        'state_conv': nrm(ks[5], (DEPTH, DEC_BATCH, SC_WIDTH - 1, SC_DIM), 1.0),
        'state_ssm_conv': nrm(ks[6], (DEPTH, DEC_BATCH, SSM_CONV - 1, SSM_CONV_DIM), 1.0),
        'state_ssm': nrm(ks[7], (DEPTH, DEC_BATCH, SSM_HEADS, SSM_HEAD_DIM, SSM_STATE), 0.2),
        'norm_mix_w': 1.0 + nrm(ks[8], (DEPTH, D_MODEL), 0.02),
        'w_in': nrm(ks[9], (DEPTH, D_MODEL, IN_COLS), D_MODEL ** -0.5),
        'sc_conv_w': nrm(ks[10], (DEPTH, SC_WIDTH, SC_DIM), SC_WIDTH ** -0.5),
        'w_sc_out': nrm(ks[11], (DEPTH, SC_DIM, D_MODEL), SC_DIM ** -0.5),
        'ssm_conv_w': nrm(ks[12], (DEPTH, SSM_CONV, SSM_CONV_DIM), SSM_CONV ** -0.5),
        'ssm_conv_b': nrm(ks[14], (DEPTH, SSM_CONV_DIM), 0.02),
        'ssm_dt_bias': dt0 + jnp.log(-jnp.expm1(-dt0)),
        'ssm_a_log': jnp.log(jax.random.uniform(ks[15], (DEPTH, SSM_HEADS), f32, 1.0, 16.0)),
        'ssm_d': 1.0 + nrm(ks[16], (DEPTH, SSM_HEADS), 0.1),
        'ssm_norm_w': 1.0 + nrm(ks[17], (DEPTH, SSM_D_INNER), 0.02),
        'w_ssm_out': nrm(ks[18], (DEPTH, SSM_D_INNER, D_MODEL), SSM_D_INNER ** -0.5),
        'norm_mem_w': 1.0 + nrm(ks[19], (DEPTH, D_MODEL), 0.02),
        'w_mem_k': nrm(ks[20], (DEPTH, D_MODEL, ATTN_DIM), D_MODEL ** -0.5),
        'w_mem_v': nrm(ks[21], (DEPTH, D_MODEL, ATTN_DIM), D_MODEL ** -0.5),
        'w_attn_o': nrm(ks[22], (DEPTH, ATTN_DIM, D_MODEL), ATTN_DIM ** -0.5),
        'w_merge_o': nrm(ks[23], (DEPTH, D_MODEL, D_MODEL), D_MODEL ** -0.5),
        'norm_ffn_w': 1.0 + nrm(ks[24], (DEPTH, D_MODEL), 0.02),
        'w_ffn_gate': nrm(ks[25], (DEPTH, D_MODEL, FFN_HIDDEN), D_MODEL ** -0.5),
        'w_ffn_up': nrm(ks[26], (DEPTH, D_MODEL, FFN_HIDDEN), D_MODEL ** -0.5),
        'w_ffn_down': nrm(ks[27], (DEPTH, FFN_HIDDEN, D_MODEL), FFN_HIDDEN ** -0.5),
        'norm_final_w': 1.0 + nrm(ks[28], (D_MODEL,), 0.02),
    }


def reference(x_prompt, x_sample, mem_prompt, cache_mem_k, cache_mem_v, state_conv, state_ssm_conv, state_ssm,
              norm_mix_w, w_in, sc_conv_w, w_sc_out, ssm_conv_w, ssm_conv_b, ssm_dt_bias, ssm_a_log, ssm_d,
              ssm_norm_w, w_ssm_out, norm_mem_w, w_mem_k, w_mem_v, w_attn_o, w_merge_o,
              norm_ffn_w, w_ffn_gate, w_ffn_up, w_ffn_down, norm_final_w):
    xp = x_prompt
    xs = x_sample
    bp = xp.shape[0]
    p_mk, p_mv, p_conv, p_ssmc, p_ssm = [], [], [], [], []
    s_conv, s_ssmc, s_ssm = [], [], []
    for l in range(DEPTH):
        layer_w = (w_in[l], sc_conv_w[l], w_sc_out[l], ssm_conv_w[l], ssm_conv_b[l], ssm_dt_bias[l], ssm_a_log[l],
                   ssm_d[l], ssm_norm_w[l], w_ssm_out[l], w_attn_o[l], w_merge_o[l])
        mem_n = rmsnorm(mem_prompt, norm_mem_w[l])
        mk = (mem_n @ w_mem_k[l]).reshape(bp, MEM_LEN, ATTN_HEADS, ATTN_HEAD_DIM)
        mv = (mem_n @ w_mem_v[l]).reshape(bp, MEM_LEN, ATTN_HEADS, ATTN_HEAD_DIM)
        h, (sc_p, ssmc_p, ssm_p) = mixer_block(
            rmsnorm(xp, norm_mix_w[l]), mk, mv,
            jnp.zeros((bp, SC_WIDTH - 1, SC_DIM), xp.dtype),
            jnp.zeros((bp, SSM_CONV - 1, SSM_CONV_DIM), xp.dtype),
            jnp.zeros((bp, SSM_HEADS, SSM_HEAD_DIM, SSM_STATE), xp.dtype),
            ssd_chunked, *layer_w)
        xp = xp + h
        xp = xp + swiglu(rmsnorm(xp, norm_ffn_w[l]), w_ffn_gate[l], w_ffn_up[l], w_ffn_down[l])
        p_mk.append(mk)
        p_mv.append(mv)
        p_conv.append(sc_p)
        p_ssmc.append(ssmc_p)
        p_ssm.append(ssm_p)
        h, (sc_s, ssmc_s, ssm_s) = mixer_block(
            rmsnorm(xs, norm_mix_w[l]), cache_mem_k[l], cache_mem_v[l],
            state_conv[l], state_ssm_conv[l], state_ssm[l],
            ssd_recurrent, *layer_w)
        xs = xs + h
        xs = xs + swiglu(rmsnorm(xs, norm_ffn_w[l]), w_ffn_gate[l], w_ffn_up[l], w_ffn_down[l])
        s_conv.append(sc_s)
        s_ssmc.append(ssmc_s)
        s_ssm.append(ssm_s)
    y_prompt = rmsnorm(xp, norm_final_w)
    y_sample = rmsnorm(xs, norm_final_w)
    return (y_prompt, y_sample, jnp.stack(p_mk), jnp.stack(p_mv), jnp.stack(p_conv), jnp.stack(p_ssmc),
            jnp.stack(p_ssm), jnp.stack(s_conv), jnp.stack(s_ssmc), jnp.stack(s_ssm))
```

```cpp
#ifndef HOST_EMU
#include <hip/hip_runtime.h>
#include <cstdio>
#include <cstdint>
#define DEV __device__ __forceinline__
#define DEVM __device__ __forceinline__
#define LAS __attribute__((address_space(3)))
#define GAS __attribute__((address_space(1)))
#endif

#ifndef CFG_BATCH
#define CFG_BATCH 8
#endif
#ifndef CFG_SEQ
#define CFG_SEQ 2048
#endif
#ifndef CFG_DEC
#define CFG_DEC 128
#endif
constexpr int D = 1024, BATCH = CFG_BATCH, SEQ = CFG_SEQ, DEC = CFG_DEC;
constexpr int MP = BATCH * SEQ;
constexpr int M_ALL = MP + 256;
constexpr int MT_ALL = M_ALL / 256;
constexpr int MEM = 256, HEADS = 4, HD = 256;
constexpr int NCH = SEQ / 128;
constexpr int SSM_H = 32, SSM_P = 64, SSM_N = 128, SSM_G = 4, DIN = 2048, XBCW = 3072;
constexpr int W_IN_COLS = 12320, IN_TILES = 49, NIN = IN_TILES * 256;
constexpr int FF = 2816, NGU = 2 * FF, GU_TILES = NGU / 256;
constexpr float EPS = 1e-6f;
static_assert(SEQ % 256 == 0 && DEC <= 256 && DEC % 4 == 0, "shape");

constexpr size_t O_YP = 0;
constexpr size_t O_YS = O_YP + (size_t)MP * D;
constexpr size_t O_MK = O_YS + (size_t)DEC * D;
constexpr size_t O_MV = O_MK + (size_t)BATCH * MEM * D;
constexpr size_t O_PCONV = O_MV + (size_t)BATCH * MEM * D;
constexpr size_t O_PSSMC = O_PCONV + (size_t)BATCH * 2 * D;
constexpr size_t O_PSSM = O_PSSMC + (size_t)BATCH * 3 * XBCW;
constexpr size_t O_SCONV = O_PSSM + (size_t)BATCH * SSM_H * SSM_P * SSM_N;
constexpr size_t O_SSSMC = O_SCONV + (size_t)DEC * 2 * D;
constexpr size_t O_SSSM = O_SSSMC + (size_t)DEC * 3 * XBCW;
constexpr size_t O_END = O_SSSM + (size_t)DEC * SSM_H * SSM_P * SSM_N;

constexpr size_t al256(size_t x) { return (x + 255) & ~(size_t)255; }
constexpr size_t WS_CTL = 0, CTL_BYTES = 1u << 20;
constexpr size_t WS_WIN = WS_CTL + CTL_BYTES;
constexpr size_t WS_WKV = WS_WIN + (size_t)NIN * 1024 * 2;
constexpr size_t WS_WCAT = WS_WKV + (size_t)2048 * 1024 * 2;
constexpr size_t WS_WMO = WS_WCAT + (size_t)1024 * 4096 * 2;
constexpr size_t WS_WGU = WS_WMO + (size_t)1024 * 1024 * 2;
constexpr size_t WS_WD = WS_WGU + (size_t)NGU * 1024 * 2;
constexpr size_t WS_XN = WS_WD + (size_t)1024 * FF * 2;
constexpr size_t WS_MEMN = WS_XN + (size_t)M_ALL * 1024 * 2;
constexpr size_t WS_KB = WS_MEMN + (size_t)BATCH * MEM * 1024 * 2;
constexpr size_t WS_VT = WS_KB + (size_t)BATCH * MEM * 1024 * 2;
constexpr size_t WS_DT = WS_VT + (size_t)BATCH * MEM * 1024 * 2;
constexpr size_t WS_CDEC = WS_DT + (size_t)M_ALL * 32 * 4;
constexpr size_t WS_DUMP = al256(WS_CDEC + (size_t)BATCH * NCH * 32 * 4);
constexpr size_t WS_ACAT = WS_DUMP + (size_t)256 * 1024 * 4;
constexpr size_t WS_U = WS_ACAT + (size_t)M_ALL * 4096 * 2;
constexpr size_t WS_XBC = WS_U + (size_t)M_ALL * 1024 * 2;
constexpr size_t WS_G = WS_XBC + (size_t)M_ALL * 3072 * 2;
constexpr size_t WS_CHST = WS_G + (size_t)M_ALL * 3072 * 2;
constexpr size_t WS_END = WS_CHST + (size_t)BATCH * NCH * 32 * 64 * 128 * 2;
constexpr size_t WS_MERGED = WS_XN, WS_HID = WS_ACAT, WS_XP2B = WS_U, WS_MSCR = WS_XBC, WS_XP2 = WS_XBC;
static_assert((size_t)M_ALL * FF * 2 <= (size_t)M_ALL * 4096 * 2 && (size_t)M_ALL * 1024 * 4 <= (size_t)M_ALL * 3072 * 2, "overlays");
constexpr int CW_BAR = 4096;
constexpr int CW_SS2 = 16384;
constexpr int CW_SS3 = CW_SS2 + M_ALL;
static_assert((size_t)(CW_SS3 + M_ALL) * 4 <= CTL_BYTES, "ctl");

constexpr int RING_BYTES = 135168;
constexpr int LDSCTL_OFF = 139264, MISC_OFF = LDSCTL_OFF + 320, LDS_BYTES = 147456;

typedef unsigned short bf16_t;
typedef short bf16x8 __attribute__((ext_vector_type(8)));
typedef float f32x4 __attribute__((ext_vector_type(4)));
typedef float f32x2 __attribute__((ext_vector_type(2)));
typedef unsigned u32x4 __attribute__((ext_vector_type(4)));
typedef unsigned u32x2 __attribute__((ext_vector_type(2)));

#ifndef HOST_EMU
DEV f32x4 MFMA16(bf16x8 a, bf16x8 b, f32x4 c) { return __builtin_amdgcn_mfma_f32_16x16x32_bf16(a, b, c, 0, 0, 0); }
#define GLDS16(g, l) __builtin_amdgcn_global_load_lds((const unsigned*)(g), (LAS unsigned*)(l), 16, 0, 0)
#define SBAR() __builtin_amdgcn_s_barrier()
#define WAIT_V(n) asm volatile("s_waitcnt vmcnt(" #n ")" ::: "memory")
#define WAIT_L(n) asm volatile("s_waitcnt lgkmcnt(" #n ")" ::: "memory")
#define SETPRIO(n) __builtin_amdgcn_s_setprio(n)
#define SCHEDB() __builtin_amdgcn_sched_barrier(0)
#define WAVE_LDS_SYNC() asm volatile("s_waitcnt lgkmcnt(0)" ::: "memory")
#define BLOCK_SYNC() __syncthreads()
#define CFENCE() asm volatile("" ::: "memory")
#define OPAQUE_V(x) asm volatile("" : "+v"(x))
#define OPAQUE_S(x) asm volatile("" : "+s"(x))
DEV int RFL(int v) { return __builtin_amdgcn_readfirstlane(v); }
DEV float SHFL_XOR(float v, int m) { return __shfl_xor(v, m); }
DEV float SHFL(float v, int src) { return __shfl(v, src); }
DEV void ATOMIC_ADD_F32(float* p, float v) { atomicAdd(p, v); }
DEV unsigned cvt_pk_bf16(float lo, float hi) { unsigned r; asm volatile("v_cvt_pk_bf16_f32 %0, %1, %2" : "=v"(r) : "v"(lo), "v"(hi)); return r; }
DEV float fast_exp(float x) { return __expf(x); }
DEV float fast_rsqrt(float x) { return rsqrtf(x); }
#endif

DEV unsigned f2bf(float f) { unsigned u = __builtin_bit_cast(unsigned, f); return (u + 0x7fffu + ((u >> 16) & 1u)) >> 16; }
DEV unsigned pk2(float lo, float hi) { return f2bf(lo) | (f2bf(hi) << 16); }
DEV float bflo(unsigned w) { return __builtin_bit_cast(float, w << 16); }
DEV float bfhi(unsigned w) { return __builtin_bit_cast(float, w & 0xffff0000u); }
DEV float bf1(bf16_t b) { return __builtin_bit_cast(float, (unsigned)b << 16); }
DEV float sigmoidf_(float x) { return 1.0f / (1.0f + fast_exp(-x)); }
DEV float siluf_(float x) { return x / (1.0f + fast_exp(-x)); }
DEV float softplusf_(float x) { return x > 20.f ? x : log1pf(expf(x)); }
DEV float wave_sum(float v) {
#pragma unroll
    for (int o = 1; o < 64; o <<= 1) v += SHFL_XOR(v, o);
    return v;
}
DEV u32x4 pack8(const f32x4& a, const f32x4& b) { u32x4 w; w.x = cvt_pk_bf16(a[0], a[1]); w.y = cvt_pk_bf16(a[2], a[3]); w.z = cvt_pk_bf16(b[0], b[1]); w.w = cvt_pk_bf16(b[2], b[3]); return w; }
DEV void unpack8(const u32x4& w, float (&o)[8]) { o[0] = bflo(w.x); o[1] = bfhi(w.x); o[2] = bflo(w.y); o[3] = bfhi(w.y); o[4] = bflo(w.z); o[5] = bfhi(w.z); o[6] = bflo(w.w); o[7] = bfhi(w.w); }

struct Params {
    const float* in[29];
    float* out;
    unsigned char* ws;
    int ph_lo, ph_hi;
};
enum { I_XP = 0, I_XS, I_MEM, I_CK, I_CV, I_SCONV, I_SSMCONV, I_SSM, I_NMIX, I_WIN, I_SCW, I_WSC, I_SSMCW, I_SSMCB, I_DTB, I_ALOG, I_SSMD, I_SSMNW, I_WSSM,
       I_NMEM, I_WMK, I_WMV, I_WAO, I_WMO, I_NFFN, I_WG, I_WU, I_WDN, I_NFIN };

namespace pg8 {
constexpr int BM = 256, BK = 64, HALF = 128, HTB = HALF * BK * 2, STAGE_BYTES = 8 * HTB, NXCD = 8, WGM = 8;
DEV int lds_byte(int r, int c) { const int st = (r >> 4) * 2 + (c >> 5), rr = r & 15, cc = c & 31, ob = rr * 64 + cc * 2; return st * 1024 + (ob ^ (((ob >> 9) & 1) << 5)); }
DEV void stage_rc(int b, int& R, int& C) { const int st = b / 1024, sb = b % 1024, swz = sb ^ (((sb >> 9) & 1) << 5); R = (st >> 1) * 16 + swz / 64; C = (st & 1) * 32 + (swz % 64) / 2; }
DEV int perm32(int rho) { const int n = rho >> 4, i = rho & 15; return 8 * (i >> 2) + 4 * n + (i & 3); }

struct Unit { const char* A; const char* B; int nt, kind, pm, pn; };
DEV void tile_of(int wgid, int nM, int nN, int& pm, int& pn) {
    const int nwg = nM * nN; { const int q = nwg / NXCD, r = nwg % NXCD, xcd = wgid % NXCD, off = wgid / NXCD; wgid = (xcd < r ? xcd * (q + 1) : r * (q + 1) + (xcd - r) * q) + off; }
    const int nig = WGM * nN, gid = wgid / nig, fm = gid * WGM, gsz = (nM - fm) < WGM ? (nM - fm) : WGM;
    pm = fm + ((wgid % nig) % gsz); pn = (wgid % nig) / gsz;
}

template <class Epi, class Sched>
DEV void gemm_phase(LAS unsigned char* lds, const int PITCH, const Sched& S, const Epi& E) {
    const int tid = threadIdx.x, wid = RFL(tid >> 6), lane = tid & 63, wr = wid >> 2, wc = wid & 3, fr = lane & 15, fq = lane >> 4;
    unsigned voffA[2], voffB[2];
#pragma unroll
    for (int i = 0; i < 2; ++i) { int R, C; stage_rc(tid * 16 + i * 8192, R, C); const int Rb = (R & ~31) + perm32(R & 31);
        voffA[i] = (unsigned)(R * PITCH + C) * 2u; voffB[i] = (unsigned)(Rb * PITCH + C) * 2u; }
    const size_t kstep = (size_t)(BK * 2);
    const size_t hstep = (size_t)HALF * PITCH * 2;
    const unsigned ldsw = (unsigned)wid * 1024u;
    const int aoff = lds_byte(wr * 64 + fr, fq * 8), boff = lds_byte(wc * 32 + fr, fq * 8);
#define PG8_SA(b, h) (((b) * 2 + (h)) * HTB)
#define PG8_SB(b, h) ((4 + (b) * 2 + (h)) * HTB)
#define PG8_STAGE(bufoff, gbase, voff) do { _Pragma("unroll") for (int _i = 0; _i < 2; ++_i) \
        GLDS16((const char*)(gbase) + (voff)[_i], lds + (bufoff) + ldsw + _i * 8192); } while (0)
#define PG8_LDA(dst, b, h) do { _Pragma("unroll") for (int m = 0; m < 4; ++m) _Pragma("unroll") for (int k = 0; k < 2; ++k) dst[m][k] = *(const LAS bf16x8*)(lds + PG8_SA(b, h) + aoff + m * 2048 + k * 1024); } while (0)
#define PG8_LDB(dst, b, h) do { _Pragma("unroll") for (int n = 0; n < 2; ++n) _Pragma("unroll") for (int k = 0; k < 2; ++k) dst[n][k] = *(const LAS bf16x8*)(lds + PG8_SB(b, h) + boff + n * 2048 + k * 1024); } while (0)
#define PG8_MMA(ai, bj, At, Bt) do { SETPRIO(1); _Pragma("unroll") for (int m = 0; m < 4; ++m) _Pragma("unroll") for (int n = 0; n < 2; ++n) _Pragma("unroll") for (int k = 0; k < 2; ++k) \
        acc[ai][bj][m][n] = MFMA16(Bt[n][k], At[m][k], acc[ai][bj][m][n]); SETPRIO(0); } while (0)
    Unit cur, nxt; int ui = 0;
    if (!S.next(0, cur)) return;
    f32x4 acc[2][2][4][2];
#pragma unroll
    for (int a = 0; a < 2; ++a)
#pragma unroll
        for (int b = 0; b < 2; ++b)
#pragma unroll
            for (int m = 0; m < 4; ++m)
#pragma unroll
                for (int n = 0; n < 2; ++n) acc[a][b][m][n] = (f32x4){0.f, 0.f, 0.f, 0.f};
    bf16x8 At[4][2], B0[2][2], B1[2][2];
    const char* cA = cur.A; const char* cB = cur.B;
    PG8_STAGE(PG8_SB(0, 0), cB, voffB); PG8_STAGE(PG8_SB(0, 1), cB + hstep, voffB); PG8_STAGE(PG8_SA(0, 0), cA, voffA); PG8_STAGE(PG8_SA(0, 1), cA + hstep, voffA);
    if (wr == 1) SBAR();
    WAIT_V(2); SBAR();
    PG8_STAGE(PG8_SB(1, 0), cB + kstep, voffB); PG8_STAGE(PG8_SA(1, 0), cA + kstep, voffA); PG8_STAGE(PG8_SB(1, 1), cB + hstep + kstep, voffB);
    WAIT_V(6); SBAR();
    for (;;) {
        const bool has_next = S.next(ui + 1, nxt);
        const char* nA = has_next ? nxt.A : cA; const char* nB = has_next ? nxt.B : cB;
        const int nt = cur.nt;
        for (int t = 0; t < nt; t += 2) {
            const bool last = (t == nt - 2);
            const char* a1 = cA + (size_t)(t + 1) * kstep;
            const char* a2 = last ? nA : cA + (size_t)(t + 2) * kstep; const char* b2 = last ? nB : cB + (size_t)(t + 2) * kstep;
            const char* a3 = a2 + kstep; const char* b3 = b2 + kstep;
            PG8_LDB(B0, 0, 0); PG8_LDB(B1, 0, 1); SCHEDB(); PG8_LDA(At, 0, 0); PG8_STAGE(PG8_SA(1, 1), a1 + hstep, voffA);
            WAIT_V(8); WAIT_L(0); SBAR(); PG8_MMA(0, 0, At, B0); PG8_MMA(0, 1, At, B1); SBAR(); SCHEDB();
            PG8_LDA(At, 0, 1); PG8_STAGE(PG8_SB(0, 0), b2, voffB); PG8_STAGE(PG8_SB(0, 1), b2 + hstep, voffB); PG8_STAGE(PG8_SA(0, 0), a2, voffA);
            WAIT_V(8); WAIT_L(0); SBAR(); PG8_MMA(1, 0, At, B0); PG8_MMA(1, 1, At, B1); SBAR(); SCHEDB();
            PG8_LDB(B0, 1, 0); PG8_LDB(B1, 1, 1); SCHEDB(); PG8_LDA(At, 1, 0); PG8_STAGE(PG8_SA(0, 1), a2 + hstep, voffA);
            WAIT_V(8); WAIT_L(0); SBAR(); PG8_MMA(0, 0, At, B0); PG8_MMA(0, 1, At, B1); SBAR(); SCHEDB();
            PG8_LDA(At, 1, 1); PG8_STAGE(PG8_SB(1, 0), b3, voffB); PG8_STAGE(PG8_SB(1, 1), b3 + hstep, voffB); PG8_STAGE(PG8_SA(1, 0), a3, voffA);
            WAIT_V(8); WAIT_L(0); SBAR(); PG8_MMA(1, 0, At, B0); PG8_MMA(1, 1, At, B1); SBAR(); SCHEDB();
        }
        if (wr == 0) SBAR();
        { int fr_ = fr, fq_ = fq; OPAQUE_V(fr_); OPAQUE_V(fq_); E(acc, cur, wr, wc, fr_, fq_); }
        if (!has_next) break;
#pragma unroll
        for (int a = 0; a < 2; ++a)
#pragma unroll
            for (int b = 0; b < 2; ++b)
#pragma unroll
                for (int m = 0; m < 4; ++m)
#pragma unroll
                    for (int n = 0; n < 2; ++n) acc[a][b][m][n] = (f32x4){0.f, 0.f, 0.f, 0.f};
        cur = nxt; cA = nA; cB = nB; ++ui;
        if (wr == 1) SBAR();
    }
    WAIT_V(0);
    SBAR();
#undef PG8_SA
#undef PG8_SB
#undef PG8_STAGE
#undef PG8_LDA
#undef PG8_LDB
#undef PG8_MMA
}
}
using pg8::Unit;

struct Frame {
    LAS unsigned char* lds;
    unsigned char* ws;
    const Params* P;
    float* out;
    int tid, lane, wave, G, bid;
};
#define WSP(T, off) ((T*)(F.ws + (off)))

DEV void transpose_item(const float* W, int src_pitch, int k0, int n0, bf16_t* WT, size_t dst_pitch, int dst_row0, int dst_k, const float* kscale, LAS float* scr, int lane) {
#pragma unroll 8
    for (int i = 0; i < 32; ++i) { const int kk = 2 * i + (lane >> 5); float v = W[(size_t)(k0 + kk) * src_pitch + n0 + (lane & 31)]; if (kscale) v *= kscale[k0 + kk]; scr[kk * 33 + (lane & 31)] = v; }
    WAVE_LDS_SYNC();
    const int c = lane & 7;
#pragma unroll
    for (int j = 0; j < 4; ++j) { const int n = (lane >> 3) + 8 * j; const LAS float* s = scr + (8 * c) * 33 + n;
        u32x4 o; o.x = pk2(s[0 * 33], s[1 * 33]); o.y = pk2(s[2 * 33], s[3 * 33]); o.z = pk2(s[4 * 33], s[5 * 33]); o.w = pk2(s[6 * 33], s[7 * 33]);
        *(u32x4*)(WT + (size_t)(dst_row0 + n) * dst_pitch + dst_k + 8 * c) = o; }
    WAVE_LDS_SYNC();
}
DEV int win_dst_row(int c) {
    if (c < 1024) return c;
    if (c < 2048) { const int j = (c - 1024) >> 7; return 1024 + 256 * j + ((c - 1024) & 127); }
    if (c < 3072) { const int j = (c - 2048) >> 7; return 1024 + 256 * j + 128 + ((c - 2048) & 127); }
    if (c < 8192) return c;
    if (c < 8224) return 12288 + (c - 8192);
    return c - 32;
}
DEV void rms_row_bf16(const float* xrow, const float* w, bf16_t* orow, int lane) {
    const f32x4* xr = (const f32x4*)xrow + lane; const f32x4* wr_ = (const f32x4*)w + lane;
    f32x4 v[4]; float s = 0.f;
#pragma unroll
    for (int j = 0; j < 4; ++j) { v[j] = xr[64 * j]; s += (v[j][0] * v[j][0] + v[j][1] * v[j][1]) + (v[j][2] * v[j][2] + v[j][3] * v[j][3]); }
    const float rs = fast_rsqrt(wave_sum(s) * (1.f / 1024.f) + EPS);
    u32x2* o8 = (u32x2*)orow + lane;
#pragma unroll
    for (int j = 0; j < 4; ++j) { const f32x4 ww = wr_[64 * j]; u32x2 o; o.x = pk2(v[j][0] * rs * ww[0], v[j][1] * rs * ww[1]); o.y = pk2(v[j][2] * rs * ww[2], v[j][3] * rs * ww[3]); o8[64 * j] = o; }
}
DEV void p0_prep(Frame& F) {
    LAS float* scr = (LAS float*)(F.lds + F.wave * 16384);
    const int gw = F.bid * 8 + F.wave, NGW = F.G * 8, lane = F.lane;
    bf16_t* WIN = WSP(bf16_t, WS_WIN); bf16_t* WKV = WSP(bf16_t, WS_WKV); bf16_t* WCAT = WSP(bf16_t, WS_WCAT); bf16_t* WMO = WSP(bf16_t, WS_WMO);
    bf16_t* WGU = WSP(bf16_t, WS_WGU); bf16_t* WD = WSP(bf16_t, WS_WD);
    constexpr int I0 = 16 * (W_IN_COLS / 32), I1 = 16 * 32, I4 = 32 * 32, I7 = 16 * (FF / 32), I9 = (FF / 64) * 32;
    constexpr int NITEMS = I0 + 2 * I1 + I1 + I4 + I1 + I1 + 2 * I7 + I9;
    for (int it = gw; it < NITEMS; it += NGW) {
        int r = it;
        if (r < I0) { const int nb = W_IN_COLS / 32, kb = r / nb, n0 = 32 * (r % nb); transpose_item(F.P->in[I_WIN], W_IN_COLS, 64 * kb, n0, WIN, 1024, win_dst_row(n0), 64 * kb, nullptr, scr, lane); continue; } r -= I0;
        if (r < I1) { const int kb = r / 32, n0 = 32 * (r % 32); transpose_item(F.P->in[I_WMK], 1024, 64 * kb, n0, WKV, 1024, n0, 64 * kb, nullptr, scr, lane); continue; } r -= I1;
        if (r < I1) { const int kb = r / 32, n0 = 32 * (r % 32); transpose_item(F.P->in[I_WMV], 1024, 64 * kb, n0, WKV, 1024, 1024 + n0, 64 * kb, nullptr, scr, lane); continue; } r -= I1;
        if (r < I1) { const int kb = r / 32, n0 = 32 * (r % 32); transpose_item(F.P->in[I_WSC], 1024, 64 * kb, n0, WCAT, 4096, n0, 64 * kb, nullptr, scr, lane); continue; } r -= I1;
        if (r < I4) { const int kb = r / 32, n0 = 32 * (r % 32); transpose_item(F.P->in[I_WSSM], 1024, 64 * kb, n0, WCAT, 4096, n0, 1024 + 64 * kb, nullptr, scr, lane); continue; } r -= I4;
        if (r < I1) { const int kb = r / 32, n0 = 32 * (r % 32); transpose_item(F.P->in[I_WAO], 1024, 64 * kb, n0, WCAT, 4096, n0, 3072 + 64 * kb, nullptr, scr, lane); continue; } r -= I1;
        if (r < I1) { const int kb = r / 32, n0 = 32 * (r % 32); transpose_item(F.P->in[I_WMO], 1024, 64 * kb, n0, WMO, 1024, n0, 64 * kb, nullptr, scr, lane); continue; } r -= I1;
        if (r < I7) { const int nb = FF / 32, kb = r / nb, n0 = 32 * (r % nb); transpose_item(F.P->in[I_WG], FF, 64 * kb, n0, WGU, 1024, 256 * (n0 >> 7) + (n0 & 127), 64 * kb, F.P->in[I_NFFN], scr, lane); continue; } r -= I7;
        if (r < I7) { const int nb = FF / 32, kb = r / nb, n0 = 32 * (r % nb); transpose_item(F.P->in[I_WU], FF, 64 * kb, n0, WGU, 1024, 256 * (n0 >> 7) + 128 + (n0 & 127), 64 * kb, F.P->in[I_NFFN], scr, lane); continue; } r -= I7;
        { const int kb = r / 32, n0 = 32 * (r % 32); transpose_item(F.P->in[I_WDN], 1024, 64 * kb, n0, WD, FF, n0, 64 * kb, nullptr, scr, lane); }
    }
    { u32x4* z = (u32x4*)(WIN + (size_t)12320 * 1024); const int nz = (NIN - 12320) * 1024 / 8;
      for (int i = F.bid * 512 + F.tid; i < nz; i += F.G * 512) z[i] = (u32x4){0u, 0u, 0u, 0u}; }
    bf16_t* XN = WSP(bf16_t, WS_XN); bf16_t* MEMN = WSP(bf16_t, WS_MEMN);
    for (int m = gw; m < M_ALL; m += NGW) {
        if (m < MP) rms_row_bf16(F.P->in[I_XP] + (size_t)m * D, F.P->in[I_NMIX], XN + (size_t)m * D, lane);
        else if (m < MP + DEC) rms_row_bf16(F.P->in[I_XS] + (size_t)(m - MP) * D, F.P->in[I_NMIX], XN + (size_t)m * D, lane);
        else { u32x4* z = (u32x4*)(XN + (size_t)m * D); z[lane] = (u32x4){0u, 0u, 0u, 0u}; z[lane + 64] = (u32x4){0u, 0u, 0u, 0u}; }
    }
    for (int m = gw; m < BATCH * MEM; m += NGW) rms_row_bf16(F.P->in[I_MEM] + (size_t)m * D, F.P->in[I_NMEM], MEMN + (size_t)m * D, lane);
}

struct SchedP1 {
    const char* XN; const char* WIN; const char* MEMN; const char* WKV; int G, c;
    DEVM bool next(int i, Unit& u) const {
        const int n1 = MT_ALL * IN_TILES, n2 = BATCH * 8; const long L = (long)i * G + c;
        if (L >= n1 + n2) return false;
        u.nt = 16;
        if (L < n1) { pg8::tile_of((int)L, MT_ALL, IN_TILES, u.pm, u.pn); u.kind = 0; u.A = XN + (size_t)u.pm * 256 * 1024 * 2; u.B = WIN + (size_t)u.pn * 256 * 1024 * 2; }
        else { pg8::tile_of((int)(L - n1), BATCH, 8, u.pm, u.pn); u.kind = 1; u.A = MEMN + (size_t)u.pm * 256 * 1024 * 2; u.B = WKV + (size_t)u.pn * 256 * 1024 * 2; }
        return true;
    }
};
struct EpiP1 {
    unsigned char* ws; float* out; const float* dtb;
    DEVM void operator()(const f32x4 (&acc)[2][2][4][2], const Unit& u, int wr, int wc, int fr, int fq) const {
        const int cb = wc * 32 + 8 * fq;
        if (u.kind == 1) {
            const int b = u.pm, h = u.pn & 3; const bool isv = u.pn >= 4;
            float* of = out + (isv ? O_MV : O_MK); bf16_t* KB = (bf16_t*)(ws + WS_KB); bf16_t* VT = (bf16_t*)(ws + WS_VT);
#pragma unroll
            for (int ai = 0; ai < 2; ++ai)
#pragma unroll
                for (int m = 0; m < 4; ++m) { const int key = ai * 128 + wr * 64 + m * 16 + fr;
#pragma unroll
                    for (int bj = 0; bj < 2; ++bj) { const int d = bj * 128 + cb; const f32x4 v0 = acc[ai][bj][m][0], v1 = acc[ai][bj][m][1];
                        float* o = of + ((size_t)(b * MEM + key) * HEADS + h) * HD + d; *(f32x4*)o = v0; *(f32x4*)(o + 4) = v1;
                        if (!isv) *(u32x4*)(KB + ((size_t)(b * HEADS + h) * MEM + key) * HD + d) = pack8(v0, v1);
                        else { bf16_t* vt = VT + ((size_t)(b * HEADS + h) * HD + d) * MEM + key;
#pragma unroll
                            for (int e = 0; e < 4; ++e) { vt[(size_t)e * MEM] = (bf16_t)f2bf(v0[e]); vt[(size_t)(e + 4) * MEM] = (bf16_t)f2bf(v1[e]); } } }
                    CFENCE(); }
            return;
        }
        const int pn = u.pn, row0 = u.pm * 256 + wr * 64 + fr;
        if (pn < 4 || (pn >= 12 && pn < 20) || (pn >= 32 && pn < 36)) {
            const int coff = pn < 4 ? pn * 256 : (pn < 20 ? 1024 + (pn - 12) * 256 : 3072 + (pn - 32) * 256);
            bf16_t* O = (bf16_t*)(ws + WS_ACAT);
#pragma unroll
            for (int ai = 0; ai < 2; ++ai)
#pragma unroll
                for (int m = 0; m < 4; ++m) { bf16_t* rp = O + (size_t)(row0 + ai * 128 + m * 16) * 4096 + coff + cb;
#pragma unroll
                    for (int bj = 0; bj < 2; ++bj) *(u32x4*)(rp + bj * 128) = pack8(acc[ai][bj][m][0], acc[ai][bj][m][1]);
                    CFENCE(); }
        } else if (pn < 12) {
            bf16_t* O = (bf16_t*)(ws + WS_U); const int j = pn - 4;
#pragma unroll
            for (int ai = 0; ai < 2; ++ai)
#pragma unroll
                for (int m = 0; m < 4; ++m) *(u32x4*)(O + (size_t)(row0 + ai * 128 + m * 16) * 1024 + 128 * j + cb) = pack8(acc[ai][0][m][0] * acc[ai][1][m][0], acc[ai][0][m][1] * acc[ai][1][m][1]);
        } else if (pn < 32) {
            bf16_t* O = (bf16_t*)(ws + WS_XBC);
#pragma unroll
            for (int ai = 0; ai < 2; ++ai)
#pragma unroll
                for (int m = 0; m < 4; ++m) { bf16_t* rp = O + (size_t)(row0 + ai * 128 + m * 16) * XBCW + (pn - 20) * 256 + cb;
#pragma unroll
                    for (int bj = 0; bj < 2; ++bj) *(u32x4*)(rp + bj * 128) = pack8(acc[ai][bj][m][0], acc[ai][bj][m][1]);
                    CFENCE(); }
        } else if (pn < 48) {
            bf16_t* O = (bf16_t*)(ws + WS_G);
#pragma unroll
            for (int ai = 0; ai < 2; ++ai)
#pragma unroll
                for (int m = 0; m < 4; ++m) { bf16_t* rp = O + (size_t)(row0 + ai * 128 + m * 16) * 3072 + (pn - 36) * 256 + cb;
#pragma unroll
                    for (int bj = 0; bj < 2; ++bj) { f32x4 v0 = acc[ai][bj][m][0], v1 = acc[ai][bj][m][1];
#pragma unroll
                        for (int e = 0; e < 4; ++e) { v0[e] = sigmoidf_(v0[e]); v1[e] = sigmoidf_(v1[e]); }
                        *(u32x4*)(rp + bj * 128) = pack8(v0, v1); }
                    CFENCE(); }
        } else {
            if (wc == 0) { float* O = (float*)(ws + WS_DT); const f32x4 b0 = *(const f32x4*)(dtb + cb), b1 = *(const f32x4*)(dtb + cb + 4);
#pragma unroll
                for (int ai = 0; ai < 2; ++ai)
#pragma unroll
                    for (int m = 0; m < 4; ++m) { f32x4 v0 = acc[ai][0][m][0] + b0, v1 = acc[ai][0][m][1] + b1;
#pragma unroll
                        for (int e = 0; e < 4; ++e) { v0[e] = softplusf_(v0[e]); v1[e] = softplusf_(v1[e]); }
                        float* o = O + (size_t)(row0 + ai * 128 + m * 16) * 32 + cb; *(f32x4*)o = v0; *(f32x4*)(o + 4) = v1; CFENCE(); } }
        }
    }
};
struct SchedP5 {
    const char* ACAT; const char* WCAT; int G, c;
    DEVM bool next(int i, Unit& u) const {
        const int su = i / 3, seg = i - 3 * su; const long L = (long)su * G + c;
        if (L >= MT_ALL * 4) return false;
        pg8::tile_of((int)L, MT_ALL, 4, u.pm, u.pn); u.kind = seg; u.nt = seg == 1 ? 32 : 16;
        const size_t koff = (seg == 0 ? 0 : (seg == 1 ? 1024 : 3072)) * 2;
        u.A = ACAT + (size_t)u.pm * 256 * 4096 * 2 + koff; u.B = WCAT + (size_t)u.pn * 256 * 4096 * 2 + koff; return true;
    }
};
struct EpiP5 {
    unsigned char* ws;
    DEVM void operator()(const f32x4 (&acc)[2][2][4][2], const Unit& u, int wr, int wc, int fr, int fq) const {
        const int row0 = u.pm * 256 + wr * 64 + fr, col0 = u.pn * 256 + wc * 32 + 8 * fq, seg = u.kind;
        const bf16_t* Gt = (const bf16_t*)(ws + WS_G) + seg * 1024; float* SC = (float*)(ws + WS_MSCR); bf16_t* MG = (bf16_t*)(ws + WS_MERGED);
#pragma unroll
        for (int ai = 0; ai < 2; ++ai)
#pragma unroll
            for (int m = 0; m < 4; ++m) { const size_t row = (size_t)(row0 + ai * 128 + m * 16);
#pragma unroll
                for (int bj = 0; bj < 2; ++bj) { const int col = col0 + bj * 128; float g[8]; unpack8(*(const u32x4*)(Gt + row * 3072 + col), g);
                    f32x4 v0 = acc[ai][bj][m][0], v1 = acc[ai][bj][m][1];
#pragma unroll
                    for (int e = 0; e < 4; ++e) { v0[e] *= g[e]; v1[e] *= g[4 + e]; }
                    float* sp = SC + row * 1024 + col;
                    if (seg > 0) { v0 += *(const f32x4*)sp; v1 += *(const f32x4*)(sp + 4); }
                    if (seg < 2) { *(f32x4*)sp = v0; *(f32x4*)(sp + 4) = v1; }
                    else *(u32x4*)(MG + row * 1024 + col) = pack8(v0, v1); } }
    }
};
struct SchedPlain {
    const char* A; const char* B; int nM, nN, nt, G, c; size_t pitchB;
    DEVM bool next(int i, Unit& u) const {
        const long L = (long)i * G + c; if (L >= nM * nN) return false;
        pg8::tile_of((int)L, nM, nN, u.pm, u.pn); u.kind = 0; u.nt = nt; u.A = A + (size_t)u.pm * 256 * pitchB; u.B = B + (size_t)u.pn * 256 * pitchB; return true;
    }
};
struct EpiP6 {
    unsigned char* ws; const float* xp; const float* xs;
    DEVM void operator()(const f32x4 (&acc)[2][2][4][2], const Unit& u, int wr, int wc, int fr, int fq) const {
        const int row0 = u.pm * 256 + wr * 64 + fr, col0 = u.pn * 256 + wc * 32 + 8 * fq;
        float* X2 = (float*)(ws + WS_XP2); bf16_t* X2B = (bf16_t*)(ws + WS_XP2B); float* SS = (float*)ws + CW_SS2;
#pragma unroll
        for (int ai = 0; ai < 2; ++ai)
#pragma unroll
            for (int m = 0; m < 4; ++m) { const int row = row0 + ai * 128 + m * 16; float s = 0.f;
                const float* xr = row < MP ? xp + (size_t)row * D : (row < MP + DEC ? xs + (size_t)(row - MP) * D : nullptr);
#pragma unroll
                for (int bj = 0; bj < 2; ++bj) { const int col = col0 + bj * 128; f32x4 v0 = acc[ai][bj][m][0], v1 = acc[ai][bj][m][1];
                    if (xr) { v0 += *(const f32x4*)(xr + col); v1 += *(const f32x4*)(xr + col + 4); }
                    s += (v0[0] * v0[0] + v0[1] * v0[1]) + (v0[2] * v0[2] + v0[3] * v0[3]) + (v1[0] * v1[0] + v1[1] * v1[1]) + (v1[2] * v1[2] + v1[3] * v1[3]);
                    float* o = X2 + (size_t)row * 1024 + col; *(f32x4*)o = v0; *(f32x4*)(o + 4) = v1;
                    *(u32x4*)(X2B + (size_t)row * 1024 + col) = pack8(v0, v1); }
                s += SHFL_XOR(s, 16); s += SHFL_XOR(s, 32);
                if (fq == 0) ATOMIC_ADD_F32(SS + row, s); }
    }
};
struct EpiP7 {
    unsigned char* ws;
    DEVM void operator()(const f32x4 (&acc)[2][2][4][2], const Unit& u, int wr, int wc, int fr, int fq) const {
        const int row0 = u.pm * 256 + wr * 64 + fr, col0 = u.pn * 128 + wc * 32 + 8 * fq;
        const float* SS2 = (const float*)ws + CW_SS2; bf16_t* H = (bf16_t*)(ws + WS_HID);
#pragma unroll
        for (int ai = 0; ai < 2; ++ai)
#pragma unroll
            for (int m = 0; m < 4; ++m) { const int row = row0 + ai * 128 + m * 16; const float rs = fast_rsqrt(SS2[row] * (1.f / 1024.f) + EPS);
                f32x4 h0, h1;
#pragma unroll
                for (int e = 0; e < 4; ++e) { h0[e] = siluf_(rs * acc[ai][0][m][0][e]) * (rs * acc[ai][1][m][0][e]); h1[e] = siluf_(rs * acc[ai][0][m][1][e]) * (rs * acc[ai][1][m][1][e]); }
                *(u32x4*)(H + (size_t)row * FF + col0) = pack8(h0, h1); }
    }
};
struct EpiP8 {
    unsigned char* ws; float* out;
    DEVM void operator()(const f32x4 (&acc)[2][2][4][2], const Unit& u, int wr, int wc, int fr, int fq) const {
        const int row0 = u.pm * 256 + wr * 64 + fr, col0 = u.pn * 256 + wc * 32 + 8 * fq;
        const float* X2 = (const float*)(ws + WS_XP2); float* SS = (float*)ws + CW_SS3;
#pragma unroll
        for (int ai = 0; ai < 2; ++ai)
#pragma unroll
            for (int m = 0; m < 4; ++m) { const int row = row0 + ai * 128 + m * 16; float s = 0.f;
                float* orow = row < MP + DEC ? out + O_YP + (size_t)row * D : (float*)(ws + WS_DUMP) + (size_t)(row - MP) * D;
#pragma unroll
                for (int bj = 0; bj < 2; ++bj) { const int col = col0 + bj * 128; const float* x = X2 + (size_t)row * 1024 + col;
                    const f32x4 v0 = acc[ai][bj][m][0] + *(const f32x4*)x, v1 = acc[ai][bj][m][1] + *(const f32x4*)(x + 4);
                    s += (v0[0] * v0[0] + v0[1] * v0[1]) + (v0[2] * v0[2] + v0[3] * v0[3]) + (v1[0] * v1[0] + v1[1] * v1[1]) + (v1[2] * v1[2] + v1[3] * v1[3]);
                    *(f32x4*)(orow + col) = v0; *(f32x4*)(orow + col + 4) = v1; }
                s += SHFL_XOR(s, 16); s += SHFL_XOR(s, 32);
                if (fq == 0) ATOMIC_ADD_F32(SS + row, s); }
    }
};

DEV void conv8(const bf16_t* XBC, int rowbase, int t, int col, const float* cw, const float* cbias, float (&o)[8]) {
    const f32x4 b0 = *(const f32x4*)(cbias + col), b1 = *(const f32x4*)(cbias + col + 4);
    float a[8] = {b0[0], b0[1], b0[2], b0[3], b1[0], b1[1], b1[2], b1[3]};
#pragma unroll
    for (int k = 0; k < 4; ++k) { const int tt = t - 3 + k;
        if (tt >= 0) { float x[8]; unpack8(*(const u32x4*)(XBC + (size_t)(rowbase + tt) * XBCW + col), x);
            const f32x4 w0 = *(const f32x4*)(cw + k * XBCW + col), w1 = *(const f32x4*)(cw + k * XBCW + col + 4);
#pragma unroll
            for (int e = 0; e < 4; ++e) { a[e] += w0[e] * x[e]; a[4 + e] += w1[e] * x[4 + e]; } } }
#pragma unroll
    for (int e = 0; e < 8; ++e) o[e] = siluf_(a[e]);
}
DEV void chunk_dt_acum(const float* DT, const float* alog, int row0, int g, int hq, int lane, LAS float* acum, LAS float* dtv) {
    const int h = 8 * g + hq; const float a = -expf(alog[h]);
    const float d0 = DT[(size_t)(row0 + 2 * lane) * 32 + h], d1 = DT[(size_t)(row0 + 2 * lane + 1) * 32 + h];
    const float v0 = d0 * a, v1 = v0 + d1 * a; float s = v1;
#pragma unroll
    for (int d = 1; d < 64; d <<= 1) { const float t = SHFL(s, (lane - d) & 63); if (lane >= d) s += t; }
    const float ex = s - v1;
    acum[(2 * lane) * 8 + hq] = ex + v0; acum[(2 * lane + 1) * 8 + hq] = s;
    dtv[(2 * lane) * 8 + hq] = d0; dtv[(2 * lane + 1) * 8 + hq] = d1;
}

DEV void ssd_states_item(Frame& F, int item) {
    const int g = item & 3, c = (item >> 2) % NCH, b = (item >> 2) / NCH;
    const int tid = F.tid, lane = F.lane, w = F.wave, l15 = lane & 15, lq = lane >> 4;
    LAS float* acum = (LAS float*)F.lds; LAS float* dtv = acum + 1024;
    LAS bf16_t* BT = (LAS bf16_t*)(F.lds + 8192);
    LAS bf16_t* XW = (LAS bf16_t*)(F.lds + 8192 + 34816);
    const bf16_t* XBC = WSP(const bf16_t, WS_XBC); const float* DT = WSP(const float, WS_DT);
    const float* cw = F.P->in[I_SSMCW]; const float* cbias = F.P->in[I_SSMCB];
    const int rowbase = b * SEQ, t0 = c * 128, row0 = rowbase + t0;
    BLOCK_SYNC();
    chunk_dt_acum(DT, F.P->in[I_ALOG], row0, g, w, lane, acum, dtv);
#pragma unroll 1
    for (int it = 0; it < 4; ++it) { const int idx = tid + 512 * it, j = idx >> 4, cg = idx & 15; float o[8];
        conv8(XBC, rowbase, t0 + j, DIN + g * 128 + 8 * cg, cw, cbias, o);
#pragma unroll
        for (int e = 0; e < 8; ++e) BT[(8 * cg + e) * 136 + j] = (bf16_t)f2bf(o[e]); }
    BLOCK_SYNC();
    if (tid < 8) WSP(float, WS_CDEC)[(size_t)(b * NCH + c) * 32 + 8 * g + tid] = expf(acum[127 * 8 + tid]);
    bf16x8 afr[4];
#pragma unroll
    for (int ks = 0; ks < 4; ++ks) afr[ks] = *(const LAS bf16x8*)(BT + (16 * w + l15) * 136 + 32 * ks + 8 * lq);
    bf16_t* CH = WSP(bf16_t, WS_CHST);
#pragma unroll 1
    for (int hb = 0; hb < 2; ++hb) {
        if (hb) BLOCK_SYNC();
#pragma unroll 1
        for (int it = 0; it < 8; ++it) { const int idx = tid + 512 * it, hh = idx >> 10, j = (idx >> 3) & 127, cg = idx & 7, hq = 4 * hb + hh; float o[8];
            conv8(XBC, rowbase, t0 + j, (8 * g + hq) * 64 + 8 * cg, cw, cbias, o);
            const float wgt = expf(acum[127 * 8 + hq] - acum[j * 8 + hq]) * dtv[j * 8 + hq];
#pragma unroll
            for (int e = 0; e < 8; ++e) XW[hh * 8704 + (8 * cg + e) * 136 + j] = (bf16_t)f2bf(wgt * o[e]); }
        BLOCK_SYNC();
#pragma unroll
        for (int hh = 0; hh < 4; ++hh) { const int h = 8 * g + 4 * hb + hh;
#pragma unroll
            for (int pf = 0; pf < 4; ++pf) { f32x4 a4 = (f32x4){0.f, 0.f, 0.f, 0.f};
#pragma unroll
                for (int ks = 0; ks < 4; ++ks) { const bf16x8 bfr = *(const LAS bf16x8*)(XW + hh * 8704 + (16 * pf + l15) * 136 + 32 * ks + 8 * lq); a4 = MFMA16(afr[ks], bfr, a4); }
                u32x2 o; o.x = pk2(a4[0], a4[1]); o.y = pk2(a4[2], a4[3]);
                *(u32x2*)(CH + ((size_t)(b * NCH + c) * 32 + h) * 8192 + (16 * pf + l15) * 128 + 16 * w + 4 * lq) = o; } }
    }
}

DEV void attn_item(Frame& F, int item) {
    const int qt = item % (SEQ / 128), h = (item / (SEQ / 128)) & 3, b = item / (SEQ / 128) / 4;
    const int tid = F.tid, lane = F.lane, w = F.wave, l15 = lane & 15, lq = lane >> 4;
    LAS bf16_t* KL = (LAS bf16_t*)F.lds;
    const bf16_t* KBh = WSP(const bf16_t, WS_KB) + (size_t)(b * HEADS + h) * MEM * HD;
    const bf16_t* VTh = WSP(const bf16_t, WS_VT) + (size_t)(b * HEADS + h) * MEM * HD;
    bf16_t* QO = WSP(bf16_t, WS_ACAT) + (size_t)(b * SEQ + qt * 128 + 16 * w + l15) * 4096 + 3072 + h * HD;
    BLOCK_SYNC();
#pragma unroll 4
    for (int it = 0; it < 16; ++it) { const int idx = tid + 512 * it, row = idx >> 5, ch = idx & 31; *(LAS u32x4*)(KL + row * 264 + 8 * ch) = *(const u32x4*)(KBh + row * 256 + 8 * ch); }
    bf16x8 qf[8];
#pragma unroll
    for (int ks = 0; ks < 8; ++ks) qf[ks] = *(const bf16x8*)(QO + 32 * ks + 8 * lq);
    BLOCK_SYNC();
    f32x4 st[16];
#pragma unroll
    for (int kf = 0; kf < 16; ++kf) { f32x4 a4 = (f32x4){0.f, 0.f, 0.f, 0.f};
#pragma unroll
        for (int ks = 0; ks < 8; ++ks) { const bf16x8 afr = *(const LAS bf16x8*)(KL + (16 * kf + l15) * 264 + 32 * ks + 8 * lq); a4 = MFMA16(afr, qf[ks], a4); }
        st[kf] = a4; }
    float mx = -3.0e38f;
#pragma unroll
    for (int kf = 0; kf < 16; ++kf) mx = fmaxf(fmaxf(fmaxf(st[kf][0], st[kf][1]), fmaxf(st[kf][2], st[kf][3])), mx);
    mx = fmaxf(mx, SHFL_XOR(mx, 16)); mx = fmaxf(mx, SHFL_XOR(mx, 32));
    float sum = 0.f;
#pragma unroll
    for (int kf = 0; kf < 16; ++kf)
#pragma unroll
        for (int r = 0; r < 4; ++r) { const float p = fast_exp((st[kf][r] - mx) * 0.0625f); st[kf][r] = p; sum += p; }
    sum += SHFL_XOR(sum, 16); sum += SHFL_XOR(sum, 32);
    const float inv = 1.0f / sum;
    u32x2 pk[16];
#pragma unroll
    for (int kf = 0; kf < 16; ++kf) { pk[kf].x = pk2(st[kf][0] * inv, st[kf][1] * inv); pk[kf].y = pk2(st[kf][2] * inv, st[kf][3] * inv); }
    BLOCK_SYNC();
#pragma unroll 4
    for (int it = 0; it < 16; ++it) { const int idx = tid + 512 * it, row = idx >> 5, ch = idx & 31; *(LAS u32x4*)(KL + row * 264 + 8 * ch) = *(const u32x4*)(VTh + row * 256 + 8 * ch); }
    BLOCK_SYNC();
#pragma unroll
    for (int df = 0; df < 16; ++df) { f32x4 a4 = (f32x4){0.f, 0.f, 0.f, 0.f};
#pragma unroll
        for (int s = 0; s < 8; ++s) { const LAS bf16_t* vp = KL + (16 * df + l15) * 264 + 32 * s + 4 * lq;
            const u32x2 lo = *(const LAS u32x2*)vp, hi = *(const LAS u32x2*)(vp + 16);
            u32x4 av; av.x = lo.x; av.y = lo.y; av.z = hi.x; av.w = hi.y;
            u32x4 bv; bv.x = pk[2 * s].x; bv.y = pk[2 * s].y; bv.z = pk[2 * s + 1].x; bv.w = pk[2 * s + 1].y;
            a4 = MFMA16(__builtin_bit_cast(bf16x8, av), __builtin_bit_cast(bf16x8, bv), a4); }
        u32x2 o; o.x = pk2(a4[0], a4[1]); o.y = pk2(a4[2], a4[3]);
        *(u32x2*)(QO + 16 * df + 4 * lq) = o; }
}

DEV void yain_item(Frame& F, int item) {
    const int row = item * 4 + (F.tid >> 7), col = 8 * (F.tid & 127), t = row % SEQ;
    const bf16_t* U = WSP(const bf16_t, WS_U); bf16_t* A = WSP(bf16_t, WS_ACAT) + (size_t)row * 4096 + col; const float* w = F.P->in[I_SCW];
    float u2[8], u1[8], u0[8], sb[8], y[8];
    unpack8(*(const u32x4*)(U + (size_t)row * 1024 + col), u2);
    if (t >= 1) unpack8(*(const u32x4*)(U + (size_t)(row - 1) * 1024 + col), u1); else {
#pragma unroll
        for (int e = 0; e < 8; ++e) u1[e] = 0.f; }
    if (t >= 2) unpack8(*(const u32x4*)(U + (size_t)(row - 2) * 1024 + col), u0); else {
#pragma unroll
        for (int e = 0; e < 8; ++e) u0[e] = 0.f; }
    unpack8(*(const u32x4*)A, sb);
#pragma unroll
    for (int e = 0; e < 8; ++e) y[e] = sb[e] * (w[col + e] * u0[e] + w[1024 + col + e] * u1[e] + w[2048 + col + e] * u2[e]);
    u32x4 o; o.x = pk2(y[0], y[1]); o.y = pk2(y[2], y[3]); o.z = pk2(y[4], y[5]); o.w = pk2(y[6], y[7]);
    *(u32x4*)A = o;
}
DEV void pstate_item(Frame& F, int b) {
    const bf16_t* U = WSP(const bf16_t, WS_U); const bf16_t* XBC = WSP(const bf16_t, WS_XBC);
    for (int i = F.tid; i < 2 * 1024; i += 512) { const int k = i >> 10, cc = i & 1023; F.out[O_PCONV + (size_t)(b * 2 + k) * 1024 + cc] = bf1(U[(size_t)(b * SEQ + SEQ - 2 + k) * 1024 + cc]); }
    for (int i = F.tid; i < 3 * XBCW; i += 512) { const int k = i / XBCW, cc = i - k * XBCW; F.out[O_PSSMC + (size_t)(b * 3 + k) * XBCW + cc] = bf1(XBC[(size_t)(b * SEQ + SEQ - 3 + k) * XBCW + cc]); }
}
DEV void s_sconv_item(Frame& F, int item) {
    const int s = item * 4 + (F.tid >> 7), col = 8 * (F.tid & 127), row = MP + s;
    const bf16_t* U = WSP(const bf16_t, WS_U); bf16_t* A = WSP(bf16_t, WS_ACAT) + (size_t)row * 4096 + col; const float* w = F.P->in[I_SCW];
    const float* h0 = F.P->in[I_SCONV] + (size_t)(s * 2) * 1024 + col; const float* h1 = h0 + 1024;
    float un[8], sb[8], y[8];
    unpack8(*(const u32x4*)(U + (size_t)row * 1024 + col), un); unpack8(*(const u32x4*)A, sb);
    float* oc = F.out + O_SCONV + (size_t)(s * 2) * 1024 + col;
#pragma unroll
    for (int e = 0; e < 8; ++e) { y[e] = sb[e] * (w[col + e] * h0[e] + w[1024 + col + e] * h1[e] + w[2048 + col + e] * un[e]); oc[e] = h1[e]; oc[1024 + e] = un[e]; }
    u32x4 o; o.x = pk2(y[0], y[1]); o.y = pk2(y[2], y[3]); o.z = pk2(y[4], y[5]); o.w = pk2(y[6], y[7]);
    *(u32x4*)A = o;
}
DEV void s_ssmconv_state_item(Frame& F, int s) {
    const bf16_t* XBC = WSP(const bf16_t, WS_XBC) + (size_t)(MP + s) * XBCW; const float* hist = F.P->in[I_SSMCONV] + (size_t)s * 3 * XBCW; float* o = F.out + O_SSSMC + (size_t)s * 3 * XBCW;
    for (int i = F.tid; i < XBCW; i += 512) { o[i] = hist[XBCW + i]; o[XBCW + i] = hist[2 * XBCW + i]; o[2 * XBCW + i] = bf1(XBC[i]); }
}
DEV void s_ssd_item(Frame& F, int item) {
    const int g = item & 3, s = item >> 2, tid = F.tid, row = MP + s;
    LAS float* xc = (LAS float*)F.lds;
    LAS float* yb = xc + 768;
    LAS float* red = yb + 512;
    const bf16_t* XBC = WSP(const bf16_t, WS_XBC) + (size_t)row * XBCW; const float* hist = F.P->in[I_SSMCONV] + (size_t)s * 3 * XBCW;
    const float* cw = F.P->in[I_SSMCW]; const float* cbias = F.P->in[I_SSMCB];
    BLOCK_SYNC();
    for (int i = tid; i < 768; i += 512) { const int col = i < 512 ? g * 512 + i : (i < 640 ? DIN + g * 128 + (i - 512) : DIN + 512 + g * 128 + (i - 640));
        const float v = cbias[col] + cw[col] * hist[col] + cw[XBCW + col] * hist[XBCW + col] + cw[2 * XBCW + col] * hist[2 * XBCW + col] + cw[3 * XBCW + col] * bf1(XBC[col]);
        xc[i] = siluf_(v); }
    BLOCK_SYNC();
    const int n4 = (tid & 31) * 4; const f32x4 Bv = *(const LAS f32x4*)(xc + 512 + n4), Cv = *(const LAS f32x4*)(xc + 640 + n4);
    const bf16_t* Z = WSP(const bf16_t, WS_ACAT) + (size_t)row * 4096 + 1024;
#pragma unroll 1
    for (int hq = 0; hq < 8; ++hq) { const int h = 8 * g + hq; const float dt = WSP(const float, WS_DT)[(size_t)row * 32 + h];
        const float dA = expf(dt * (-expf(F.P->in[I_ALOG][h]))), Dh = F.P->in[I_SSMD][h];
        const float* s0 = F.P->in[I_SSM] + ((size_t)s * 32 + h) * 8192; float* s1 = F.out + O_SSSM + ((size_t)s * 32 + h) * 8192;
#pragma unroll
        for (int k = 0; k < 4; ++k) { const int p = (tid >> 5) + 16 * k; const float xv = xc[hq * 64 + p], dx = dt * xv;
            const f32x4 so = *(const f32x4*)(s0 + p * 128 + n4); f32x4 sn;
#pragma unroll
            for (int e = 0; e < 4; ++e) sn[e] = so[e] * dA + dx * Bv[e];
            *(f32x4*)(s1 + p * 128 + n4) = sn;
            float y = (sn[0] * Cv[0] + sn[1] * Cv[1]) + (sn[2] * Cv[2] + sn[3] * Cv[3]);
            y += SHFL_XOR(y, 1); y += SHFL_XOR(y, 2); y += SHFL_XOR(y, 4); y += SHFL_XOR(y, 8); y += SHFL_XOR(y, 16);
            if ((tid & 31) == 0) { y += Dh * xv; yb[hq * 64 + p] = y * siluf_(bf1(Z[h * 64 + p])); } } }
    BLOCK_SYNC();
    const float yv = yb[tid]; const float ssw = wave_sum(yv * yv);
    if (F.lane == 0) red[F.wave] = ssw;
    BLOCK_SYNC();
    float tot = 0.f;
#pragma unroll
    for (int i = 0; i < 8; ++i) tot += red[i];
    const float rs = fast_rsqrt(tot * (1.f / 512.f) + EPS);
    WSP(bf16_t, WS_ACAT)[(size_t)row * 4096 + 1024 + g * 512 + tid] = (bf16_t)f2bf(yv * rs * F.P->in[I_SSMNW][g * 512 + tid]);
}
DEV void s_attn_item(Frame& F, int item) {
    const int h = item & 3, s = item >> 2, tid = F.tid, lane = F.lane, w = F.wave, row = MP + s;
    LAS float* sc = (LAS float*)F.lds;
    LAS float* part = sc + 256;
    LAS float* red = part + 512;
    bf16_t* QO = WSP(bf16_t, WS_ACAT) + (size_t)row * 4096 + 3072 + h * HD;
    const float* Kc = F.P->in[I_CK] + ((size_t)s * MEM * HEADS + h) * HD; const float* Vc = F.P->in[I_CV] + ((size_t)s * MEM * HEADS + h) * HD;
    BLOCK_SYNC();
    const u32x2 qw = *(const u32x2*)(QO + 4 * lane); const float q0 = bflo(qw.x), q1 = bfhi(qw.x), q2 = bflo(qw.y), q3 = bfhi(qw.y);
#pragma unroll 4
    for (int i = 0; i < 32; ++i) { const int key = 32 * w + i; const f32x4 kv = *(const f32x4*)(Kc + (size_t)key * (HEADS * HD) + 4 * lane);
        const float d = wave_sum((kv[0] * q0 + kv[1] * q1) + (kv[2] * q2 + kv[3] * q3)); if (lane == 0) sc[key] = d * 0.0625f; }
    BLOCK_SYNC();
    if (w == 0) { const f32x4 v = *(const LAS f32x4*)(sc + 4 * lane); float mx = fmaxf(fmaxf(v[0], v[1]), fmaxf(v[2], v[3]));
#pragma unroll
        for (int o = 1; o < 64; o <<= 1) mx = fmaxf(mx, SHFL_XOR(mx, o));
        f32x4 p; float sm = 0.f;
#pragma unroll
        for (int e = 0; e < 4; ++e) { p[e] = expf(v[e] - mx); sm += p[e]; }
        sm = wave_sum(sm); const float inv = 1.f / sm;
        *(LAS f32x4*)(sc + 4 * lane) = p * inv; }
    BLOCK_SYNC();
    { const int d = tid & 255, k0 = (tid >> 8) * 128; float a = 0.f;
#pragma unroll 8
      for (int k = 0; k < 128; ++k) a += sc[k0 + k] * Vc[(size_t)(k0 + k) * (HEADS * HD) + d];
      part[tid] = a; }
    BLOCK_SYNC();
    if (tid < 256) QO[tid] = (bf16_t)f2bf(part[tid] + part[tid + 256]);
    (void)red;
}

DEV void p3_scan(Frame& F) {
    bf16_t* CH = WSP(bf16_t, WS_CHST); const float* CDEC = WSP(const float, WS_CDEC);
    const int ntask = BATCH * 32 * 64 * 32;
    for (int i = F.bid * 512 + F.tid; i < ntask; i += F.G * 512) {
        const int n4 = (i & 31) * 4, p = (i >> 5) & 63, h = (i >> 11) & 31, b = i >> 16;
        f32x4 S = (f32x4){0.f, 0.f, 0.f, 0.f};
#pragma unroll 1
        for (int c = 0; c < NCH; ++c) { bf16_t* q = CH + ((size_t)(b * NCH + c) * 32 + h) * 8192 + p * 128 + n4; const u32x2 raw = *(const u32x2*)q; const float dec = CDEC[(size_t)(b * NCH + c) * 32 + h];
            u32x2 o; o.x = pk2(S[0], S[1]); o.y = pk2(S[2], S[3]); *(u32x2*)q = o;
            S[0] = S[0] * dec + bflo(raw.x); S[1] = S[1] * dec + bfhi(raw.x); S[2] = S[2] * dec + bflo(raw.y); S[3] = S[3] * dec + bfhi(raw.y); }
        *(f32x4*)(F.out + O_PSSM + ((size_t)(b * 32 + h) * 64 + p) * 128 + n4) = S;
    }
}

DEV void ssd_out_item(Frame& F, int item) {
    const int g = item & 3, c = (item >> 2) % NCH, b = (item >> 2) / NCH;
    const int tid = F.tid, lane = F.lane, w = F.wave, l15 = lane & 15, lq = lane >> 4;
    LAS float* acum = (LAS float*)F.lds; LAS float* dtv = acum + 1024;
    LAS bf16_t* CL = (LAS bf16_t*)(F.lds + 8192);
    LAS bf16_t* BL = (LAS bf16_t*)(F.lds + 8192 + 34816);
    LAS bf16_t* XdT = BL; LAS bf16_t* SL = BL + 8704;
    LAS bf16_t* MW = (LAS bf16_t*)(F.lds + 8192 + 2 * 34816) + w * 2176;
    LAS bf16_t* XN_ = (LAS bf16_t*)(F.lds + 8192 + 3 * 34816);
    const bf16_t* XBC = WSP(const bf16_t, WS_XBC); const float* DT = WSP(const float, WS_DT);
    const float* cw = F.P->in[I_SSMCW]; const float* cbias = F.P->in[I_SSMCB];
    const int rowbase = b * SEQ, t0 = c * 128, row0 = rowbase + t0;
    BLOCK_SYNC();
    chunk_dt_acum(DT, F.P->in[I_ALOG], row0, g, w, lane, acum, dtv);
#pragma unroll 1
    for (int it = 0; it < 8; ++it) { const int idx = tid + 512 * it, isC = idx >> 11, j = (idx >> 4) & 127, cg = idx & 15; float o[8];
        conv8(XBC, rowbase, t0 + j, DIN + isC * 512 + g * 128 + 8 * cg, cw, cbias, o);
        u32x4 pw; pw.x = pk2(o[0], o[1]); pw.y = pk2(o[2], o[3]); pw.z = pk2(o[4], o[5]); pw.w = pk2(o[6], o[7]);
        *(LAS u32x4*)((isC ? CL : BL) + j * 136 + 8 * cg) = pw; }
    BLOCK_SYNC();
    bf16x8 cfr[4];
#pragma unroll
    for (int ks = 0; ks < 4; ++ks) cfr[ks] = *(const LAS bf16x8*)(CL + (16 * w + l15) * 136 + 32 * ks + 8 * lq);
    f32x4 cb[8];
#pragma unroll
    for (int jf = 0; jf < 8; ++jf) { f32x4 a4 = (f32x4){0.f, 0.f, 0.f, 0.f};
#pragma unroll
        for (int ks = 0; ks < 4; ++ks) { const bf16x8 bfr = *(const LAS bf16x8*)(BL + (16 * jf + l15) * 136 + 32 * ks + 8 * lq); a4 = MFMA16(bfr, cfr[ks], a4); }
        cb[jf] = a4; }
    const int il = 16 * w + l15;
    bf16_t* Zrow = WSP(bf16_t, WS_ACAT) + (size_t)(row0 + il) * 4096 + 1024;
    const bf16_t* SP = WSP(const bf16_t, WS_CHST);
    u32x2 ykeep[8][4]; float ss = 0.f;
#pragma unroll
    for (int a = 0; a < 8; ++a)
#pragma unroll
        for (int pf = 0; pf < 4; ++pf) ykeep[a][pf] = (u32x2){0u, 0u};
#pragma unroll 1
    for (int hq = 0; hq < 8; ++hq) { const int h = 8 * g + hq;
        BLOCK_SYNC();
#pragma unroll 1
        for (int it = 0; it < 2; ++it) { const int idx = tid + 512 * it, j = idx >> 3, cg = idx & 7; float o[8];
            conv8(XBC, rowbase, t0 + j, h * 64 + 8 * cg, cw, cbias, o);
            u32x4 pw; pw.x = pk2(o[0], o[1]); pw.y = pk2(o[2], o[3]); pw.z = pk2(o[4], o[5]); pw.w = pk2(o[6], o[7]);
            *(LAS u32x4*)(XN_ + j * 72 + 8 * cg) = pw;
            const float dj = dtv[j * 8 + hq];
#pragma unroll
            for (int e = 0; e < 8; ++e) XdT[(8 * cg + e) * 136 + j] = (bf16_t)f2bf(dj * o[e]); }
#pragma unroll 1
        for (int it = 0; it < 2; ++it) { const int idx = tid + 512 * it, p = idx >> 4, ch = idx & 15;
            *(LAS u32x4*)(SL + p * 136 + 8 * ch) = *(const u32x4*)(SP + ((size_t)(b * NCH + c) * 32 + h) * 8192 + p * 128 + 8 * ch); }
        const float ai_ = acum[il * 8 + hq];
#pragma unroll
        for (int jf = 0; jf < 8; ++jf) { const int j0 = 16 * jf + 4 * lq; float mv[4];
#pragma unroll
            for (int r = 0; r < 4; ++r) { const int j = j0 + r; const float e = fast_exp(fminf(ai_ - acum[j * 8 + hq], 0.f)); mv[r] = j <= il ? cb[jf][r] * e : 0.f; }
            u32x2 o; o.x = pk2(mv[0], mv[1]); o.y = pk2(mv[2], mv[3]); *(LAS u32x2*)(MW + l15 * 136 + j0) = o; }
        BLOCK_SYNC();
        f32x4 yd[4], yo[4];
#pragma unroll
        for (int pf = 0; pf < 4; ++pf) { yd[pf] = (f32x4){0.f, 0.f, 0.f, 0.f}; yo[pf] = (f32x4){0.f, 0.f, 0.f, 0.f}; }
#pragma unroll
        for (int ks = 0; ks < 4; ++ks) { const bf16x8 mfr = *(const LAS bf16x8*)(MW + l15 * 136 + 32 * ks + 8 * lq);
#pragma unroll
            for (int pf = 0; pf < 4; ++pf) { const bf16x8 xfr = *(const LAS bf16x8*)(XdT + (16 * pf + l15) * 136 + 32 * ks + 8 * lq); yd[pf] = MFMA16(xfr, mfr, yd[pf]); } }
#pragma unroll
        for (int ks = 0; ks < 4; ++ks)
#pragma unroll
            for (int pf = 0; pf < 4; ++pf) { const bf16x8 sfr = *(const LAS bf16x8*)(SL + (16 * pf + l15) * 136 + 32 * ks + 8 * lq); yo[pf] = MFMA16(sfr, cfr[ks], yo[pf]); }
        const float ei = expf(ai_), Dh = F.P->in[I_SSMD][h];
#pragma unroll
        for (int pf = 0; pf < 4; ++pf) { const int p0 = 16 * pf + 4 * lq;
            const u32x2 xw = *(const LAS u32x2*)(XN_ + il * 72 + p0); const u32x2 zw = *(const u32x2*)(Zrow + h * 64 + p0);
            const float xv[4] = {bflo(xw.x), bfhi(xw.x), bflo(xw.y), bfhi(xw.y)}, zv[4] = {bflo(zw.x), bfhi(zw.x), bflo(zw.y), bfhi(zw.y)}; float y[4];
#pragma unroll
            for (int r = 0; r < 4; ++r) { y[r] = (yd[pf][r] + ei * yo[pf][r] + Dh * xv[r]) * siluf_(zv[r]); ss += y[r] * y[r]; }
            u32x2 yn; yn.x = pk2(y[0], y[1]); yn.y = pk2(y[2], y[3]);
#pragma unroll
            for (int a = 0; a < 7; ++a) ykeep[a][pf] = ykeep[a + 1][pf];
            ykeep[7][pf] = yn; }
    }
    ss += SHFL_XOR(ss, 16); ss += SHFL_XOR(ss, 32);
    const float rs = fast_rsqrt(ss * (1.f / 512.f) + EPS); const float* nw = F.P->in[I_SSMNW] + g * 512;
#pragma unroll
    for (int hq = 0; hq < 8; ++hq)
#pragma unroll
        for (int pf = 0; pf < 4; ++pf) { const int cidx = hq * 64 + 16 * pf + 4 * lq; const f32x4 wv = *(const f32x4*)(nw + cidx); const u32x2 k = ykeep[hq][pf];
            u32x2 o; o.x = pk2(bflo(k.x) * rs * wv[0], bfhi(k.x) * rs * wv[1]); o.y = pk2(bflo(k.y) * rs * wv[2], bfhi(k.y) * rs * wv[3]);
            *(u32x2*)(Zrow + g * 512 + cidx) = o; }
}

DEV void p9_final(Frame& F) {
    const int gw = F.bid * 8 + F.wave, NGW = F.G * 8, lane = F.lane; const float* SS3 = (const float*)F.ws + CW_SS3; const f32x4* wv = (const f32x4*)F.P->in[I_NFIN] + lane;
    for (int m = gw; m < MP + DEC; m += NGW) { const float rs = fast_rsqrt(SS3[m] * (1.f / 1024.f) + EPS); f32x4* x = (f32x4*)(F.out + O_YP + (size_t)m * D) + lane;
#pragma unroll
        for (int j = 0; j < 4; ++j) { const f32x4 ww = wv[64 * j]; f32x4 v = x[64 * j]; v = v * rs; v = v * ww; x[64 * j] = v; } }
}

constexpr int N_PHASES = 10;
#ifndef PH_MASK
#define PH_MASK 0x3ff
#endif
#define PH_ON(k) ((PH_MASK >> (k)) & 1)
DEV void run_phase(const Frame& F0, int ph) {
    if (!((PH_MASK >> ph) & 1)) return;
    Frame F = F0;
    OPAQUE_V(F.tid); OPAQUE_S(F.bid); OPAQUE_S(F.G);
    F.lane = F.tid & 63; F.wave = RFL(F.tid >> 6);
    const int G = F.G, bid = F.bid;
    if (ph == 0) { p0_prep(F); }
    else if (ph == 1) {
        SchedP1 S{(const char*)(F.ws + WS_XN), (const char*)(F.ws + WS_WIN), (const char*)(F.ws + WS_MEMN), (const char*)(F.ws + WS_WKV), G, bid};
        EpiP1 E{F.ws, F.out, F.P->in[I_DTB]};
        pg8::gemm_phase(F.lds, 1024, S, E);
    } else if (ph == 2) {
        constexpr int N_ATT = BATCH * HEADS * (SEQ / 128), N_ST = BATCH * NCH * 4, N_SATT = DEC * 4, N_SSSD = DEC * 4, N_YA = MP / 4, N_SSC = DEC / 4, N_SST = DEC, N_PST = BATCH;
        constexpr int TOT = N_ATT + N_ST + N_SATT + N_SSSD + N_YA + N_SSC + N_SST + N_PST;
        for (int it = bid; it < TOT; it += G) { int r = it;
            if (r < N_ATT) { attn_item(F, r); continue; } r -= N_ATT;
            if (r < N_ST) { ssd_states_item(F, r); continue; } r -= N_ST;
            if (r < N_SATT) { s_attn_item(F, r); continue; } r -= N_SATT;
            if (r < N_SSSD) { s_ssd_item(F, r); continue; } r -= N_SSSD;
            if (r < N_YA) { yain_item(F, r); continue; } r -= N_YA;
            if (r < N_SSC) { s_sconv_item(F, r); continue; } r -= N_SSC;
            if (r < N_SST) { s_ssmconv_state_item(F, r); continue; } r -= N_SST;
            pstate_item(F, r); }
    } else if (ph == 3) { p3_scan(F); }
    else if (ph == 4) { for (int it = bid; it < BATCH * NCH * 4; it += G) ssd_out_item(F, it); }
    else if (ph == 5) {
        SchedP5 S{(const char*)(F.ws + WS_ACAT), (const char*)(F.ws + WS_WCAT), G, bid}; EpiP5 E{F.ws};
        pg8::gemm_phase(F.lds, 4096, S, E);
    } else if (ph == 6) {
        SchedPlain S{(const char*)(F.ws + WS_MERGED), (const char*)(F.ws + WS_WMO), MT_ALL, 4, 16, G, bid, (size_t)1024 * 2}; EpiP6 E{F.ws, F.P->in[I_XP], F.P->in[I_XS]};
        pg8::gemm_phase(F.lds, 1024, S, E);
    } else if (ph == 7) {
        SchedPlain S{(const char*)(F.ws + WS_XP2B), (const char*)(F.ws + WS_WGU), MT_ALL, GU_TILES, 16, G, bid, (size_t)1024 * 2}; EpiP7 E{F.ws};
        pg8::gemm_phase(F.lds, 1024, S, E);
    } else if (ph == 8) {
        SchedPlain S{(const char*)(F.ws + WS_HID), (const char*)(F.ws + WS_WD), MT_ALL, 4, FF / 64, G, bid, (size_t)FF * 2}; EpiP8 E{F.ws, F.out};
        pg8::gemm_phase(F.lds, FF, S, E);
    } else if (ph == 9) { p9_final(F); }
}

#ifndef HOST_EMU
#define XB_TMO      128
#define XB_XCNT(j)  (256  + 64 * (j))
#define XB_XSUB(j)  (1280 + 64 * (j))
#define XB_XGEN(j)  (2304 + 64 * (j))
#define XB_TOP      3328
#define XB_TOPGEN   3392
#define XCD_BAR_WORDS 3456
#define XB_SPIN_CAP (1u << 18)
__device__ __forceinline__ unsigned xb_ld(unsigned* p)              { return __hip_atomic_load(p, __ATOMIC_RELAXED, __HIP_MEMORY_SCOPE_AGENT); }
__device__ __forceinline__ unsigned xb_add(unsigned* p, unsigned v) { return __hip_atomic_fetch_add(p, v, __ATOMIC_RELAXED, __HIP_MEMORY_SCOPE_AGENT); }
__device__ __forceinline__ unsigned xb_xcc_id() { return (unsigned)__builtin_amdgcn_s_getreg((3 << 11) | 20) & 0xFu; }
#define XB_SPIN(cond, bar) do { unsigned _sp = 0; while (cond) { __builtin_amdgcn_s_sleep(1); \
    if ((++_sp & 255u) == 0u) { if (xb_ld(&(bar)[XB_TMO])) break; if (_sp > XB_SPIN_CAP) { atomicAdd(&(bar)[XB_TMO], 1u); break; } } } } while (0)
struct XcdBarrier { unsigned* bar; unsigned x; volatile LAS unsigned* st; };
__device__ __forceinline__ XcdBarrier xcd_barrier_post(unsigned* bar, volatile LAS unsigned* st) {
    XcdBarrier b; b.bar = bar; b.x = xb_xcc_id(); b.st = st;
    if (threadIdx.x == 0) (void)xb_add(&bar[XB_XCNT(b.x)], 1u);
    return b;
}
__device__ __forceinline__ void xcd_barrier_complete(unsigned* bar, unsigned x, unsigned& nloc, unsigned& nx) {
    const unsigned G = gridDim.x * gridDim.y * gridDim.z;
    unsigned sum, cnt, mine, sp = 0u;
    for (;;) {
        sum = 0u; cnt = 0u; mine = 0u;
#pragma unroll
        for (unsigned j = 0; j < 16; ++j) { const unsigned c = xb_ld(&bar[XB_XCNT(j)]); sum += c; cnt += (c > 0u) ? 1u : 0u; mine = (j == x) ? c : mine; }
        if (sum == G) break;
        __builtin_amdgcn_s_sleep(1);
        if ((++sp & 255u) == 0u) { if (xb_ld(&bar[XB_TMO])) break; if (sp > XB_SPIN_CAP) { atomicAdd(&bar[XB_TMO], 1u); break; } }
    }
    nloc = mine > 0u ? mine : 1u; nx = cnt > 0u ? cnt : 1u;
}
__device__ __forceinline__ void xcd_barrier(const XcdBarrier& b) {
    asm volatile("s_waitcnt vmcnt(0)" ::: "memory");
    __syncthreads();
    if (threadIdx.x == 0) {
        unsigned* bar = b.bar;
        __builtin_amdgcn_s_waitcnt(0);
        unsigned nloc = b.st[0], nx = b.st[1];
        if (nloc == 0u) { xcd_barrier_complete(bar, b.x, nloc, nx); b.st[0] = nloc; b.st[1] = nx; }
        const unsigned old = xb_add(&bar[XB_XSUB(b.x)], 1u);
        const unsigned gen = old / nloc;
        if (old + 1u == (gen + 1u) * nloc) {
            __builtin_amdgcn_fence(__ATOMIC_RELEASE, "agent");
            asm volatile("s_waitcnt vmcnt(0)" ::: "memory");
            const unsigned og = xb_add(&bar[XB_TOP], 1u);
            const unsigned tg = og / nx;
            if (og + 1u == (tg + 1u) * nx) xb_add(&bar[XB_TOPGEN], 1u);
            else XB_SPIN(xb_ld(&bar[XB_TOPGEN]) == tg, bar);
            __builtin_amdgcn_fence(__ATOMIC_ACQUIRE, "agent");
            xb_add(&bar[XB_XGEN(b.x)], 1u);
            asm volatile("s_waitcnt vmcnt(0)" ::: "memory");
        } else {
            XB_SPIN(xb_ld(&bar[XB_XGEN(b.x)]) == gen, bar);
            __builtin_amdgcn_fence(__ATOMIC_ACQUIRE, "agent");
            asm volatile("s_waitcnt vmcnt(0)" ::: "memory");
        }
    }
    __syncthreads();
}

__global__ void __launch_bounds__(512, 2) fwd_kernel(Params P) {
    extern __shared__ __attribute__((aligned(16))) unsigned char lds_raw[];
    Frame F;
    F.lds = (LAS unsigned char*)lds_raw; F.ws = P.ws; F.out = P.out; F.P = &P;
    F.tid = threadIdx.x; F.lane = F.tid & 63; F.wave = __builtin_amdgcn_readfirstlane(F.tid >> 6); F.G = gridDim.x; F.bid = blockIdx.x;
    volatile LAS unsigned* MISC = (volatile LAS unsigned*)(F.lds + MISC_OFF);
    for (int u = F.tid; u < (LDS_BYTES - LDSCTL_OFF) / 4; u += 512) ((LAS unsigned*)(F.lds + LDSCTL_OFF))[u] = 0u;
    __syncthreads();
    const bool multi = (P.ph_hi - P.ph_lo) > 1;
    XcdBarrier bar; bar.bar = (unsigned*)(P.ws + WS_CTL) + CW_BAR; bar.x = 0; bar.st = nullptr;
    if (multi) bar = xcd_barrier_post((unsigned*)(P.ws + WS_CTL) + CW_BAR, MISC + 8);
#define RUN_PH(k) if (P.ph_lo <= (k) && (k) < P.ph_hi) { run_phase(F, (k)); if ((k) + 1 < P.ph_hi) xcd_barrier(bar); }
    RUN_PH(0) RUN_PH(1) RUN_PH(2) RUN_PH(3) RUN_PH(4) RUN_PH(5) RUN_PH(6) RUN_PH(7) RUN_PH(8) RUN_PH(9)
#undef RUN_PH
}

#ifndef N_LAUNCH_MODE
#define N_LAUNCH_MODE 0
#endif
extern "C" void kernel_launch(void* const* d_in, const int* in_sizes, int n_in, void* d_out, int out_size, void* d_ws, size_t ws_size, hipStream_t stream) {
    static int grid = 0;
    if (grid == 0) {
        if (n_in != 29 || ws_size < WS_END) { fprintf(stderr, "kernel_launch: unexpected shapes (n_in %d out %d ws %zu need %zu)\n", n_in, out_size, ws_size, (size_t)WS_END); grid = -1; return; }
        int dev = 0, cus = 0;
        if (hipGetDevice(&dev) != hipSuccess || hipDeviceGetAttribute(&cus, hipDeviceAttributeMultiprocessorCount, dev) != hipSuccess) { grid = -1; return; }
        if (hipFuncSetAttribute((const void*)fwd_kernel, hipFuncAttributeMaxDynamicSharedMemorySize, LDS_BYTES) != hipSuccess) { fprintf(stderr, "kernel_launch: hipFuncSetAttribute failed\n"); grid = -1; return; }
        (void)hipGetLastError();
        grid = cus;
    }
    if (grid < 0) return;
    (void)hipMemsetAsync((char*)d_ws + WS_CTL, 0, CTL_BYTES, stream);
    Params P{};
    for (int i = 0; i < 29; ++i) P.in[i] = (const float*)d_in[i];
    P.out = (float*)d_out; P.ws = (unsigned char*)d_ws;
#if N_LAUNCH_MODE == 0
    P.ph_lo = 0; P.ph_hi = N_PHASES;
    hipLaunchKernelGGL(fwd_kernel, dim3(grid), dim3(512), LDS_BYTES, stream, P);
#else
    for (int ph = 0; ph < N_PHASES; ++ph) { P.ph_lo = ph; P.ph_hi = ph + 1; hipLaunchKernelGGL(fwd_kernel, dim3(grid), dim3(512), LDS_BYTES, stream, P); }
#endif
}
#endif
```

```cpp
#ifndef HOST_EMU
#include <hip/hip_runtime.h>
#include <cstdio>
#include <cstdint>
#define DEV __device__ __forceinline__
#define DEVM __device__ __forceinline__
#define LAS __attribute__((address_space(3)))
#define GAS __attribute__((address_space(1)))
#endif

#ifndef CFG_BATCH
#define CFG_BATCH 8
#endif
#ifndef CFG_SEQ
#define CFG_SEQ 2048
#endif
#ifndef CFG_DEC
#define CFG_DEC 128
#endif
constexpr int D = 1024, BATCH = CFG_BATCH, SEQ = CFG_SEQ, DEC = CFG_DEC;
constexpr int MP = BATCH * SEQ;
constexpr int M_ALL = MP + 256;
constexpr int MT_ALL = M_ALL / 256, MT_P = MP / 256;
constexpr int MEM = 256, HEADS = 4, HD = 256;
constexpr int NCH = SEQ / 128;
constexpr int SSM_H = 32, SSM_P = 64, SSM_N = 128, SSM_G = 4, DIN = 2048, XBCW = 3072;
constexpr int W_IN_COLS = 12320, IN_TILES = 49, NIN = IN_TILES * 256;
constexpr int FF = 2816, NGU = 2 * FF, GU_TILES = NGU / 256;
constexpr float EPS = 1e-6f;
static_assert(SEQ % 256 == 0 && DEC <= 256 && DEC % 4 == 0, "shape");

constexpr size_t O_YP = 0;
constexpr size_t O_YS = O_YP + (size_t)MP * D;
constexpr size_t O_MK = O_YS + (size_t)DEC * D;
constexpr size_t O_MV = O_MK + (size_t)BATCH * MEM * D;
constexpr size_t O_PCONV = O_MV + (size_t)BATCH * MEM * D;
constexpr size_t O_PSSMC = O_PCONV + (size_t)BATCH * 2 * D;
constexpr size_t O_PSSM = O_PSSMC + (size_t)BATCH * 3 * XBCW;
constexpr size_t O_SCONV = O_PSSM + (size_t)BATCH * SSM_H * SSM_P * SSM_N;
constexpr size_t O_SSSMC = O_SCONV + (size_t)DEC * 2 * D;
constexpr size_t O_SSSM = O_SSSMC + (size_t)DEC * 3 * XBCW;
constexpr size_t O_END = O_SSSM + (size_t)DEC * SSM_H * SSM_P * SSM_N;

constexpr size_t al256(size_t x) { return (x + 255) & ~(size_t)255; }
constexpr size_t WS_CTL = 0, CTL_BYTES = 1u << 20;
constexpr size_t WS_WIN = WS_CTL + CTL_BYTES;
constexpr size_t WS_WKV = WS_WIN + (size_t)NIN * 1024 * 2;
constexpr size_t WS_WCAT = WS_WKV + (size_t)2048 * 1024 * 2;
constexpr size_t WS_WMO = WS_WCAT + (size_t)1024 * 4096 * 2;
constexpr size_t WS_WGU = WS_WMO + (size_t)1024 * 1024 * 2;
constexpr size_t WS_WD = WS_WGU + (size_t)NGU * 1024 * 2;
constexpr size_t WS_XN = WS_WD + (size_t)1024 * FF * 2;
constexpr size_t WS_MEMN = WS_XN + (size_t)M_ALL * 1024 * 2;
constexpr size_t WS_KB = WS_MEMN + (size_t)BATCH * MEM * 1024 * 2;
constexpr size_t WS_VT = WS_KB + (size_t)BATCH * MEM * 1024 * 2;
constexpr size_t WS_DT = WS_VT + (size_t)BATCH * MEM * 1024 * 2;
constexpr size_t WS_CDEC = WS_DT + (size_t)M_ALL * 32 * 4;
constexpr size_t WS_DUMP = al256(WS_CDEC + (size_t)BATCH * NCH * 32 * 4);
constexpr size_t WS_ACAT = WS_DUMP + (size_t)256 * 1024 * 4;
constexpr size_t WS_U = WS_ACAT + (size_t)M_ALL * 4096 * 2;
constexpr size_t WS_XBC = WS_U + (size_t)M_ALL * 1024 * 2;
constexpr size_t WS_G = WS_XBC + (size_t)M_ALL * 3072 * 2;
constexpr size_t WS_CHST = WS_G + (size_t)M_ALL * 3072 * 2;
constexpr size_t WS_END = WS_CHST + (size_t)BATCH * NCH * 32 * 64 * 128 * 2;
constexpr size_t WS_MERGED = WS_XN, WS_HID = WS_ACAT, WS_XP2B = WS_U, WS_MSCR = WS_XBC, WS_XP2 = WS_XBC;
static_assert((size_t)M_ALL * FF * 2 <= (size_t)M_ALL * 4096 * 2 && (size_t)M_ALL * 1024 * 4 <= (size_t)M_ALL * 3072 * 2, "overlays");
constexpr int CW_BAR = 4096;
constexpr int CW_SS2 = 16384;
constexpr int CW_SS3 = CW_SS2 + M_ALL;
static_assert((size_t)(CW_SS3 + M_ALL) * 4 <= CTL_BYTES, "ctl");

constexpr int RING_BYTES = 135168;
constexpr int LDSCTL_OFF = 139264, MISC_OFF = LDSCTL_OFF + 320, LDS_BYTES = 147456;

typedef unsigned short bf16_t;
typedef short bf16x8 __attribute__((ext_vector_type(8)));
typedef float f32x4 __attribute__((ext_vector_type(4)));
typedef float f32x2 __attribute__((ext_vector_type(2)));
typedef unsigned u32x4 __attribute__((ext_vector_type(4)));
typedef unsigned u32x2 __attribute__((ext_vector_type(2)));

#ifndef HOST_EMU
DEV f32x4 MFMA16(bf16x8 a, bf16x8 b, f32x4 c) { return __builtin_amdgcn_mfma_f32_16x16x32_bf16(a, b, c, 0, 0, 0); }
#define GLDS16(g, l) __builtin_amdgcn_global_load_lds((const unsigned*)(g), (LAS unsigned*)(l), 16, 0, 0)
#define SBAR() __builtin_amdgcn_s_barrier()
#define WAIT_V(n) asm volatile("s_waitcnt vmcnt(" #n ")" ::: "memory")
#define WAIT_L(n) asm volatile("s_waitcnt lgkmcnt(" #n ")" ::: "memory")
#define SETPRIO(n) __builtin_amdgcn_s_setprio(n)
#define SCHEDB() __builtin_amdgcn_sched_barrier(0)
#define WAVE_LDS_SYNC() asm volatile("s_waitcnt lgkmcnt(0)" ::: "memory")
#define BLOCK_SYNC() __syncthreads()
#define CFENCE() asm volatile("" ::: "memory")
#define OPAQUE_V(x) asm volatile("" : "+v"(x))
#define OPAQUE_S(x) asm volatile("" : "+s"(x))
DEV int RFL(int v) { return __builtin_amdgcn_readfirstlane(v); }
DEV float SHFL_XOR(float v, int m) { return __shfl_xor(v, m); }
DEV float SHFL(float v, int src) { return __shfl(v, src); }
DEV void ATOMIC_ADD_F32(float* p, float v) { atomicAdd(p, v); }
DEV unsigned cvt_pk_bf16(float lo, float hi) { unsigned r; asm volatile("v_cvt_pk_bf16_f32 %0, %1, %2" : "=v"(r) : "v"(lo), "v"(hi)); return r; }
DEV float fast_exp(float x) { return __expf(x); }
DEV float fast_rsqrt(float x) { return rsqrtf(x); }
#endif

DEV unsigned f2bf(float f) { unsigned u = __builtin_bit_cast(unsigned, f); return (u + 0x7fffu + ((u >> 16) & 1u)) >> 16; }
DEV unsigned pk2(float lo, float hi) { return f2bf(lo) | (f2bf(hi) << 16); }
DEV float bflo(unsigned w) { return __builtin_bit_cast(float, w << 16); }
DEV float bfhi(unsigned w) { return __builtin_bit_cast(float, w & 0xffff0000u); }
DEV float bf1(bf16_t b) { return __builtin_bit_cast(float, (unsigned)b << 16); }
DEV float sigmoidf_(float x) { return 1.0f / (1.0f + fast_exp(-x)); }
DEV float siluf_(float x) { return x / (1.0f + fast_exp(-x)); }
DEV float softplusf_(float x) { return x > 20.f ? x : log1pf(expf(x)); }
DEV float wave_sum(float v) {
#pragma unroll
    for (int o = 1; o < 64; o <<= 1) v += SHFL_XOR(v, o);
    return v;
}
DEV u32x4 pack8(const f32x4& a, const f32x4& b) { u32x4 w; w.x = cvt_pk_bf16(a[0], a[1]); w.y = cvt_pk_bf16(a[2], a[3]); w.z = cvt_pk_bf16(b[0], b[1]); w.w = cvt_pk_bf16(b[2], b[3]); return w; }
DEV void unpack8(const u32x4& w, float (&o)[8]) { o[0] = bflo(w.x); o[1] = bfhi(w.x); o[2] = bflo(w.y); o[3] = bfhi(w.y); o[4] = bflo(w.z); o[5] = bfhi(w.z); o[6] = bflo(w.w); o[7] = bfhi(w.w); }

struct Params {
    const float* in[29];
    float* out;
    unsigned char* ws;
    int ph_lo, ph_hi, dup_ph, dup_sub;
};
enum { I_XP = 0, I_XS, I_MEM, I_CK, I_CV, I_SCONV, I_SSMCONV, I_SSM, I_NMIX, I_WIN, I_SCW, I_WSC, I_SSMCW, I_SSMCB, I_DTB, I_ALOG, I_SSMD, I_SSMNW, I_WSSM,
       I_NMEM, I_WMK, I_WMV, I_WAO, I_WMO, I_NFFN, I_WG, I_WU, I_WDN, I_NFIN };

namespace pg8 {
constexpr int BM = 256, BK = 64, HALF = 128, HTB = HALF * BK * 2, STAGE_BYTES = 8 * HTB, NXCD = 8, WGM = 8;
DEV int lds_byte(int r, int c) { const int st = (r >> 4) * 2 + (c >> 5), rr = r & 15, cc = c & 31, ob = rr * 64 + cc * 2; return st * 1024 + (ob ^ (((ob >> 9) & 1) << 5)); }
DEV void stage_rc(int b, int& R, int& C) { const int st = b / 1024, sb = b % 1024, swz = sb ^ (((sb >> 9) & 1) << 5); R = (st >> 1) * 16 + swz / 64; C = (st & 1) * 32 + (swz % 64) / 2; }
DEV int perm32(int rho) { const int n = rho >> 4, i = rho & 15; return 8 * (i >> 2) + 4 * n + (i & 3); }

struct Unit { const char* A; const char* B; int nt, kind, pm, pn; };
DEV void tile_of(int wgid, int nM, int nN, int& pm, int& pn) {
    const int nwg = nM * nN; { const int q = nwg / NXCD, r = nwg % NXCD, xcd = wgid % NXCD, off = wgid / NXCD; wgid = (xcd < r ? xcd * (q + 1) : r * (q + 1) + (xcd - r) * q) + off; }
    const int nig = WGM * nN, gid = wgid / nig, fm = gid * WGM, gsz = (nM - fm) < WGM ? (nM - fm) : WGM;
    pm = fm + ((wgid % nig) % gsz); pn = (wgid % nig) / gsz;
}

template <class Epi, class Sched>
DEV void gemm_phase(LAS unsigned char* lds, const int PITCH, const Sched& S, const Epi& E) {
    const int tid = threadIdx.x, wid = RFL(tid >> 6), lane = tid & 63, wr = wid >> 2, wc = wid & 3, fr = lane & 15, fq = lane >> 4;
    unsigned voffA[2], voffB[2];
#pragma unroll
    for (int i = 0; i < 2; ++i) { int R, C; stage_rc(tid * 16 + i * 8192, R, C); const int Rb = (R & ~31) + perm32(R & 31);
        voffA[i] = (unsigned)(R * PITCH + C) * 2u; voffB[i] = (unsigned)(Rb * PITCH + C) * 2u; }
    const size_t kstep = (size_t)(BK * 2);
    const size_t hstep = (size_t)HALF * PITCH * 2;
    const unsigned ldsw = (unsigned)wid * 1024u;
    const int aoff = lds_byte(wr * 64 + fr, fq * 8), boff = lds_byte(wc * 32 + fr, fq * 8);
#define PG8_SA(b, h) (((b) * 2 + (h)) * HTB)
#define PG8_SB(b, h) ((4 + (b) * 2 + (h)) * HTB)
#define PG8_STAGE(bufoff, gbase, voff) do { _Pragma("unroll") for (int _i = 0; _i < 2; ++_i) \
        GLDS16((const char*)(gbase) + (voff)[_i], lds + (bufoff) + ldsw + _i * 8192); } while (0)
#define PG8_LDA(dst, b, h) do { _Pragma("unroll") for (int m = 0; m < 4; ++m) _Pragma("unroll") for (int k = 0; k < 2; ++k) dst[m][k] = *(const LAS bf16x8*)(lds + PG8_SA(b, h) + aoff + m * 2048 + k * 1024); } while (0)
#define PG8_LDB(dst, b, h) do { _Pragma("unroll") for (int n = 0; n < 2; ++n) _Pragma("unroll") for (int k = 0; k < 2; ++k) dst[n][k] = *(const LAS bf16x8*)(lds + PG8_SB(b, h) + boff + n * 2048 + k * 1024); } while (0)
#define PG8_MMA(ai, bj, At, Bt) do { SETPRIO(1); _Pragma("unroll") for (int m = 0; m < 4; ++m) _Pragma("unroll") for (int n = 0; n < 2; ++n) _Pragma("unroll") for (int k = 0; k < 2; ++k) \
        acc[ai][bj][m][n] = MFMA16(Bt[n][k], At[m][k], acc[ai][bj][m][n]); SETPRIO(0); } while (0)
    Unit cur, nxt; int ui = 0;
    if (!S.next(0, cur)) return;
    f32x4 acc[2][2][4][2];
#pragma unroll
    for (int a = 0; a < 2; ++a)
#pragma unroll
        for (int b = 0; b < 2; ++b)
#pragma unroll
            for (int m = 0; m < 4; ++m)
#pragma unroll
                for (int n = 0; n < 2; ++n) acc[a][b][m][n] = (f32x4){0.f, 0.f, 0.f, 0.f};
    bf16x8 At[4][2], B0[2][2], B1[2][2];
    const char* cA = cur.A; const char* cB = cur.B;
    PG8_STAGE(PG8_SB(0, 0), cB, voffB); PG8_STAGE(PG8_SB(0, 1), cB + hstep, voffB); PG8_STAGE(PG8_SA(0, 0), cA, voffA); PG8_STAGE(PG8_SA(0, 1), cA + hstep, voffA);
    if (wr == 1) SBAR();
    WAIT_V(2); SBAR();
    PG8_STAGE(PG8_SB(1, 0), cB + kstep, voffB); PG8_STAGE(PG8_SA(1, 0), cA + kstep, voffA); PG8_STAGE(PG8_SB(1, 1), cB + hstep + kstep, voffB);
    WAIT_V(6); SBAR();
    for (;;) {
        const bool has_next = S.next(ui + 1, nxt);
        const char* nA = has_next ? nxt.A : cA; const char* nB = has_next ? nxt.B : cB;
        const int nt = cur.nt;
        for (int t = 0; t < nt; t += 2) {
            const bool last = (t == nt - 2);
            const char* a1 = cA + (size_t)(t + 1) * kstep;
            const char* a2 = last ? nA : cA + (size_t)(t + 2) * kstep; const char* b2 = last ? nB : cB + (size_t)(t + 2) * kstep;
            const char* a3 = a2 + kstep; const char* b3 = b2 + kstep;
            PG8_LDB(B0, 0, 0); PG8_LDB(B1, 0, 1); SCHEDB(); PG8_LDA(At, 0, 0); PG8_STAGE(PG8_SA(1, 1), a1 + hstep, voffA);
            WAIT_V(8); WAIT_L(0); SBAR(); PG8_MMA(0, 0, At, B0); PG8_MMA(0, 1, At, B1); SBAR(); SCHEDB();
            PG8_LDA(At, 0, 1); PG8_STAGE(PG8_SB(0, 0), b2, voffB); PG8_STAGE(PG8_SB(0, 1), b2 + hstep, voffB); PG8_STAGE(PG8_SA(0, 0), a2, voffA);
            WAIT_V(8); WAIT_L(0); SBAR(); PG8_MMA(1, 0, At, B0); PG8_MMA(1, 1, At, B1); SBAR(); SCHEDB();
            PG8_LDB(B0, 1, 0); PG8_LDB(B1, 1, 1); SCHEDB(); PG8_LDA(At, 1, 0); PG8_STAGE(PG8_SA(0, 1), a2 + hstep, voffA);
            WAIT_V(8); WAIT_L(0); SBAR(); PG8_MMA(0, 0, At, B0); PG8_MMA(0, 1, At, B1); SBAR(); SCHEDB();
            PG8_LDA(At, 1, 1); PG8_STAGE(PG8_SB(1, 0), b3, voffB); PG8_STAGE(PG8_SB(1, 1), b3 + hstep, voffB); PG8_STAGE(PG8_SA(1, 0), a3, voffA);
            WAIT_V(8); WAIT_L(0); SBAR(); PG8_MMA(1, 0, At, B0); PG8_MMA(1, 1, At, B1); SBAR(); SCHEDB();
        }
        if (wr == 0) SBAR();
        { int fr_ = fr, fq_ = fq; OPAQUE_V(fr_); OPAQUE_V(fq_); E(acc, cur, wr, wc, fr_, fq_); }
        if (!has_next) break;
#pragma unroll
        for (int a = 0; a < 2; ++a)
#pragma unroll
            for (int b = 0; b < 2; ++b)
#pragma unroll
                for (int m = 0; m < 4; ++m)
#pragma unroll
                    for (int n = 0; n < 2; ++n) acc[a][b][m][n] = (f32x4){0.f, 0.f, 0.f, 0.f};
        cur = nxt; cA = nA; cB = nB; ++ui;
        if (wr == 1) SBAR();
    }
    WAIT_V(0);
    SBAR();
#undef PG8_SA
#undef PG8_SB
#undef PG8_STAGE
#undef PG8_LDA
#undef PG8_LDB
#undef PG8_MMA
}
}
using pg8::Unit;

struct Frame {
    LAS unsigned char* lds;
    unsigned char* ws;
    const Params* P;
    float* out;
    int tid, lane, wave, G, bid;
    int dry, sub;
};
#define WSP(T, off) ((T*)(F.ws + (off)))

DEV void transpose_item(const float* W, int src_pitch, int k0, int n0, bf16_t* WT, size_t dst_pitch, int dst_row0, int dst_k, const float* kscale, LAS float* scr, int lane) {
#pragma unroll 8
    for (int i = 0; i < 32; ++i) { const int kk = 2 * i + (lane >> 5); float v = W[(size_t)(k0 + kk) * src_pitch + n0 + (lane & 31)]; if (kscale) v *= kscale[k0 + kk]; scr[kk * 33 + (lane & 31)] = v; }
    WAVE_LDS_SYNC();
    const int c = lane & 7;
#pragma unroll
    for (int j = 0; j < 4; ++j) { const int n = (lane >> 3) + 8 * j; const LAS float* s = scr + (8 * c) * 33 + n;
        u32x4 o; o.x = pk2(s[0 * 33], s[1 * 33]); o.y = pk2(s[2 * 33], s[3 * 33]); o.z = pk2(s[4 * 33], s[5 * 33]); o.w = pk2(s[6 * 33], s[7 * 33]);
        *(u32x4*)(WT + (size_t)(dst_row0 + n) * dst_pitch + dst_k + 8 * c) = o; }
    WAVE_LDS_SYNC();
}
DEV int win_dst_row(int c) {
    if (c < 1024) return c;
    if (c < 2048) { const int j = (c - 1024) >> 7; return 1024 + 256 * j + ((c - 1024) & 127); }
    if (c < 3072) { const int j = (c - 2048) >> 7; return 1024 + 256 * j + 128 + ((c - 2048) & 127); }
    if (c < 8192) return c;
    if (c < 8224) return 12288 + (c - 8192);
    return c - 32;
}
DEV void rms_row_bf16(const float* xrow, const float* w, bf16_t* orow, int lane) {
    const f32x4* xr = (const f32x4*)xrow + lane; const f32x4* wr_ = (const f32x4*)w + lane;
    f32x4 v[4]; float s = 0.f;
#pragma unroll
    for (int j = 0; j < 4; ++j) { v[j] = xr[64 * j]; s += (v[j][0] * v[j][0] + v[j][1] * v[j][1]) + (v[j][2] * v[j][2] + v[j][3] * v[j][3]); }
    const float rs = fast_rsqrt(wave_sum(s) * (1.f / 1024.f) + EPS);
    u32x2* o8 = (u32x2*)orow + lane;
#pragma unroll
    for (int j = 0; j < 4; ++j) { const f32x4 ww = wr_[64 * j]; u32x2 o; o.x = pk2(v[j][0] * rs * ww[0], v[j][1] * rs * ww[1]); o.y = pk2(v[j][2] * rs * ww[2], v[j][3] * rs * ww[3]); o8[64 * j] = o; }
}
DEV void p0_prep(Frame& F) {
    LAS float* scr = (LAS float*)(F.lds + F.wave * 16384);
    const int gw = F.bid * 8 + F.wave, NGW = F.G * 8, lane = F.lane;
    bf16_t* WIN = WSP(bf16_t, WS_WIN); bf16_t* WKV = WSP(bf16_t, WS_WKV); bf16_t* WCAT = WSP(bf16_t, WS_WCAT); bf16_t* WMO = WSP(bf16_t, WS_WMO);
    bf16_t* WGU = WSP(bf16_t, WS_WGU); bf16_t* WD = WSP(bf16_t, WS_WD);
    constexpr int I0 = 16 * (W_IN_COLS / 32), I1 = 16 * 32, I4 = 32 * 32, I7 = 16 * (FF / 32), I9 = (FF / 64) * 32;
    constexpr int NITEMS = I0 + 2 * I1 + I1 + I4 + I1 + I1 + 2 * I7 + I9;
    for (int it = gw; it < NITEMS; it += NGW) {
        int r = it;
        if (r < I0) { const int nb = W_IN_COLS / 32, kb = r / nb, n0 = 32 * (r % nb); transpose_item(F.P->in[I_WIN], W_IN_COLS, 64 * kb, n0, WIN, 1024, win_dst_row(n0), 64 * kb, nullptr, scr, lane); continue; } r -= I0;
        if (r < I1) { const int kb = r / 32, n0 = 32 * (r % 32); transpose_item(F.P->in[I_WMK], 1024, 64 * kb, n0, WKV, 1024, n0, 64 * kb, nullptr, scr, lane); continue; } r -= I1;
        if (r < I1) { const int kb = r / 32, n0 = 32 * (r % 32); transpose_item(F.P->in[I_WMV], 1024, 64 * kb, n0, WKV, 1024, 1024 + n0, 64 * kb, nullptr, scr, lane); continue; } r -= I1;
        if (r < I1) { const int kb = r / 32, n0 = 32 * (r % 32); transpose_item(F.P->in[I_WSC], 1024, 64 * kb, n0, WCAT, 4096, n0, 64 * kb, nullptr, scr, lane); continue; } r -= I1;
        if (r < I4) { const int kb = r / 32, n0 = 32 * (r % 32); transpose_item(F.P->in[I_WSSM], 1024, 64 * kb, n0, WCAT, 4096, n0, 1024 + 64 * kb, nullptr, scr, lane); continue; } r -= I4;
        if (r < I1) { const int kb = r / 32, n0 = 32 * (r % 32); transpose_item(F.P->in[I_WAO], 1024, 64 * kb, n0, WCAT, 4096, n0, 3072 + 64 * kb, nullptr, scr, lane); continue; } r -= I1;
        if (r < I1) { const int kb = r / 32, n0 = 32 * (r % 32); transpose_item(F.P->in[I_WMO], 1024, 64 * kb, n0, WMO, 1024, n0, 64 * kb, nullptr, scr, lane); continue; } r -= I1;
        if (r < I7) { const int nb = FF / 32, kb = r / nb, n0 = 32 * (r % nb); transpose_item(F.P->in[I_WG], FF, 64 * kb, n0, WGU, 1024, 256 * (n0 >> 7) + (n0 & 127), 64 * kb, F.P->in[I_NFFN], scr, lane); continue; } r -= I7;
        if (r < I7) { const int nb = FF / 32, kb = r / nb, n0 = 32 * (r % nb); transpose_item(F.P->in[I_WU], FF, 64 * kb, n0, WGU, 1024, 256 * (n0 >> 7) + 128 + (n0 & 127), 64 * kb, F.P->in[I_NFFN], scr, lane); continue; } r -= I7;
        { const int kb = r / 32, n0 = 32 * (r % 32); transpose_item(F.P->in[I_WDN], 1024, 64 * kb, n0, WD, FF, n0, 64 * kb, nullptr, scr, lane); }
    }
    { u32x4* z = (u32x4*)(WIN + (size_t)12320 * 1024); const int nz = (NIN - 12320) * 1024 / 8;
      for (int i = F.bid * 512 + F.tid; i < nz; i += F.G * 512) z[i] = (u32x4){0u, 0u, 0u, 0u}; }
    bf16_t* XN = WSP(bf16_t, WS_XN); bf16_t* MEMN = WSP(bf16_t, WS_MEMN);
    for (int m = gw; m < M_ALL; m += NGW) {
        if (m < MP) rms_row_bf16(F.P->in[I_XP] + (size_t)m * D, F.P->in[I_NMIX], XN + (size_t)m * D, lane);
        else if (m < MP + DEC) rms_row_bf16(F.P->in[I_XS] + (size_t)(m - MP) * D, F.P->in[I_NMIX], XN + (size_t)m * D, lane);
        else { u32x4* z = (u32x4*)(XN + (size_t)m * D); z[lane] = (u32x4){0u, 0u, 0u, 0u}; z[lane + 64] = (u32x4){0u, 0u, 0u, 0u}; }
    }
    for (int m = gw; m < BATCH * MEM; m += NGW) rms_row_bf16(F.P->in[I_MEM] + (size_t)m * D, F.P->in[I_NMEM], MEMN + (size_t)m * D, lane);
}

struct SchedP1 {
    const char* XN; const char* WIN; const char* MEMN; const char* WKV; int G, c;
    DEVM bool next(int i, Unit& u) const {
        const int n1 = MT_P * IN_TILES, n2 = BATCH * 8; const long L = (long)i * G + c;
        if (L >= n1 + n2) return false;
        u.nt = 16;
        if (L < n1) { pg8::tile_of((int)L, MT_P, IN_TILES, u.pm, u.pn); u.kind = 0; u.A = XN + (size_t)u.pm * 256 * 1024 * 2; u.B = WIN + (size_t)u.pn * 256 * 1024 * 2; }
        else { pg8::tile_of((int)(L - n1), BATCH, 8, u.pm, u.pn); u.kind = 1; u.A = MEMN + (size_t)u.pm * 256 * 1024 * 2; u.B = WKV + (size_t)u.pn * 256 * 1024 * 2; }
        return true;
    }
};
struct EpiP1 {
    unsigned char* ws; float* out; const float* dtb;
    DEVM void operator()(const f32x4 (&acc)[2][2][4][2], const Unit& u, int wr, int wc, int fr, int fq) const {
        const int cb = wc * 32 + 8 * fq;
        if (u.kind == 1) {
            const int b = u.pm, h = u.pn & 3; const bool isv = u.pn >= 4;
            float* of = out + (isv ? O_MV : O_MK); bf16_t* KB = (bf16_t*)(ws + WS_KB); bf16_t* VT = (bf16_t*)(ws + WS_VT);
#pragma unroll
            for (int ai = 0; ai < 2; ++ai)
#pragma unroll
                for (int m = 0; m < 4; ++m) { const int key = ai * 128 + wr * 64 + m * 16 + fr;
#pragma unroll
                    for (int bj = 0; bj < 2; ++bj) { const int d = bj * 128 + cb; const f32x4 v0 = acc[ai][bj][m][0], v1 = acc[ai][bj][m][1];
                        float* o = of + ((size_t)(b * MEM + key) * HEADS + h) * HD + d; *(f32x4*)o = v0; *(f32x4*)(o + 4) = v1;
                        if (!isv) *(u32x4*)(KB + ((size_t)(b * HEADS + h) * MEM + key) * HD + d) = pack8(v0, v1);
                        else { bf16_t* vt = VT + ((size_t)(b * HEADS + h) * HD + d) * MEM + key;
#pragma unroll
                            for (int e = 0; e < 4; ++e) { vt[(size_t)e * MEM] = (bf16_t)f2bf(v0[e]); vt[(size_t)(e + 4) * MEM] = (bf16_t)f2bf(v1[e]); } } }
                    CFENCE(); }
            return;
        }
        const int pn = u.pn, row0 = u.pm * 256 + wr * 64 + fr;
        if (pn < 4 || (pn >= 12 && pn < 20) || (pn >= 32 && pn < 36)) {
            const int coff = pn < 4 ? pn * 256 : (pn < 20 ? 1024 + (pn - 12) * 256 : 3072 + (pn - 32) * 256);
            bf16_t* O = (bf16_t*)(ws + WS_ACAT);
#pragma unroll
            for (int ai = 0; ai < 2; ++ai)
#pragma unroll
                for (int m = 0; m < 4; ++m) { bf16_t* rp = O + (size_t)(row0 + ai * 128 + m * 16) * 4096 + coff + cb;
#pragma unroll
                    for (int bj = 0; bj < 2; ++bj) *(u32x4*)(rp + bj * 128) = pack8(acc[ai][bj][m][0], acc[ai][bj][m][1]);
                    CFENCE(); }
        } else if (pn < 12) {
            bf16_t* O = (bf16_t*)(ws + WS_U); const int j = pn - 4;
#pragma unroll
            for (int ai = 0; ai < 2; ++ai)
#pragma unroll
                for (int m = 0; m < 4; ++m) *(u32x4*)(O + (size_t)(row0 + ai * 128 + m * 16) * 1024 + 128 * j + cb) = pack8(acc[ai][0][m][0] * acc[ai][1][m][0], acc[ai][0][m][1] * acc[ai][1][m][1]);
        } else if (pn < 32) {
            bf16_t* O = (bf16_t*)(ws + WS_XBC);
#pragma unroll
            for (int ai = 0; ai < 2; ++ai)
#pragma unroll
                for (int m = 0; m < 4; ++m) { bf16_t* rp = O + (size_t)(row0 + ai * 128 + m * 16) * XBCW + (pn - 20) * 256 + cb;
#pragma unroll
                    for (int bj = 0; bj < 2; ++bj) *(u32x4*)(rp + bj * 128) = pack8(acc[ai][bj][m][0], acc[ai][bj][m][1]);
                    CFENCE(); }
        } else if (pn < 48) {
            bf16_t* O = (bf16_t*)(ws + WS_G);
#pragma unroll
            for (int ai = 0; ai < 2; ++ai)
#pragma unroll
                for (int m = 0; m < 4; ++m) { bf16_t* rp = O + (size_t)(row0 + ai * 128 + m * 16) * 3072 + (pn - 36) * 256 + cb;
#pragma unroll
                    for (int bj = 0; bj < 2; ++bj) { f32x4 v0 = acc[ai][bj][m][0], v1 = acc[ai][bj][m][1];
#pragma unroll
                        for (int e = 0; e < 4; ++e) { v0[e] = sigmoidf_(v0[e]); v1[e] = sigmoidf_(v1[e]); }
                        *(u32x4*)(rp + bj * 128) = pack8(v0, v1); }
                    CFENCE(); }
        } else {
            if (wc == 0) { float* O = (float*)(ws + WS_DT); const f32x4 b0 = *(const f32x4*)(dtb + cb), b1 = *(const f32x4*)(dtb + cb + 4);
#pragma unroll
                for (int ai = 0; ai < 2; ++ai)
#pragma unroll
                    for (int m = 0; m < 4; ++m) { f32x4 v0 = acc[ai][0][m][0] + b0, v1 = acc[ai][0][m][1] + b1;
#pragma unroll
                        for (int e = 0; e < 4; ++e) { v0[e] = softplusf_(v0[e]); v1[e] = softplusf_(v1[e]); }
                        float* o = O + (size_t)(row0 + ai * 128 + m * 16) * 32 + cb; *(f32x4*)o = v0; *(f32x4*)(o + 4) = v1; CFENCE(); } }
        }
    }
};
struct SchedP5 {
    const char* ACAT; const char* WCAT; int G, c;
    DEVM bool next(int i, Unit& u) const {
        const int su = i / 3, seg = i - 3 * su; const long L = (long)su * G + c;
        if (L >= MT_P * 4) return false;
        pg8::tile_of((int)L, MT_P, 4, u.pm, u.pn); u.kind = seg; u.nt = seg == 1 ? 32 : 16;
        const size_t koff = (seg == 0 ? 0 : (seg == 1 ? 1024 : 3072)) * 2;
        u.A = ACAT + (size_t)u.pm * 256 * 4096 * 2 + koff; u.B = WCAT + (size_t)u.pn * 256 * 4096 * 2 + koff; return true;
    }
};
struct EpiP5 {
    unsigned char* ws;
    DEVM void operator()(const f32x4 (&acc)[2][2][4][2], const Unit& u, int wr, int wc, int fr, int fq) const {
        const int row0 = u.pm * 256 + wr * 64 + fr, col0 = u.pn * 256 + wc * 32 + 8 * fq, seg = u.kind;
        const bf16_t* Gt = (const bf16_t*)(ws + WS_G) + seg * 1024; float* SC = (float*)(ws + WS_MSCR); bf16_t* MG = (bf16_t*)(ws + WS_MERGED);
#pragma unroll
        for (int ai = 0; ai < 2; ++ai)
#pragma unroll
            for (int m = 0; m < 4; ++m) { const size_t row = (size_t)(row0 + ai * 128 + m * 16);
#pragma unroll
                for (int bj = 0; bj < 2; ++bj) { const int col = col0 + bj * 128; float g[8]; unpack8(*(const u32x4*)(Gt + row * 3072 + col), g);
                    f32x4 v0 = acc[ai][bj][m][0], v1 = acc[ai][bj][m][1];
#pragma unroll
                    for (int e = 0; e < 4; ++e) { v0[e] *= g[e]; v1[e] *= g[4 + e]; }
                    float* sp = SC + row * 1024 + col;
                    if (seg > 0) { v0 += *(const f32x4*)sp; v1 += *(const f32x4*)(sp + 4); }
                    if (seg < 2) { *(f32x4*)sp = v0; *(f32x4*)(sp + 4) = v1; }
                    else *(u32x4*)(MG + row * 1024 + col) = pack8(v0, v1); } }
    }
};
struct SchedPlain {
    const char* A; const char* B; int nM, nN, nt, G, c; size_t pitchB;
    DEVM bool next(int i, Unit& u) const {
        const long L = (long)i * G + c; if (L >= nM * nN) return false;
        pg8::tile_of((int)L, nM, nN, u.pm, u.pn); u.kind = 0; u.nt = nt; u.A = A + (size_t)u.pm * 256 * pitchB; u.B = B + (size_t)u.pn * 256 * pitchB; return true;
    }
};
struct EpiP6 {
    unsigned char* ws; const float* xp; const float* xs;
    DEVM void operator()(const f32x4 (&acc)[2][2][4][2], const Unit& u, int wr, int wc, int fr, int fq) const {
        const int row0 = u.pm * 256 + wr * 64 + fr, col0 = u.pn * 256 + wc * 32 + 8 * fq;
        float* X2 = (float*)(ws + WS_XP2); bf16_t* X2B = (bf16_t*)(ws + WS_XP2B); float* SS = (float*)ws + CW_SS2;
#pragma unroll
        for (int ai = 0; ai < 2; ++ai)
#pragma unroll
            for (int m = 0; m < 4; ++m) { const int row = row0 + ai * 128 + m * 16; float s = 0.f;
                const float* xr = row < MP ? xp + (size_t)row * D : (row < MP + DEC ? xs + (size_t)(row - MP) * D : nullptr);
#pragma unroll
                for (int bj = 0; bj < 2; ++bj) { const int col = col0 + bj * 128; f32x4 v0 = acc[ai][bj][m][0], v1 = acc[ai][bj][m][1];
                    if (xr) { v0 += *(const f32x4*)(xr + col); v1 += *(const f32x4*)(xr + col + 4); }
                    s += (v0[0] * v0[0] + v0[1] * v0[1]) + (v0[2] * v0[2] + v0[3] * v0[3]) + (v1[0] * v1[0] + v1[1] * v1[1]) + (v1[2] * v1[2] + v1[3] * v1[3]);
                    float* o = X2 + (size_t)row * 1024 + col; *(f32x4*)o = v0; *(f32x4*)(o + 4) = v1;
                    *(u32x4*)(X2B + (size_t)row * 1024 + col) = pack8(v0, v1); }
                s += SHFL_XOR(s, 16); s += SHFL_XOR(s, 32);
                if (fq == 0) ATOMIC_ADD_F32(SS + row, s); }
    }
};
struct EpiP7 {
    unsigned char* ws;
    DEVM void operator()(const f32x4 (&acc)[2][2][4][2], const Unit& u, int wr, int wc, int fr, int fq) const {
        const int row0 = u.pm * 256 + wr * 64 + fr, col0 = u.pn * 128 + wc * 32 + 8 * fq;
        const float* SS2 = (const float*)ws + CW_SS2; bf16_t* H = (bf16_t*)(ws + WS_HID);
#pragma unroll
        for (int ai = 0; ai < 2; ++ai)
#pragma unroll
            for (int m = 0; m < 4; ++m) { const int row = row0 + ai * 128 + m * 16; const float rs = fast_rsqrt(SS2[row] * (1.f / 1024.f) + EPS);
                f32x4 h0, h1;
#pragma unroll
                for (int e = 0; e < 4; ++e) { h0[e] = siluf_(rs * acc[ai][0][m][0][e]) * (rs * acc[ai][1][m][0][e]); h1[e] = siluf_(rs * acc[ai][0][m][1][e]) * (rs * acc[ai][1][m][1][e]); }
                *(u32x4*)(H + (size_t)row * FF + col0) = pack8(h0, h1); }
    }
};
struct EpiP8 {
    unsigned char* ws; float* out;
    DEVM void operator()(const f32x4 (&acc)[2][2][4][2], const Unit& u, int wr, int wc, int fr, int fq) const {
        const int row0 = u.pm * 256 + wr * 64 + fr, col0 = u.pn * 256 + wc * 32 + 8 * fq;
        const float* X2 = (const float*)(ws + WS_XP2); float* SS = (float*)ws + CW_SS3;
#pragma unroll
        for (int ai = 0; ai < 2; ++ai)
#pragma unroll
            for (int m = 0; m < 4; ++m) { const int row = row0 + ai * 128 + m * 16; float s = 0.f;
                float* orow = row < MP + DEC ? out + O_YP + (size_t)row * D : (float*)(ws + WS_DUMP) + (size_t)(row - MP) * D;
#pragma unroll
                for (int bj = 0; bj < 2; ++bj) { const int col = col0 + bj * 128; const float* x = X2 + (size_t)row * 1024 + col;
                    const f32x4 v0 = acc[ai][bj][m][0] + *(const f32x4*)x, v1 = acc[ai][bj][m][1] + *(const f32x4*)(x + 4);
                    s += (v0[0] * v0[0] + v0[1] * v0[1]) + (v0[2] * v0[2] + v0[3] * v0[3]) + (v1[0] * v1[0] + v1[1] * v1[1]) + (v1[2] * v1[2] + v1[3] * v1[3]);
                    *(f32x4*)(orow + col) = v0; *(f32x4*)(orow + col + 4) = v1; }
                s += SHFL_XOR(s, 16); s += SHFL_XOR(s, 32);
                if (fq == 0) ATOMIC_ADD_F32(SS + row, s); }
    }
};


DEV void skinny_core(Frame& F, const bf16_t* A, size_t lda, const bf16_t* B, size_t ldb, int K, f32x4 (&acc)[2][2]) {
    const int tid = F.tid, w = F.wave, l15 = F.lane & 15, lq = F.lane >> 4;
    LAS bf16_t* BL = (LAS bf16_t*)F.lds;
    const bf16_t* ap = A + (size_t)(16 * w + l15) * lda + 8 * lq;
    const int r0 = tid >> 5, ch = tid & 31;
    const bf16_t* bp = B + (size_t)((r0 & 31) + (r0 >> 5) * 128) * ldb + 8 * ch;
    u32x4 st[4];
#pragma unroll
    for (int hf = 0; hf < 2; ++hf)
#pragma unroll
        for (int nf = 0; nf < 2; ++nf) acc[hf][nf] = (f32x4){0.f, 0.f, 0.f, 0.f};
    BLOCK_SYNC();
#pragma unroll
    for (int i = 0; i < 4; ++i) { const int r = r0 + 16 * i; st[i] = *(const u32x4*)(B + (size_t)((r & 31) + (r >> 5) * 128) * ldb + 8 * ch); }
#pragma unroll
    for (int i = 0; i < 4; ++i) *(LAS u32x4*)(BL + (r0 + 16 * i) * 264 + 8 * ch) = st[i];
    int cur = 0;
#pragma unroll 1
    for (int k0 = 0; k0 < K; k0 += 256) { bf16x8 a[8];
#pragma unroll
        for (int u = 0; u < 8; ++u) a[u] = *(const bf16x8*)(ap + k0 + 32 * u);
        const bool more = k0 + 256 < K;
        if (more) {
#pragma unroll
            for (int i = 0; i < 4; ++i) { const int r = r0 + 16 * i; st[i] = *(const u32x4*)(B + (size_t)((r & 31) + (r >> 5) * 128) * ldb + k0 + 256 + 8 * ch); } }
        BLOCK_SYNC();
        const LAS bf16_t* bl = BL + cur * (64 * 264);
#pragma unroll
        for (int u = 0; u < 8; ++u)
#pragma unroll
            for (int hf = 0; hf < 2; ++hf)
#pragma unroll
                for (int nf = 0; nf < 2; ++nf) { const bf16x8 x = *(const LAS bf16x8*)(bl + (32 * hf + 16 * nf + l15) * 264 + 32 * u + 8 * lq); acc[hf][nf] = MFMA16(x, a[u], acc[hf][nf]); }
        if (more) {
#pragma unroll
            for (int i = 0; i < 4; ++i) *(LAS u32x4*)(BL + (cur ^ 1) * (64 * 264) + (r0 + 16 * i) * 264 + 8 * ch) = st[i]; }
        cur ^= 1; }
    (void)bp;
}
DEV u32x2 pack4(const f32x4& v) { u32x2 o; o.x = cvt_pk_bf16(v[0], v[1]); o.y = cvt_pk_bf16(v[2], v[3]); return o; }
DEV void sk_inproj_item(Frame& F, int item) {
    const int pn = item >> 2, cg = item & 3, w = F.wave, l15 = F.lane & 15, lq = F.lane >> 4, row = MP + 16 * w + l15;
    f32x4 acc[2][2];
    skinny_core(F, WSP(const bf16_t, WS_XN) + (size_t)MP * 1024, 1024, WSP(const bf16_t, WS_WIN) + (size_t)(pn * 256 + 32 * cg) * 1024, 1024, 1024, acc);
#pragma unroll
    for (int nf = 0; nf < 2; ++nf) { const int cb = 32 * cg + 16 * nf + 4 * lq; f32x4 v0 = acc[0][nf], v1 = acc[1][nf];
        if (pn < 4 || (pn >= 12 && pn < 20) || (pn >= 32 && pn < 36)) { const int coff = pn < 4 ? pn * 256 : (pn < 20 ? 1024 + (pn - 12) * 256 : 3072 + (pn - 32) * 256);
            bf16_t* o = WSP(bf16_t, WS_ACAT) + (size_t)row * 4096 + coff + cb; *(u32x2*)o = pack4(v0); *(u32x2*)(o + 128) = pack4(v1); }
        else if (pn < 12) { *(u32x2*)(WSP(bf16_t, WS_U) + (size_t)row * 1024 + 128 * (pn - 4) + cb) = pack4(v0 * v1); }
        else if (pn < 32) { bf16_t* o = WSP(bf16_t, WS_XBC) + (size_t)row * XBCW + (pn - 20) * 256 + cb; *(u32x2*)o = pack4(v0); *(u32x2*)(o + 128) = pack4(v1); }
        else if (pn < 48) {
#pragma unroll
            for (int e = 0; e < 4; ++e) { v0[e] = sigmoidf_(v0[e]); v1[e] = sigmoidf_(v1[e]); }
            bf16_t* o = WSP(bf16_t, WS_G) + (size_t)row * 3072 + (pn - 36) * 256 + cb; *(u32x2*)o = pack4(v0); *(u32x2*)(o + 128) = pack4(v1); }
        else if (cg == 0) { const f32x4 b = *(const f32x4*)(F.P->in[I_DTB] + cb); f32x4 d;
#pragma unroll
            for (int e = 0; e < 4; ++e) d[e] = softplusf_(v0[e] + b[e]);
            *(f32x4*)(WSP(float, WS_DT) + (size_t)row * 32 + cb) = d; } }
}
DEV void sk_merge_item(Frame& F, int item) {
    const int pn = item >> 2, cg = item & 3, w = F.wave, l15 = F.lane & 15, lq = F.lane >> 4, row = MP + 16 * w + l15;
    const bf16_t* A = WSP(const bf16_t, WS_ACAT) + (size_t)MP * 4096; const bf16_t* W = WSP(const bf16_t, WS_WCAT) + (size_t)(pn * 256 + 32 * cg) * 4096;
    f32x4 m[2][2];
#pragma unroll
    for (int hf = 0; hf < 2; ++hf)
#pragma unroll
        for (int nf = 0; nf < 2; ++nf) m[hf][nf] = (f32x4){0.f, 0.f, 0.f, 0.f};
#pragma unroll 1
    for (int seg = 0; seg < 3; ++seg) { const int koff = seg == 0 ? 0 : (seg == 1 ? 1024 : 3072), K = seg == 1 ? 2048 : 1024;
        f32x4 acc[2][2];
        skinny_core(F, A + koff, 4096, W + koff, 4096, K, acc);
#pragma unroll
        for (int hf = 0; hf < 2; ++hf)
#pragma unroll
            for (int nf = 0; nf < 2; ++nf) { const u32x2 g = *(const u32x2*)(WSP(const bf16_t, WS_G) + (size_t)row * 3072 + seg * 1024 + pn * 256 + 128 * hf + 32 * cg + 16 * nf + 4 * lq);
                m[hf][nf][0] += bflo(g.x) * acc[hf][nf][0]; m[hf][nf][1] += bfhi(g.x) * acc[hf][nf][1]; m[hf][nf][2] += bflo(g.y) * acc[hf][nf][2]; m[hf][nf][3] += bfhi(g.y) * acc[hf][nf][3]; } }
#pragma unroll
    for (int hf = 0; hf < 2; ++hf)
#pragma unroll
        for (int nf = 0; nf < 2; ++nf) *(u32x2*)(WSP(bf16_t, WS_MERGED) + (size_t)row * 1024 + pn * 256 + 128 * hf + 32 * cg + 16 * nf + 4 * lq) = pack4(m[hf][nf]);
}
DEV void sk_mergeo_item(Frame& F, int item) {
    const int pn = item >> 2, cg = item & 3, w = F.wave, l15 = F.lane & 15, lq = F.lane >> 4, s = 16 * w + l15, row = MP + s;
    f32x4 acc[2][2];
    skinny_core(F, WSP(const bf16_t, WS_MERGED) + (size_t)MP * 1024, 1024, WSP(const bf16_t, WS_WMO) + (size_t)(pn * 256 + 32 * cg) * 1024, 1024, 1024, acc);
    float ss = 0.f;
#pragma unroll
    for (int hf = 0; hf < 2; ++hf)
#pragma unroll
        for (int nf = 0; nf < 2; ++nf) { const int col = pn * 256 + 128 * hf + 32 * cg + 16 * nf + 4 * lq; f32x4 v = acc[hf][nf];
            if (s < DEC) v += *(const f32x4*)(F.P->in[I_XS] + (size_t)s * D + col);
            *(f32x4*)(WSP(float, WS_XP2) + (size_t)row * 1024 + col) = v; *(u32x2*)(WSP(bf16_t, WS_XP2B) + (size_t)row * 1024 + col) = pack4(v);
            ss += (v[0] * v[0] + v[1] * v[1]) + (v[2] * v[2] + v[3] * v[3]); }
    ss += SHFL_XOR(ss, 16); ss += SHFL_XOR(ss, 32);
    if (lq == 0) ATOMIC_ADD_F32((float*)F.ws + CW_SS2 + row, ss);
}
DEV void sk_up_item(Frame& F, int item) {
    const int pn = item >> 2, cg = item & 3, w = F.wave, l15 = F.lane & 15, lq = F.lane >> 4, row = MP + 16 * w + l15;
    f32x4 acc[2][2];
    skinny_core(F, WSP(const bf16_t, WS_XP2B) + (size_t)MP * 1024, 1024, WSP(const bf16_t, WS_WGU) + (size_t)(pn * 256 + 32 * cg) * 1024, 1024, 1024, acc);
    const float rs = fast_rsqrt(((const float*)F.ws)[CW_SS2 + row] * (1.f / 1024.f) + EPS);
#pragma unroll
    for (int nf = 0; nf < 2; ++nf) { f32x4 h;
#pragma unroll
        for (int e = 0; e < 4; ++e) h[e] = siluf_(rs * acc[0][nf][e]) * (rs * acc[1][nf][e]);
        *(u32x2*)(WSP(bf16_t, WS_HID) + (size_t)row * FF + pn * 128 + 32 * cg + 16 * nf + 4 * lq) = pack4(h); }
}
DEV void sk_down_item(Frame& F, int item) {
    const int pn = item >> 2, cg = item & 3, w = F.wave, l15 = F.lane & 15, lq = F.lane >> 4, s = 16 * w + l15, row = MP + s;
    f32x4 acc[2][2];
    skinny_core(F, WSP(const bf16_t, WS_HID) + (size_t)MP * FF, FF, WSP(const bf16_t, WS_WD) + (size_t)(pn * 256 + 32 * cg) * FF, FF, FF, acc);
    float ss = 0.f; float* orow = s < DEC ? F.out + O_YS + (size_t)s * D : WSP(float, WS_DUMP) + (size_t)s * D;
#pragma unroll
    for (int hf = 0; hf < 2; ++hf)
#pragma unroll
        for (int nf = 0; nf < 2; ++nf) { const int col = pn * 256 + 128 * hf + 32 * cg + 16 * nf + 4 * lq;
            const f32x4 v = acc[hf][nf] + *(const f32x4*)(WSP(const float, WS_XP2) + (size_t)row * 1024 + col);
            *(f32x4*)(orow + col) = v; ss += (v[0] * v[0] + v[1] * v[1]) + (v[2] * v[2] + v[3] * v[3]); }
    ss += SHFL_XOR(ss, 16); ss += SHFL_XOR(ss, 32);
    if (lq == 0) ATOMIC_ADD_F32((float*)F.ws + CW_SS3 + row, ss);
}

DEV void conv8(const bf16_t* XBC, int rowbase, int t, int col, const float* cw, const float* cbias, float (&o)[8]) {
    const f32x4 b0 = *(const f32x4*)(cbias + col), b1 = *(const f32x4*)(cbias + col + 4);
    float a[8] = {b0[0], b0[1], b0[2], b0[3], b1[0], b1[1], b1[2], b1[3]};
#pragma unroll
    for (int k = 0; k < 4; ++k) { const int tt = t - 3 + k;
        if (tt >= 0) { float x[8]; unpack8(*(const u32x4*)(XBC + (size_t)(rowbase + tt) * XBCW + col), x);
            const f32x4 w0 = *(const f32x4*)(cw + k * XBCW + col), w1 = *(const f32x4*)(cw + k * XBCW + col + 4);
#pragma unroll
            for (int e = 0; e < 4; ++e) { a[e] += w0[e] * x[e]; a[4 + e] += w1[e] * x[4 + e]; } } }
#pragma unroll
    for (int e = 0; e < 8; ++e) o[e] = siluf_(a[e]);
}
DEV void chunk_dt_acum(const float* DT, const float* alog, int row0, int g, int hq, int lane, LAS float* acum, LAS float* dtv) {
    const int h = 8 * g + hq; const float a = -expf(alog[h]);
    const float d0 = DT[(size_t)(row0 + 2 * lane) * 32 + h], d1 = DT[(size_t)(row0 + 2 * lane + 1) * 32 + h];
    const float v0 = d0 * a, v1 = v0 + d1 * a; float s = v1;
#pragma unroll
    for (int d = 1; d < 64; d <<= 1) { const float t = SHFL(s, (lane - d) & 63); if (lane >= d) s += t; }
    const float ex = s - v1;
    acum[(2 * lane) * 8 + hq] = ex + v0; acum[(2 * lane + 1) * 8 + hq] = s;
    dtv[(2 * lane) * 8 + hq] = d0; dtv[(2 * lane + 1) * 8 + hq] = d1;
}

DEV void ssd_states_item(Frame& F, int item) {
    const int g = item & 3, c = (item >> 2) % NCH, b = (item >> 2) / NCH;
    const int tid = F.tid, lane = F.lane, w = F.wave, l15 = lane & 15, lq = lane >> 4;
    LAS float* acum = (LAS float*)F.lds; LAS float* dtv = acum + 1024;
    LAS bf16_t* BT = (LAS bf16_t*)(F.lds + 8192);
    LAS bf16_t* XW = (LAS bf16_t*)(F.lds + 8192 + 34816);
    const bf16_t* XBC = WSP(const bf16_t, WS_XBC); const float* DT = WSP(const float, WS_DT);
    const float* cw = F.P->in[I_SSMCW]; const float* cbias = F.P->in[I_SSMCB];
    const int rowbase = b * SEQ, t0 = c * 128, row0 = rowbase + t0;
    BLOCK_SYNC();
    chunk_dt_acum(DT, F.P->in[I_ALOG], row0, g, w, lane, acum, dtv);
#pragma unroll 1
    for (int it = 0; it < 4; ++it) { const int idx = tid + 512 * it, j = idx >> 4, cg = idx & 15; float o[8];
        conv8(XBC, rowbase, t0 + j, DIN + g * 128 + 8 * cg, cw, cbias, o);
#pragma unroll
        for (int e = 0; e < 8; ++e) BT[(8 * cg + e) * 136 + j] = (bf16_t)f2bf(o[e]); }
    BLOCK_SYNC();
    if (tid < 8) WSP(float, WS_CDEC)[(size_t)(b * NCH + c) * 32 + 8 * g + tid] = expf(acum[127 * 8 + tid]);
    bf16x8 afr[4];
#pragma unroll
    for (int ks = 0; ks < 4; ++ks) afr[ks] = *(const LAS bf16x8*)(BT + (16 * w + l15) * 136 + 32 * ks + 8 * lq);
    bf16_t* CH = WSP(bf16_t, WS_CHST);
#pragma unroll 1
    for (int hb = 0; hb < 2; ++hb) {
        if (hb) BLOCK_SYNC();
#pragma unroll 1
        for (int it = 0; it < 8; ++it) { const int idx = tid + 512 * it, hh = idx >> 10, j = (idx >> 3) & 127, cg = idx & 7, hq = 4 * hb + hh; float o[8];
            conv8(XBC, rowbase, t0 + j, (8 * g + hq) * 64 + 8 * cg, cw, cbias, o);
            const float wgt = expf(acum[127 * 8 + hq] - acum[j * 8 + hq]) * dtv[j * 8 + hq];
#pragma unroll
            for (int e = 0; e < 8; ++e) XW[hh * 8704 + (8 * cg + e) * 136 + j] = (bf16_t)f2bf(wgt * o[e]); }
        BLOCK_SYNC();
#pragma unroll
        for (int hh = 0; hh < 4; ++hh) { const int h = 8 * g + 4 * hb + hh;
#pragma unroll
            for (int pf = 0; pf < 4; ++pf) { f32x4 a4 = (f32x4){0.f, 0.f, 0.f, 0.f};
#pragma unroll
                for (int ks = 0; ks < 4; ++ks) { const bf16x8 bfr = *(const LAS bf16x8*)(XW + hh * 8704 + (16 * pf + l15) * 136 + 32 * ks + 8 * lq); a4 = MFMA16(afr[ks], bfr, a4); }
                u32x2 o; o.x = pk2(a4[0], a4[1]); o.y = pk2(a4[2], a4[3]);
                *(u32x2*)(CH + ((size_t)(b * NCH + c) * 32 + h) * 8192 + (16 * pf + l15) * 128 + 16 * w + 4 * lq) = o; } }
    }
}

DEV void attn_item(Frame& F, int item) {
    const int qt = item % (SEQ / 128), h = (item / (SEQ / 128)) & 3, b = item / (SEQ / 128) / 4;
    const int tid = F.tid, lane = F.lane, w = F.wave, l15 = lane & 15, lq = lane >> 4;
    LAS bf16_t* KL = (LAS bf16_t*)F.lds;
    const bf16_t* KBh = WSP(const bf16_t, WS_KB) + (size_t)(b * HEADS + h) * MEM * HD;
    const bf16_t* VTh = WSP(const bf16_t, WS_VT) + (size_t)(b * HEADS + h) * MEM * HD;
    bf16_t* QO = WSP(bf16_t, WS_ACAT) + (size_t)(b * SEQ + qt * 128 + 16 * w + l15) * 4096 + 3072 + h * HD;
    BLOCK_SYNC();
#pragma unroll 4
    for (int it = 0; it < 16; ++it) { const int idx = tid + 512 * it, row = idx >> 5, ch = idx & 31; *(LAS u32x4*)(KL + row * 264 + 8 * ch) = *(const u32x4*)(KBh + row * 256 + 8 * ch); }
    bf16x8 qf[8];
#pragma unroll
    for (int ks = 0; ks < 8; ++ks) qf[ks] = *(const bf16x8*)(QO + 32 * ks + 8 * lq);
    BLOCK_SYNC();
    f32x4 st[16];
#pragma unroll
    for (int kf = 0; kf < 16; ++kf) { f32x4 a4 = (f32x4){0.f, 0.f, 0.f, 0.f};
#pragma unroll
        for (int ks = 0; ks < 8; ++ks) { const bf16x8 afr = *(const LAS bf16x8*)(KL + (16 * kf + l15) * 264 + 32 * ks + 8 * lq); a4 = MFMA16(afr, qf[ks], a4); }
        st[kf] = a4; }
    float mx = -3.0e38f;
#pragma unroll
    for (int kf = 0; kf < 16; ++kf) mx = fmaxf(fmaxf(fmaxf(st[kf][0], st[kf][1]), fmaxf(st[kf][2], st[kf][3])), mx);
    mx = fmaxf(mx, SHFL_XOR(mx, 16)); mx = fmaxf(mx, SHFL_XOR(mx, 32));
    float sum = 0.f;
#pragma unroll
    for (int kf = 0; kf < 16; ++kf)
#pragma unroll
        for (int r = 0; r < 4; ++r) { const float p = fast_exp((st[kf][r] - mx) * 0.0625f); st[kf][r] = p; sum += p; }
    sum += SHFL_XOR(sum, 16); sum += SHFL_XOR(sum, 32);
    const float inv = 1.0f / sum;
    u32x2 pk[16];
#pragma unroll
    for (int kf = 0; kf < 16; ++kf) { pk[kf].x = pk2(st[kf][0] * inv, st[kf][1] * inv); pk[kf].y = pk2(st[kf][2] * inv, st[kf][3] * inv); }
    BLOCK_SYNC();
#pragma unroll 4
    for (int it = 0; it < 16; ++it) { const int idx = tid + 512 * it, row = idx >> 5, ch = idx & 31; *(LAS u32x4*)(KL + row * 264 + 8 * ch) = *(const u32x4*)(VTh + row * 256 + 8 * ch); }
    BLOCK_SYNC();
#pragma unroll
    for (int df = 0; df < 16; ++df) { f32x4 a4 = (f32x4){0.f, 0.f, 0.f, 0.f};
#pragma unroll
        for (int s = 0; s < 8; ++s) { const LAS bf16_t* vp = KL + (16 * df + l15) * 264 + 32 * s + 4 * lq;
            const u32x2 lo = *(const LAS u32x2*)vp, hi = *(const LAS u32x2*)(vp + 16);
            u32x4 av; av.x = lo.x; av.y = lo.y; av.z = hi.x; av.w = hi.y;
            u32x4 bv; bv.x = pk[2 * s].x; bv.y = pk[2 * s].y; bv.z = pk[2 * s + 1].x; bv.w = pk[2 * s + 1].y;
            a4 = MFMA16(__builtin_bit_cast(bf16x8, av), __builtin_bit_cast(bf16x8, bv), a4); }
        u32x2 o; o.x = pk2(a4[0], a4[1]); o.y = pk2(a4[2], a4[3]);
        if (!F.dry) *(u32x2*)(QO + 16 * df + 4 * lq) = o; }
}

DEV void yain_item(Frame& F, int item) {
    const int row = item * 4 + (F.tid >> 7), col = 8 * (F.tid & 127), t = row % SEQ;
    const bf16_t* U = WSP(const bf16_t, WS_U); bf16_t* A = WSP(bf16_t, WS_ACAT) + (size_t)row * 4096 + col; const float* w = F.P->in[I_SCW];
    float u2[8], u1[8], u0[8], sb[8], y[8];
    unpack8(*(const u32x4*)(U + (size_t)row * 1024 + col), u2);
    if (t >= 1) unpack8(*(const u32x4*)(U + (size_t)(row - 1) * 1024 + col), u1); else {
#pragma unroll
        for (int e = 0; e < 8; ++e) u1[e] = 0.f; }
    if (t >= 2) unpack8(*(const u32x4*)(U + (size_t)(row - 2) * 1024 + col), u0); else {
#pragma unroll
        for (int e = 0; e < 8; ++e) u0[e] = 0.f; }
    unpack8(*(const u32x4*)A, sb);
#pragma unroll
    for (int e = 0; e < 8; ++e) y[e] = sb[e] * (w[col + e] * u0[e] + w[1024 + col + e] * u1[e] + w[2048 + col + e] * u2[e]);
    u32x4 o; o.x = pk2(y[0], y[1]); o.y = pk2(y[2], y[3]); o.z = pk2(y[4], y[5]); o.w = pk2(y[6], y[7]);
    if (!F.dry) *(u32x4*)A = o;
}
DEV void pstate_item(Frame& F, int b) {
    const bf16_t* U = WSP(const bf16_t, WS_U); const bf16_t* XBC = WSP(const bf16_t, WS_XBC);
    for (int i = F.tid; i < 2 * 1024; i += 512) { const int k = i >> 10, cc = i & 1023; F.out[O_PCONV + (size_t)(b * 2 + k) * 1024 + cc] = bf1(U[(size_t)(b * SEQ + SEQ - 2 + k) * 1024 + cc]); }
    for (int i = F.tid; i < 3 * XBCW; i += 512) { const int k = i / XBCW, cc = i - k * XBCW; F.out[O_PSSMC + (size_t)(b * 3 + k) * XBCW + cc] = bf1(XBC[(size_t)(b * SEQ + SEQ - 3 + k) * XBCW + cc]); }
}
DEV void s_sconv_item(Frame& F, int item) {
    const int s = item * 4 + (F.tid >> 7), col = 8 * (F.tid & 127), row = MP + s;
    const bf16_t* U = WSP(const bf16_t, WS_U); bf16_t* A = WSP(bf16_t, WS_ACAT) + (size_t)row * 4096 + col; const float* w = F.P->in[I_SCW];
    const float* h0 = F.P->in[I_SCONV] + (size_t)(s * 2) * 1024 + col; const float* h1 = h0 + 1024;
    float un[8], sb[8], y[8];
    unpack8(*(const u32x4*)(U + (size_t)row * 1024 + col), un); unpack8(*(const u32x4*)A, sb);
    float* oc = F.out + O_SCONV + (size_t)(s * 2) * 1024 + col;
#pragma unroll
    for (int e = 0; e < 8; ++e) { y[e] = sb[e] * (w[col + e] * h0[e] + w[1024 + col + e] * h1[e] + w[2048 + col + e] * un[e]); oc[e] = h1[e]; oc[1024 + e] = un[e]; }
    u32x4 o; o.x = pk2(y[0], y[1]); o.y = pk2(y[2], y[3]); o.z = pk2(y[4], y[5]); o.w = pk2(y[6], y[7]);
    if (!F.dry) *(u32x4*)A = o;
}
DEV void s_ssmconv_state_item(Frame& F, int s) {
    const bf16_t* XBC = WSP(const bf16_t, WS_XBC) + (size_t)(MP + s) * XBCW; const float* hist = F.P->in[I_SSMCONV] + (size_t)s * 3 * XBCW; float* o = F.out + O_SSSMC + (size_t)s * 3 * XBCW;
    for (int i = F.tid; i < XBCW; i += 512) { o[i] = hist[XBCW + i]; o[XBCW + i] = hist[2 * XBCW + i]; o[2 * XBCW + i] = bf1(XBC[i]); }
}
DEV void s_ssd_item(Frame& F, int item) {
    const int g = item & 3, s = item >> 2, tid = F.tid, row = MP + s;
    LAS float* xc = (LAS float*)F.lds;
    LAS float* yb = xc + 768;
    LAS float* red = yb + 512;
    const bf16_t* XBC = WSP(const bf16_t, WS_XBC) + (size_t)row * XBCW; const float* hist = F.P->in[I_SSMCONV] + (size_t)s * 3 * XBCW;
    const float* cw = F.P->in[I_SSMCW]; const float* cbias = F.P->in[I_SSMCB];
    BLOCK_SYNC();
    for (int i = tid; i < 768; i += 512) { const int col = i < 512 ? g * 512 + i : (i < 640 ? DIN + g * 128 + (i - 512) : DIN + 512 + g * 128 + (i - 640));
        const float v = cbias[col] + cw[col] * hist[col] + cw[XBCW + col] * hist[XBCW + col] + cw[2 * XBCW + col] * hist[2 * XBCW + col] + cw[3 * XBCW + col] * bf1(XBC[col]);
        xc[i] = siluf_(v); }
    BLOCK_SYNC();
    const int n4 = (tid & 31) * 4; const f32x4 Bv = *(const LAS f32x4*)(xc + 512 + n4), Cv = *(const LAS f32x4*)(xc + 640 + n4);
    const bf16_t* Z = WSP(const bf16_t, WS_ACAT) + (size_t)row * 4096 + 1024;
#pragma unroll 1
    for (int hq = 0; hq < 8; ++hq) { const int h = 8 * g + hq; const float dt = WSP(const float, WS_DT)[(size_t)row * 32 + h];
        const float dA = expf(dt * (-expf(F.P->in[I_ALOG][h]))), Dh = F.P->in[I_SSMD][h];
        const float* s0 = F.P->in[I_SSM] + ((size_t)s * 32 + h) * 8192; float* s1 = F.out + O_SSSM + ((size_t)s * 32 + h) * 8192;
#pragma unroll
        for (int k = 0; k < 4; ++k) { const int p = (tid >> 5) + 16 * k; const float xv = xc[hq * 64 + p], dx = dt * xv;
            const f32x4 so = *(const f32x4*)(s0 + p * 128 + n4); f32x4 sn;
#pragma unroll
            for (int e = 0; e < 4; ++e) sn[e] = so[e] * dA + dx * Bv[e];
            *(f32x4*)(s1 + p * 128 + n4) = sn;
            float y = (sn[0] * Cv[0] + sn[1] * Cv[1]) + (sn[2] * Cv[2] + sn[3] * Cv[3]);
            y += SHFL_XOR(y, 1); y += SHFL_XOR(y, 2); y += SHFL_XOR(y, 4); y += SHFL_XOR(y, 8); y += SHFL_XOR(y, 16);
            if ((tid & 31) == 0) { y += Dh * xv; yb[hq * 64 + p] = y * siluf_(bf1(Z[h * 64 + p])); } } }
    BLOCK_SYNC();
    const float yv = yb[tid]; const float ssw = wave_sum(yv * yv);
    if (F.lane == 0) red[F.wave] = ssw;
    BLOCK_SYNC();
    float tot = 0.f;
#pragma unroll
    for (int i = 0; i < 8; ++i) tot += red[i];
    const float rs = fast_rsqrt(tot * (1.f / 512.f) + EPS);
    if (!F.dry) WSP(bf16_t, WS_ACAT)[(size_t)row * 4096 + 1024 + g * 512 + tid] = (bf16_t)f2bf(yv * rs * F.P->in[I_SSMNW][g * 512 + tid]);
}
DEV void s_attn_item(Frame& F, int item) {
    const int h = item & 3, s = item >> 2, tid = F.tid, lane = F.lane, w = F.wave, row = MP + s;
    LAS float* sc = (LAS float*)F.lds;
    LAS float* part = sc + 256;
    LAS float* red = part + 512;
    bf16_t* QO = WSP(bf16_t, WS_ACAT) + (size_t)row * 4096 + 3072 + h * HD;
    const float* Kc = F.P->in[I_CK] + ((size_t)s * MEM * HEADS + h) * HD; const float* Vc = F.P->in[I_CV] + ((size_t)s * MEM * HEADS + h) * HD;
    BLOCK_SYNC();
    const u32x2 qw = *(const u32x2*)(QO + 4 * lane); const float q0 = bflo(qw.x), q1 = bfhi(qw.x), q2 = bflo(qw.y), q3 = bfhi(qw.y);
#pragma unroll 4
    for (int i = 0; i < 32; ++i) { const int key = 32 * w + i; const f32x4 kv = *(const f32x4*)(Kc + (size_t)key * (HEADS * HD) + 4 * lane);
        const float d = wave_sum((kv[0] * q0 + kv[1] * q1) + (kv[2] * q2 + kv[3] * q3)); if (lane == 0) sc[key] = d * 0.0625f; }
    BLOCK_SYNC();
    if (w == 0) { const f32x4 v = *(const LAS f32x4*)(sc + 4 * lane); float mx = fmaxf(fmaxf(v[0], v[1]), fmaxf(v[2], v[3]));
#pragma unroll
        for (int o = 1; o < 64; o <<= 1) mx = fmaxf(mx, SHFL_XOR(mx, o));
        f32x4 p; float sm = 0.f;
#pragma unroll
        for (int e = 0; e < 4; ++e) { p[e] = expf(v[e] - mx); sm += p[e]; }
        sm = wave_sum(sm); const float inv = 1.f / sm;
        *(LAS f32x4*)(sc + 4 * lane) = p * inv; }
    BLOCK_SYNC();
    { const int d = tid & 255, k0 = (tid >> 8) * 128; float a = 0.f;
#pragma unroll 8
      for (int k = 0; k < 128; ++k) a += sc[k0 + k] * Vc[(size_t)(k0 + k) * (HEADS * HD) + d];
      part[tid] = a; }
    BLOCK_SYNC();
    if (tid < 256 && !F.dry) QO[tid] = (bf16_t)f2bf(part[tid] + part[tid + 256]);
    (void)red;
}

DEV void p3_scan(Frame& F) {
    bf16_t* CH = WSP(bf16_t, WS_CHST); const float* CDEC = WSP(const float, WS_CDEC);
    const int ntask = BATCH * 32 * 64 * 32;
    for (int i = F.bid * 512 + F.tid; i < ntask; i += F.G * 512) {
        const int n4 = (i & 31) * 4, p = (i >> 5) & 63, h = (i >> 11) & 31, b = i >> 16;
        f32x4 S = (f32x4){0.f, 0.f, 0.f, 0.f};
#pragma unroll 1
        for (int c = 0; c < NCH; ++c) { bf16_t* q = CH + ((size_t)(b * NCH + c) * 32 + h) * 8192 + p * 128 + n4; const u32x2 raw = *(const u32x2*)q; const float dec = CDEC[(size_t)(b * NCH + c) * 32 + h];
            u32x2 o; o.x = pk2(S[0], S[1]); o.y = pk2(S[2], S[3]); if (!F.dry) *(u32x2*)q = o;
            S[0] = S[0] * dec + bflo(raw.x); S[1] = S[1] * dec + bfhi(raw.x); S[2] = S[2] * dec + bflo(raw.y); S[3] = S[3] * dec + bfhi(raw.y); }
        *(f32x4*)(F.out + O_PSSM + ((size_t)(b * 32 + h) * 64 + p) * 128 + n4) = S;
    }
}

DEV void ssd_out_item(Frame& F, int item) {
    const int g = item & 3, c = (item >> 2) % NCH, b = (item >> 2) / NCH;
    const int tid = F.tid, lane = F.lane, w = F.wave, l15 = lane & 15, lq = lane >> 4;
    LAS float* acum = (LAS float*)F.lds; LAS float* dtv = acum + 1024;
    LAS bf16_t* CL = (LAS bf16_t*)(F.lds + 8192);
    LAS bf16_t* BL = (LAS bf16_t*)(F.lds + 8192 + 34816);
    LAS bf16_t* XdT = BL; LAS bf16_t* SL = BL + 8704;
    LAS bf16_t* MW = (LAS bf16_t*)(F.lds + 8192 + 2 * 34816) + w * 2176;
    LAS bf16_t* XN_ = (LAS bf16_t*)(F.lds + 8192 + 3 * 34816);
    const bf16_t* XBC = WSP(const bf16_t, WS_XBC); const float* DT = WSP(const float, WS_DT);
    const float* cw = F.P->in[I_SSMCW]; const float* cbias = F.P->in[I_SSMCB];
    const int rowbase = b * SEQ, t0 = c * 128, row0 = rowbase + t0;
    BLOCK_SYNC();
    chunk_dt_acum(DT, F.P->in[I_ALOG], row0, g, w, lane, acum, dtv);
#pragma unroll 1
    for (int it = 0; it < 8; ++it) { const int idx = tid + 512 * it, isC = idx >> 11, j = (idx >> 4) & 127, cg = idx & 15; float o[8];
        conv8(XBC, rowbase, t0 + j, DIN + isC * 512 + g * 128 + 8 * cg, cw, cbias, o);
        u32x4 pw; pw.x = pk2(o[0], o[1]); pw.y = pk2(o[2], o[3]); pw.z = pk2(o[4], o[5]); pw.w = pk2(o[6], o[7]);
        *(LAS u32x4*)((isC ? CL : BL) + j * 136 + 8 * cg) = pw; }
    BLOCK_SYNC();
    bf16x8 cfr[4];
#pragma unroll
    for (int ks = 0; ks < 4; ++ks) cfr[ks] = *(const LAS bf16x8*)(CL + (16 * w + l15) * 136 + 32 * ks + 8 * lq);
    f32x4 cb[8];
#pragma unroll
    for (int jf = 0; jf < 8; ++jf) { f32x4 a4 = (f32x4){0.f, 0.f, 0.f, 0.f};
#pragma unroll
        for (int ks = 0; ks < 4; ++ks) { const bf16x8 bfr = *(const LAS bf16x8*)(BL + (16 * jf + l15) * 136 + 32 * ks + 8 * lq); a4 = MFMA16(bfr, cfr[ks], a4); }
        cb[jf] = a4; }
    const int il = 16 * w + l15;
    bf16_t* Zrow = WSP(bf16_t, WS_ACAT) + (size_t)(row0 + il) * 4096 + 1024;
    const bf16_t* SP = WSP(const bf16_t, WS_CHST);
    u32x2 ykeep[8][4]; float ss = 0.f;
#pragma unroll
    for (int a = 0; a < 8; ++a)
#pragma unroll
        for (int pf = 0; pf < 4; ++pf) ykeep[a][pf] = (u32x2){0u, 0u};
#pragma unroll 1
    for (int hq = 0; hq < 8; ++hq) { const int h = 8 * g + hq;
        BLOCK_SYNC();
#pragma unroll 1
        for (int it = 0; it < 2; ++it) { const int idx = tid + 512 * it, j = idx >> 3, cg = idx & 7; float o[8];
            conv8(XBC, rowbase, t0 + j, h * 64 + 8 * cg, cw, cbias, o);
            u32x4 pw; pw.x = pk2(o[0], o[1]); pw.y = pk2(o[2], o[3]); pw.z = pk2(o[4], o[5]); pw.w = pk2(o[6], o[7]);
            *(LAS u32x4*)(XN_ + j * 72 + 8 * cg) = pw;
            const float dj = dtv[j * 8 + hq];
#pragma unroll
            for (int e = 0; e < 8; ++e) XdT[(8 * cg + e) * 136 + j] = (bf16_t)f2bf(dj * o[e]); }
#pragma unroll 1
        for (int it = 0; it < 2; ++it) { const int idx = tid + 512 * it, p = idx >> 4, ch = idx & 15;
            *(LAS u32x4*)(SL + p * 136 + 8 * ch) = *(const u32x4*)(SP + ((size_t)(b * NCH + c) * 32 + h) * 8192 + p * 128 + 8 * ch); }
        const float ai_ = acum[il * 8 + hq];
#pragma unroll
        for (int jf = 0; jf < 8; ++jf) { const int j0 = 16 * jf + 4 * lq; float mv[4];
#pragma unroll
            for (int r = 0; r < 4; ++r) { const int j = j0 + r; const float e = fast_exp(fminf(ai_ - acum[j * 8 + hq], 0.f)); mv[r] = j <= il ? cb[jf][r] * e : 0.f; }
            u32x2 o; o.x = pk2(mv[0], mv[1]); o.y = pk2(mv[2], mv[3]); *(LAS u32x2*)(MW + l15 * 136 + j0) = o; }
        BLOCK_SYNC();
        f32x4 yd[4], yo[4];
#pragma unroll
        for (int pf = 0; pf < 4; ++pf) { yd[pf] = (f32x4){0.f, 0.f, 0.f, 0.f}; yo[pf] = (f32x4){0.f, 0.f, 0.f, 0.f}; }
#pragma unroll
        for (int ks = 0; ks < 4; ++ks) { const bf16x8 mfr = *(const LAS bf16x8*)(MW + l15 * 136 + 32 * ks + 8 * lq);
#pragma unroll
            for (int pf = 0; pf < 4; ++pf) { const bf16x8 xfr = *(const LAS bf16x8*)(XdT + (16 * pf + l15) * 136 + 32 * ks + 8 * lq); yd[pf] = MFMA16(xfr, mfr, yd[pf]); } }
#pragma unroll
        for (int ks = 0; ks < 4; ++ks)
#pragma unroll
            for (int pf = 0; pf < 4; ++pf) { const bf16x8 sfr = *(const LAS bf16x8*)(SL + (16 * pf + l15) * 136 + 32 * ks + 8 * lq); yo[pf] = MFMA16(sfr, cfr[ks], yo[pf]); }
        const float ei = expf(ai_), Dh = F.P->in[I_SSMD][h];
#pragma unroll
        for (int pf = 0; pf < 4; ++pf) { const int p0 = 16 * pf + 4 * lq;
            const u32x2 xw = *(const LAS u32x2*)(XN_ + il * 72 + p0); const u32x2 zw = *(const u32x2*)(Zrow + h * 64 + p0);
            const float xv[4] = {bflo(xw.x), bfhi(xw.x), bflo(xw.y), bfhi(xw.y)}, zv[4] = {bflo(zw.x), bfhi(zw.x), bflo(zw.y), bfhi(zw.y)}; float y[4];
#pragma unroll
            for (int r = 0; r < 4; ++r) { y[r] = (yd[pf][r] + ei * yo[pf][r] + Dh * xv[r]) * siluf_(zv[r]); ss += y[r] * y[r]; }
            u32x2 yn; yn.x = pk2(y[0], y[1]); yn.y = pk2(y[2], y[3]);
#pragma unroll
            for (int a = 0; a < 7; ++a) ykeep[a][pf] = ykeep[a + 1][pf];
            ykeep[7][pf] = yn; }
    }
    ss += SHFL_XOR(ss, 16); ss += SHFL_XOR(ss, 32);
    const float rs = fast_rsqrt(ss * (1.f / 512.f) + EPS); const float* nw = F.P->in[I_SSMNW] + g * 512;
#pragma unroll
    for (int hq = 0; hq < 8; ++hq)
#pragma unroll
        for (int pf = 0; pf < 4; ++pf) { const int cidx = hq * 64 + 16 * pf + 4 * lq; const f32x4 wv = *(const f32x4*)(nw + cidx); const u32x2 k = ykeep[hq][pf];
            u32x2 o; o.x = pk2(bflo(k.x) * rs * wv[0], bfhi(k.x) * rs * wv[1]); o.y = pk2(bflo(k.y) * rs * wv[2], bfhi(k.y) * rs * wv[3]);
            if (!F.dry) *(u32x2*)(Zrow + g * 512 + cidx) = o; }
}

DEV void p9_final(Frame& F) {
    const int gw = F.bid * 8 + F.wave, NGW = F.G * 8, lane = F.lane; const float* SS3 = (const float*)F.ws + CW_SS3; const f32x4* wv = (const f32x4*)F.P->in[I_NFIN] + lane;
    for (int m = gw; m < MP + DEC; m += NGW) { const float rs = fast_rsqrt(SS3[m] * (1.f / 1024.f) + EPS); f32x4* x = (f32x4*)(F.out + O_YP + (size_t)m * D) + lane;
#pragma unroll
        for (int j = 0; j < 4; ++j) { const f32x4 ww = wv[64 * j]; f32x4 v = x[64 * j]; v = v * rs; v = v * ww; x[64 * j] = v; } }
}

constexpr int N_PHASES = 10;
#ifndef PH_MASK
#define PH_MASK 0x3ff
#endif
#define PH_ON(k) ((PH_MASK >> (k)) & 1)
DEV void run_phase(const Frame& F0, int ph) {
    if (!((PH_MASK >> ph) & 1)) return;
    Frame F = F0;
    OPAQUE_V(F.tid); OPAQUE_S(F.bid); OPAQUE_S(F.G);
    F.lane = F.tid & 63; F.wave = RFL(F.tid >> 6);
    const int G = F.G, bid = F.bid;
    if (ph == 0) { p0_prep(F); }
    else if (ph == 1) {
        SchedP1 S{(const char*)(F.ws + WS_XN), (const char*)(F.ws + WS_WIN), (const char*)(F.ws + WS_MEMN), (const char*)(F.ws + WS_WKV), G, bid};
        EpiP1 E{F.ws, F.out, F.P->in[I_DTB]};
        { const int hb = G / 2; if (bid >= hb) for (int it = bid - hb; it < IN_TILES * 4; it += G - hb) sk_inproj_item(F, it); }
        BLOCK_SYNC();
        pg8::gemm_phase(F.lds, 1024, S, E);
    } else if (ph == 2) {
        constexpr int N_ATT = BATCH * HEADS * (SEQ / 128), N_ST = BATCH * NCH * 4, N_SATT = DEC * 4, N_SSSD = DEC * 4, N_YA = MP / 4, N_SSC = DEC / 4, N_SST = DEC, N_PST = BATCH;
        constexpr int TOT = N_ATT + N_ST + N_SATT + N_SSSD + N_YA + N_SSC + N_SST + N_PST;
        for (int it = bid; it < TOT; it += G) { int r = it;
            if (r < N_ATT) { if (F.sub & 1) attn_item(F, r); continue; } r -= N_ATT;
            if (r < N_ST) { if (F.sub & 2) ssd_states_item(F, r); continue; } r -= N_ST;
            if (r < N_SATT) { if (F.sub & 4) s_attn_item(F, r); continue; } r -= N_SATT;
            if (r < N_SSSD) { if (F.sub & 8) s_ssd_item(F, r); continue; } r -= N_SSSD;
            if (r < N_YA) { if (F.sub & 16) yain_item(F, r); continue; } r -= N_YA;
            if (r < N_SSC) { if (F.sub & 32) s_sconv_item(F, r); continue; } r -= N_SSC;
            if (r < N_SST) { if (F.sub & 32) s_ssmconv_state_item(F, r); continue; } r -= N_SST;
            if (F.sub & 32) pstate_item(F, r); }
    } else if (ph == 3) { p3_scan(F); }
    else if (ph == 4) { for (int it = bid; it < BATCH * NCH * 4; it += G) ssd_out_item(F, it); }
    else if (ph == 5) {
        SchedP5 S{(const char*)(F.ws + WS_ACAT), (const char*)(F.ws + WS_WCAT), G, bid}; EpiP5 E{F.ws};
        for (int it = bid; it < 16; it += G) sk_merge_item(F, it);
        BLOCK_SYNC();
        pg8::gemm_phase(F.lds, 4096, S, E);
    } else if (ph == 6) {
        SchedPlain S{(const char*)(F.ws + WS_MERGED), (const char*)(F.ws + WS_WMO), MT_P, 4, 16, G, bid, (size_t)1024 * 2}; EpiP6 E{F.ws, F.P->in[I_XP], F.P->in[I_XS]};
        for (int it = bid; it < 16; it += G) sk_mergeo_item(F, it);
        BLOCK_SYNC();
        pg8::gemm_phase(F.lds, 1024, S, E);
    } else if (ph == 7) {
        SchedPlain S{(const char*)(F.ws + WS_XP2B), (const char*)(F.ws + WS_WGU), MT_P, GU_TILES, 16, G, bid, (size_t)1024 * 2}; EpiP7 E{F.ws};
        { const int hb = G / 2; if (bid >= hb) for (int it = bid - hb; it < GU_TILES * 4; it += G - hb) sk_up_item(F, it); }
        BLOCK_SYNC();
        pg8::gemm_phase(F.lds, 1024, S, E);
    } else if (ph == 8) {
        SchedPlain S{(const char*)(F.ws + WS_HID), (const char*)(F.ws + WS_WD), MT_P, 4, FF / 64, G, bid, (size_t)FF * 2}; EpiP8 E{F.ws, F.out};
        for (int it = bid; it < 16; it += G) sk_down_item(F, it);
        BLOCK_SYNC();
        pg8::gemm_phase(F.lds, FF, S, E);
    } else if (ph == 9) { p9_final(F); }
}

#ifndef HOST_EMU
#define XB_TMO      128
#define XB_XCNT(j)  (256  + 64 * (j))
#define XB_XSUB(j)  (1280 + 64 * (j))
#define XB_XGEN(j)  (2304 + 64 * (j))
#define XB_TOP      3328
#define XB_TOPGEN   3392
#define XCD_BAR_WORDS 3456
#define XB_SPIN_CAP (1u << 18)
__device__ __forceinline__ unsigned xb_ld(unsigned* p)              { return __hip_atomic_load(p, __ATOMIC_RELAXED, __HIP_MEMORY_SCOPE_AGENT); }
__device__ __forceinline__ unsigned xb_add(unsigned* p, unsigned v) { return __hip_atomic_fetch_add(p, v, __ATOMIC_RELAXED, __HIP_MEMORY_SCOPE_AGENT); }
__device__ __forceinline__ unsigned xb_xcc_id() { return (unsigned)__builtin_amdgcn_s_getreg((3 << 11) | 20) & 0xFu; }
#define XB_SPIN(cond, bar) do { unsigned _sp = 0; while (cond) { __builtin_amdgcn_s_sleep(1); \
    if ((++_sp & 255u) == 0u) { if (xb_ld(&(bar)[XB_TMO])) break; if (_sp > XB_SPIN_CAP) { atomicAdd(&(bar)[XB_TMO], 1u); break; } } } } while (0)
struct XcdBarrier { unsigned* bar; unsigned x; volatile LAS unsigned* st; };
__device__ __forceinline__ XcdBarrier xcd_barrier_post(unsigned* bar, volatile LAS unsigned* st) {
    XcdBarrier b; b.bar = bar; b.x = xb_xcc_id(); b.st = st;
    if (threadIdx.x == 0) (void)xb_add(&bar[XB_XCNT(b.x)], 1u);
    return b;
}
__device__ __forceinline__ void xcd_barrier_complete(unsigned* bar, unsigned x, unsigned& nloc, unsigned& nx) {
    const unsigned G = gridDim.x * gridDim.y * gridDim.z;
    unsigned sum, cnt, mine, sp = 0u;
    for (;;) {
        sum = 0u; cnt = 0u; mine = 0u;
#pragma unroll
        for (unsigned j = 0; j < 16; ++j) { const unsigned c = xb_ld(&bar[XB_XCNT(j)]); sum += c; cnt += (c > 0u) ? 1u : 0u; mine = (j == x) ? c : mine; }
        if (sum == G) break;
        __builtin_amdgcn_s_sleep(1);
        if ((++sp & 255u) == 0u) { if (xb_ld(&bar[XB_TMO])) break; if (sp > XB_SPIN_CAP) { atomicAdd(&bar[XB_TMO], 1u); break; } }
    }
    nloc = mine > 0u ? mine : 1u; nx = cnt > 0u ? cnt : 1u;
}
__device__ __forceinline__ void xcd_barrier(const XcdBarrier& b) {
    asm volatile("s_waitcnt vmcnt(0)" ::: "memory");
    __syncthreads();
    if (threadIdx.x == 0) {
        unsigned* bar = b.bar;
        __builtin_amdgcn_s_waitcnt(0);
        unsigned nloc = b.st[0], nx = b.st[1];
        if (nloc == 0u) { xcd_barrier_complete(bar, b.x, nloc, nx); b.st[0] = nloc; b.st[1] = nx; }
        const unsigned old = xb_add(&bar[XB_XSUB(b.x)], 1u);
        const unsigned gen = old / nloc;
        if (old + 1u == (gen + 1u) * nloc) {
            __builtin_amdgcn_fence(__ATOMIC_RELEASE, "agent");
            asm volatile("s_waitcnt vmcnt(0)" ::: "memory");
            const unsigned og = xb_add(&bar[XB_TOP], 1u);
            const unsigned tg = og / nx;
            if (og + 1u == (tg + 1u) * nx) xb_add(&bar[XB_TOPGEN], 1u);
            else XB_SPIN(xb_ld(&bar[XB_TOPGEN]) == tg, bar);
            __builtin_amdgcn_fence(__ATOMIC_ACQUIRE, "agent");
            xb_add(&bar[XB_XGEN(b.x)], 1u);
            asm volatile("s_waitcnt vmcnt(0)" ::: "memory");
        } else {
            XB_SPIN(xb_ld(&bar[XB_XGEN(b.x)]) == gen, bar);
            __builtin_amdgcn_fence(__ATOMIC_ACQUIRE, "agent");
            asm volatile("s_waitcnt vmcnt(0)" ::: "memory");
        }
    }
    __syncthreads();
}

__global__ void __launch_bounds__(512, 2) fwd_kernel(Params P) {
    extern __shared__ __attribute__((aligned(16))) unsigned char lds_raw[];
    Frame F;
    F.lds = (LAS unsigned char*)lds_raw; F.ws = P.ws; F.out = P.out; F.P = &P;
    F.tid = threadIdx.x; F.lane = F.tid & 63; F.wave = __builtin_amdgcn_readfirstlane(F.tid >> 6); F.G = gridDim.x; F.bid = blockIdx.x; F.dry = 0; F.sub = 0xff;
    volatile LAS unsigned* MISC = (volatile LAS unsigned*)(F.lds + MISC_OFF);
    for (int u = F.tid; u < (LDS_BYTES - LDSCTL_OFF) / 4; u += 512) ((LAS unsigned*)(F.lds + LDSCTL_OFF))[u] = 0u;
    __syncthreads();
    const bool multi = (P.ph_hi - P.ph_lo) > 1;
    XcdBarrier bar; bar.bar = (unsigned*)(P.ws + WS_CTL) + CW_BAR; bar.x = 0; bar.st = nullptr;
    if (multi) bar = xcd_barrier_post((unsigned*)(P.ws + WS_CTL) + CW_BAR, MISC + 8);
#define RUN_PH(k) if (P.ph_lo <= (k) && (k) < P.ph_hi) { if ((k) == P.dup_ph) { F.dry = 1; F.sub = P.dup_sub; run_phase(F, (k)); xcd_barrier(bar); F.dry = 0; F.sub = 0xff; } run_phase(F, (k)); if ((k) + 1 < P.ph_hi) xcd_barrier(bar); }
    RUN_PH(0) RUN_PH(1) RUN_PH(2) RUN_PH(3) RUN_PH(4) RUN_PH(5) RUN_PH(6) RUN_PH(7) RUN_PH(8) RUN_PH(9)
#undef RUN_PH
}

#ifndef N_LAUNCH_MODE
#define N_LAUNCH_MODE 0
#endif
extern "C" void kernel_launch(void* const* d_in, const int* in_sizes, int n_in, void* d_out, int out_size, void* d_ws, size_t ws_size, hipStream_t stream) {
    static int grid = 0;
    if (grid == 0) {
        if (n_in != 29 || ws_size < WS_END) { fprintf(stderr, "kernel_launch: unexpected shapes (n_in %d out %d ws %zu need %zu)\n", n_in, out_size, ws_size, (size_t)WS_END); grid = -1; return; }
        int dev = 0, cus = 0;
        if (hipGetDevice(&dev) != hipSuccess || hipDeviceGetAttribute(&cus, hipDeviceAttributeMultiprocessorCount, dev) != hipSuccess) { grid = -1; return; }
        if (hipFuncSetAttribute((const void*)fwd_kernel, hipFuncAttributeMaxDynamicSharedMemorySize, LDS_BYTES) != hipSuccess) { fprintf(stderr, "kernel_launch: hipFuncSetAttribute failed\n"); grid = -1; return; }
        (void)hipGetLastError();
        grid = cus;
    }
    if (grid < 0) return;
    (void)hipMemsetAsync((char*)d_ws + WS_CTL, 0, CTL_BYTES, stream);
    Params P{};
    for (int i = 0; i < 29; ++i) P.in[i] = (const float*)d_in[i];
    P.out = (float*)d_out; P.ws = (unsigned char*)d_ws;
#ifndef DUP_PH
#define DUP_PH (-1)
#endif
#ifndef DUP_SUB
#define DUP_SUB 0xff
#endif
    P.dup_ph = DUP_PH; P.dup_sub = DUP_SUB;
#if N_LAUNCH_MODE == 0
    P.ph_lo = 0; P.ph_hi = N_PHASES;
    hipLaunchKernelGGL(fwd_kernel, dim3(grid), dim3(512), LDS_BYTES, stream, P);
#else
    for (int ph = 0; ph < N_PHASES; ++ph) { P.ph_lo = ph; P.ph_hi = ph + 1; hipLaunchKernelGGL(fwd_kernel, dim3(grid), dim3(512), LDS_BYTES, stream, P); }
#endif
}
#endif
```

```cpp
#ifndef HOST_EMU
#include <hip/hip_runtime.h>
#include <cstdio>
#include <cstdint>
#define DEV __device__ __forceinline__
#define DEVM __device__ __forceinline__
#define LAS __attribute__((address_space(3)))
#define GAS __attribute__((address_space(1)))
#endif

#ifndef CFG_BATCH
#define CFG_BATCH 8
#endif
#ifndef CFG_SEQ
#define CFG_SEQ 2048
#endif
#ifndef CFG_DEC
#define CFG_DEC 128
#endif
constexpr int D = 1024, BATCH = CFG_BATCH, SEQ = CFG_SEQ, DEC = CFG_DEC;
constexpr int MP = BATCH * SEQ;
constexpr int M_ALL = MP + 256;
constexpr int MT_ALL = M_ALL / 256, MT_P = MP / 256;
constexpr int MEM = 256, HEADS = 4, HD = 256;
constexpr int NCH = SEQ / 128;
constexpr int SSM_H = 32, SSM_P = 64, SSM_N = 128, SSM_G = 4, DIN = 2048, XBCW = 3072;
constexpr int W_IN_COLS = 12320, IN_TILES = 49, NIN = IN_TILES * 256;
constexpr int FF = 2816, NGU = 2 * FF, GU_TILES = NGU / 256;
constexpr float EPS = 1e-6f;
static_assert(SEQ % 256 == 0 && DEC <= 256 && DEC % 4 == 0, "shape");

constexpr size_t O_YP = 0;
constexpr size_t O_YS = O_YP + (size_t)MP * D;
constexpr size_t O_MK = O_YS + (size_t)DEC * D;
constexpr size_t O_MV = O_MK + (size_t)BATCH * MEM * D;
constexpr size_t O_PCONV = O_MV + (size_t)BATCH * MEM * D;
constexpr size_t O_PSSMC = O_PCONV + (size_t)BATCH * 2 * D;
constexpr size_t O_PSSM = O_PSSMC + (size_t)BATCH * 3 * XBCW;
constexpr size_t O_SCONV = O_PSSM + (size_t)BATCH * SSM_H * SSM_P * SSM_N;
constexpr size_t O_SSSMC = O_SCONV + (size_t)DEC * 2 * D;
constexpr size_t O_SSSM = O_SSSMC + (size_t)DEC * 3 * XBCW;
constexpr size_t O_END = O_SSSM + (size_t)DEC * SSM_H * SSM_P * SSM_N;

constexpr size_t al256(size_t x) { return (x + 255) & ~(size_t)255; }
constexpr size_t WS_CTL = 0, CTL_BYTES = 1u << 20;
constexpr size_t WS_WIN = WS_CTL + CTL_BYTES;
constexpr size_t WS_WKV = WS_WIN + (size_t)NIN * 1024 * 2;
constexpr size_t WS_WCAT = WS_WKV + (size_t)2048 * 1024 * 2;
constexpr size_t WS_WMO = WS_WCAT + (size_t)1024 * 4096 * 2;
constexpr size_t WS_WGU = WS_WMO + (size_t)1024 * 1024 * 2;
constexpr size_t WS_WD = WS_WGU + (size_t)NGU * 1024 * 2;
constexpr size_t WS_XN = WS_WD + (size_t)1024 * FF * 2;
constexpr size_t WS_MEMN = WS_XN + (size_t)M_ALL * 1024 * 2;
constexpr size_t WS_KB = WS_MEMN + (size_t)BATCH * MEM * 1024 * 2;
constexpr size_t WS_VT = WS_KB + (size_t)BATCH * MEM * 1024 * 2;
constexpr size_t WS_DT = WS_VT + (size_t)BATCH * MEM * 1024 * 2;
constexpr size_t WS_CDEC = WS_DT + (size_t)M_ALL * 32 * 4;
constexpr size_t WS_DUMP = al256(WS_CDEC + (size_t)BATCH * NCH * 32 * 4);
constexpr size_t WS_ACAT = WS_DUMP + (size_t)256 * 1024 * 4;
constexpr size_t WS_U = WS_ACAT + (size_t)M_ALL * 4096 * 2;
constexpr size_t WS_XBC = WS_U + (size_t)M_ALL * 1024 * 2;
constexpr size_t WS_G = WS_XBC + (size_t)M_ALL * 3072 * 2;
constexpr size_t WS_CHST = WS_G + (size_t)M_ALL * 3072 * 2;
constexpr size_t WS_END = WS_CHST + (size_t)BATCH * NCH * 32 * 64 * 128 * 2;
constexpr size_t WS_MERGED = WS_XN, WS_HID = WS_ACAT, WS_XP2B = WS_U, WS_MSCR = WS_XBC, WS_XP2 = WS_XBC;
static_assert((size_t)M_ALL * FF * 2 <= (size_t)M_ALL * 4096 * 2 && (size_t)M_ALL * 1024 * 4 <= (size_t)M_ALL * 3072 * 2, "overlays");
constexpr int CW_BAR = 4096;
constexpr int CW_SS2 = 16384;
constexpr int CW_SS3 = CW_SS2 + M_ALL;
static_assert((size_t)(CW_SS3 + M_ALL) * 4 <= CTL_BYTES, "ctl");

constexpr int RING_BYTES = 135168;
constexpr int LDSCTL_OFF = 139264, MISC_OFF = LDSCTL_OFF + 320, LDS_BYTES = 147456;

typedef unsigned short bf16_t;
typedef short bf16x8 __attribute__((ext_vector_type(8)));
typedef float f32x4 __attribute__((ext_vector_type(4)));
typedef float f32x2 __attribute__((ext_vector_type(2)));
typedef unsigned u32x4 __attribute__((ext_vector_type(4)));
typedef unsigned u32x2 __attribute__((ext_vector_type(2)));

#ifndef HOST_EMU
DEV f32x4 MFMA16(bf16x8 a, bf16x8 b, f32x4 c) { return __builtin_amdgcn_mfma_f32_16x16x32_bf16(a, b, c, 0, 0, 0); }
#define GLDS16(g, l) __builtin_amdgcn_global_load_lds((const unsigned*)(g), (LAS unsigned*)(l), 16, 0, 0)
#define SBAR() __builtin_amdgcn_s_barrier()
#define WAIT_V(n) asm volatile("s_waitcnt vmcnt(" #n ")" ::: "memory")
#define WAIT_L(n) asm volatile("s_waitcnt lgkmcnt(" #n ")" ::: "memory")
#define SETPRIO(n) __builtin_amdgcn_s_setprio(n)
#define SCHEDB() __builtin_amdgcn_sched_barrier(0)
#define WAVE_LDS_SYNC() asm volatile("s_waitcnt lgkmcnt(0)" ::: "memory")
#define BLOCK_SYNC() __syncthreads()
typedef short s16x4_t __attribute__((ext_vector_type(4)));
DEV s16x4_t LDS_TR(const LAS unsigned short* p) { return __builtin_amdgcn_ds_read_tr16_b64_v4i16((LAS s16x4_t*)p); }
#define CFENCE() asm volatile("" ::: "memory")
#define OPAQUE_V(x) asm volatile("" : "+v"(x))
#define OPAQUE_S(x) asm volatile("" : "+s"(x))
DEV int RFL(int v) { return __builtin_amdgcn_readfirstlane(v); }
DEV float SHFL_XOR(float v, int m) { return __shfl_xor(v, m); }
DEV float SHFL(float v, int src) { return __shfl(v, src); }
DEV void ATOMIC_ADD_F32(float* p, float v) { atomicAdd(p, v); }
typedef __bf16 bf16x2_t __attribute__((ext_vector_type(2)));
DEV unsigned cvt_pk_bf16(float lo, float hi) { const f32x2 v = {lo, hi}; return __builtin_bit_cast(unsigned, __builtin_convertvector(v, bf16x2_t)); }
DEV float fast_exp(float x) { return __expf(x); }
DEV float fast_rsqrt(float x) { return rsqrtf(x); }
DEV float fast_rcp(float x) { return __builtin_amdgcn_rcpf(x); }
#endif

DEV unsigned f2bf(float f) { unsigned u = __builtin_bit_cast(unsigned, f); return (u + 0x7fffu + ((u >> 16) & 1u)) >> 16; }
DEV unsigned pk2(float lo, float hi) { return cvt_pk_bf16(lo, hi); }
DEV float bflo(unsigned w) { return __builtin_bit_cast(float, w << 16); }
DEV float bfhi(unsigned w) { return __builtin_bit_cast(float, w & 0xffff0000u); }
DEV float bf1(bf16_t b) { return __builtin_bit_cast(float, (unsigned)b << 16); }
DEV float sigmoidf_(float x) { return fast_rcp(1.0f + fast_exp(-x)); }
DEV float siluf_(float x) { return x * fast_rcp(1.0f + fast_exp(-x)); }
DEV float softplusf_(float x) { return x > 20.f ? x : log1pf(expf(x)); }
DEV float wave_sum(float v) {
#pragma unroll
    for (int o = 1; o < 64; o <<= 1) v += SHFL_XOR(v, o);
    return v;
}
DEV u32x4 pack8(const f32x4& a, const f32x4& b) { u32x4 w; w.x = cvt_pk_bf16(a[0], a[1]); w.y = cvt_pk_bf16(a[2], a[3]); w.z = cvt_pk_bf16(b[0], b[1]); w.w = cvt_pk_bf16(b[2], b[3]); return w; }
DEV void unpack8(const u32x4& w, float (&o)[8]) { o[0] = bflo(w.x); o[1] = bfhi(w.x); o[2] = bflo(w.y); o[3] = bfhi(w.y); o[4] = bflo(w.z); o[5] = bfhi(w.z); o[6] = bflo(w.w); o[7] = bfhi(w.w); }

struct Params {
    const float* in[29];
    float* out;
    unsigned char* ws;
    int ph_lo, ph_hi, dup_ph, dup_sub;
};
enum { I_XP = 0, I_XS, I_MEM, I_CK, I_CV, I_SCONV, I_SSMCONV, I_SSM, I_NMIX, I_WIN, I_SCW, I_WSC, I_SSMCW, I_SSMCB, I_DTB, I_ALOG, I_SSMD, I_SSMNW, I_WSSM,
       I_NMEM, I_WMK, I_WMV, I_WAO, I_WMO, I_NFFN, I_WG, I_WU, I_WDN, I_NFIN };

namespace pg8 {
constexpr int BM = 256, BK = 64, HALF = 128, HTB = HALF * BK * 2, STAGE_BYTES = 8 * HTB, NXCD = 8, WGM = 8;
DEV int lds_byte(int r, int c) { const int st = (r >> 4) * 2 + (c >> 5), rr = r & 15, cc = c & 31, ob = rr * 64 + cc * 2; return st * 1024 + (ob ^ (((ob >> 9) & 1) << 5)); }
DEV void stage_rc(int b, int& R, int& C) { const int st = b / 1024, sb = b % 1024, swz = sb ^ (((sb >> 9) & 1) << 5); R = (st >> 1) * 16 + swz / 64; C = (st & 1) * 32 + (swz % 64) / 2; }
DEV int perm32(int rho) { const int n = rho >> 4, i = rho & 15; return 8 * (i >> 2) + 4 * n + (i & 3); }

struct Unit { const char* A; const char* B; int nt, kind, pm, pn; };
DEV void tile_of(int wgid, int nM, int nN, int& pm, int& pn) {
    const int nwg = nM * nN; { const int q = nwg / NXCD, r = nwg % NXCD, xcd = wgid % NXCD, off = wgid / NXCD; wgid = (xcd < r ? xcd * (q + 1) : r * (q + 1) + (xcd - r) * q) + off; }
    const int nig = WGM * nN, gid = wgid / nig, fm = gid * WGM, gsz = (nM - fm) < WGM ? (nM - fm) : WGM;
    pm = fm + ((wgid % nig) % gsz); pn = (wgid % nig) / gsz;
}

template <class Epi, class Sched>
DEV void gemm_phase(LAS unsigned char* lds, const int PITCH, const Sched& S, const Epi& E) {
    const int tid = threadIdx.x, wid = RFL(tid >> 6), lane = tid & 63, wr = wid >> 2, wc = wid & 3, fr = lane & 15, fq = lane >> 4;
    unsigned voffA[2], voffB[2];
#pragma unroll
    for (int i = 0; i < 2; ++i) { int R, C; stage_rc(tid * 16 + i * 8192, R, C); const int Rb = (R & ~31) + perm32(R & 31);
        voffA[i] = (unsigned)(R * PITCH + C) * 2u; voffB[i] = (unsigned)(Rb * PITCH + C) * 2u; }
    const size_t kstep = (size_t)(BK * 2);
    const size_t hstep = (size_t)HALF * PITCH * 2;
    const unsigned ldsw = (unsigned)wid * 1024u;
    const int aoff = lds_byte(wr * 64 + fr, fq * 8), boff = lds_byte(wc * 32 + fr, fq * 8);
#define PG8_SA(b, h) (((b) * 2 + (h)) * HTB)
#define PG8_SB(b, h) ((4 + (b) * 2 + (h)) * HTB)
#define PG8_STAGE(bufoff, gbase, voff) do { _Pragma("unroll") for (int _i = 0; _i < 2; ++_i) \
        GLDS16((const char*)(gbase) + (voff)[_i], lds + (bufoff) + ldsw + _i * 8192); } while (0)
#define PG8_LDA(dst, b, h) do { _Pragma("unroll") for (int m = 0; m < 4; ++m) _Pragma("unroll") for (int k = 0; k < 2; ++k) dst[m][k] = *(const LAS bf16x8*)(lds + PG8_SA(b, h) + aoff + m * 2048 + k * 1024); } while (0)
#define PG8_LDB(dst, b, h) do { _Pragma("unroll") for (int n = 0; n < 2; ++n) _Pragma("unroll") for (int k = 0; k < 2; ++k) dst[n][k] = *(const LAS bf16x8*)(lds + PG8_SB(b, h) + boff + n * 2048 + k * 1024); } while (0)
#define PG8_MMA(ai, bj, At, Bt) do { SETPRIO(1); _Pragma("unroll") for (int m = 0; m < 4; ++m) _Pragma("unroll") for (int n = 0; n < 2; ++n) _Pragma("unroll") for (int k = 0; k < 2; ++k) \
        acc[ai][bj][m][n] = MFMA16(Bt[n][k], At[m][k], acc[ai][bj][m][n]); SETPRIO(0); } while (0)
    Unit cur, nxt; int ui = 0;
    if (!S.next(0, cur)) return;
    f32x4 acc[2][2][4][2];
#pragma unroll
    for (int a = 0; a < 2; ++a)
#pragma unroll
        for (int b = 0; b < 2; ++b)
#pragma unroll
            for (int m = 0; m < 4; ++m)
#pragma unroll
                for (int n = 0; n < 2; ++n) acc[a][b][m][n] = (f32x4){0.f, 0.f, 0.f, 0.f};
    bf16x8 At[4][2], B0[2][2], B1[2][2];
    const char* cA = cur.A; const char* cB = cur.B;
    PG8_STAGE(PG8_SB(0, 0), cB, voffB); PG8_STAGE(PG8_SB(0, 1), cB + hstep, voffB); PG8_STAGE(PG8_SA(0, 0), cA, voffA); PG8_STAGE(PG8_SA(0, 1), cA + hstep, voffA);
    if (wr == 1) SBAR();
    WAIT_V(2); SBAR();
    PG8_STAGE(PG8_SB(1, 0), cB + kstep, voffB); PG8_STAGE(PG8_SA(1, 0), cA + kstep, voffA); PG8_STAGE(PG8_SB(1, 1), cB + hstep + kstep, voffB);
    WAIT_V(6); SBAR();
    for (;;) {
        const bool has_next = S.next(ui + 1, nxt);
        const char* nA = has_next ? nxt.A : cA; const char* nB = has_next ? nxt.B : cB;
        const int nt = cur.nt;
        for (int t = 0; t < nt; t += 2) {
            const bool last = (t == nt - 2);
            const char* a1 = cA + (size_t)(t + 1) * kstep;
            const char* a2 = last ? nA : cA + (size_t)(t + 2) * kstep; const char* b2 = last ? nB : cB + (size_t)(t + 2) * kstep;
            const char* a3 = a2 + kstep; const char* b3 = b2 + kstep;
            PG8_LDB(B0, 0, 0); PG8_LDB(B1, 0, 1); SCHEDB(); PG8_LDA(At, 0, 0); PG8_STAGE(PG8_SA(1, 1), a1 + hstep, voffA);
            WAIT_V(8); WAIT_L(0); SBAR(); PG8_MMA(0, 0, At, B0); PG8_MMA(0, 1, At, B1); SBAR(); SCHEDB();
            PG8_LDA(At, 0, 1); PG8_STAGE(PG8_SB(0, 0), b2, voffB); PG8_STAGE(PG8_SB(0, 1), b2 + hstep, voffB); PG8_STAGE(PG8_SA(0, 0), a2, voffA);
            WAIT_V(8); WAIT_L(0); SBAR(); PG8_MMA(1, 0, At, B0); PG8_MMA(1, 1, At, B1); SBAR(); SCHEDB();
            PG8_LDB(B0, 1, 0); PG8_LDB(B1, 1, 1); SCHEDB(); PG8_LDA(At, 1, 0); PG8_STAGE(PG8_SA(0, 1), a2 + hstep, voffA);
            WAIT_V(8); WAIT_L(0); SBAR(); PG8_MMA(0, 0, At, B0); PG8_MMA(0, 1, At, B1); SBAR(); SCHEDB();
            PG8_LDA(At, 1, 1); PG8_STAGE(PG8_SB(1, 0), b3, voffB); PG8_STAGE(PG8_SB(1, 1), b3 + hstep, voffB); PG8_STAGE(PG8_SA(1, 0), a3, voffA);
            WAIT_V(8); WAIT_L(0); SBAR(); PG8_MMA(1, 0, At, B0); PG8_MMA(1, 1, At, B1); SBAR(); SCHEDB();
        }
        if (wr == 0) SBAR();
        { int fr_ = fr, fq_ = fq; OPAQUE_V(fr_); OPAQUE_V(fq_); E(acc, cur, wr, wc, fr_, fq_); }
        if (!has_next) break;
#pragma unroll
        for (int a = 0; a < 2; ++a)
#pragma unroll
            for (int b = 0; b < 2; ++b)
#pragma unroll
                for (int m = 0; m < 4; ++m)
#pragma unroll
                    for (int n = 0; n < 2; ++n) acc[a][b][m][n] = (f32x4){0.f, 0.f, 0.f, 0.f};
        cur = nxt; cA = nA; cB = nB; ++ui;
        if (wr == 1) SBAR();
    }
    WAIT_V(0);
    SBAR();
#undef PG8_SA
#undef PG8_SB
#undef PG8_STAGE
#undef PG8_LDA
#undef PG8_LDB
#undef PG8_MMA
}
}
using pg8::Unit;

struct Frame {
    LAS unsigned char* lds;
    unsigned char* ws;
    const Params* P;
    float* out;
    int tid, lane, wave, G, bid;
    int dry, sub;
};
#define WSP(T, off) ((T*)(F.ws + (off)))

DEV void transpose_item(const float* W, int src_pitch, int k0, int n0, bf16_t* WT, size_t dst_pitch, int dst_row0, int dst_k, const float* kscale, LAS float* scr, int lane) {
#pragma unroll 8
    for (int i = 0; i < 32; ++i) { const int kk = 2 * i + (lane >> 5); float v = W[(size_t)(k0 + kk) * src_pitch + n0 + (lane & 31)]; if (kscale) v *= kscale[k0 + kk]; scr[kk * 33 + (lane & 31)] = v; }
    WAVE_LDS_SYNC();
    const int c = lane & 7;
#pragma unroll
    for (int j = 0; j < 4; ++j) { const int n = (lane >> 3) + 8 * j; const LAS float* s = scr + (8 * c) * 33 + n;
        u32x4 o; o.x = pk2(s[0 * 33], s[1 * 33]); o.y = pk2(s[2 * 33], s[3 * 33]); o.z = pk2(s[4 * 33], s[5 * 33]); o.w = pk2(s[6 * 33], s[7 * 33]);
        *(u32x4*)(WT + (size_t)(dst_row0 + n) * dst_pitch + dst_k + 8 * c) = o; }
    WAVE_LDS_SYNC();
}
DEV int win_dst_row(int c) {
    if (c < 1024) return c;
    if (c < 2048) { const int j = (c - 1024) >> 7; return 1024 + 256 * j + ((c - 1024) & 127); }
    if (c < 3072) { const int j = (c - 2048) >> 7; return 1024 + 256 * j + 128 + ((c - 2048) & 127); }
    if (c < 8192) return c;
    if (c < 8224) return 12288 + (c - 8192);
    return c - 32;
}
DEV void rms_row_bf16(const float* xrow, const float* w, bf16_t* orow, int lane) {
    const f32x4* xr = (const f32x4*)xrow + lane; const f32x4* wr_ = (const f32x4*)w + lane;
    f32x4 v[4]; float s = 0.f;
#pragma unroll
    for (int j = 0; j < 4; ++j) { v[j] = xr[64 * j]; s += (v[j][0] * v[j][0] + v[j][1] * v[j][1]) + (v[j][2] * v[j][2] + v[j][3] * v[j][3]); }
    const float rs = fast_rsqrt(wave_sum(s) * (1.f / 1024.f) + EPS);
    u32x2* o8 = (u32x2*)orow + lane;
#pragma unroll
    for (int j = 0; j < 4; ++j) { const f32x4 ww = wr_[64 * j]; u32x2 o; o.x = pk2(v[j][0] * rs * ww[0], v[j][1] * rs * ww[1]); o.y = pk2(v[j][2] * rs * ww[2], v[j][3] * rs * ww[3]); o8[64 * j] = o; }
}
DEV void p0_prep(Frame& F) {
    LAS float* scr = (LAS float*)(F.lds + F.wave * 16384);
    const int gw = F.bid * 8 + F.wave, NGW = F.G * 8, lane = F.lane;
    bf16_t* WIN = WSP(bf16_t, WS_WIN); bf16_t* WKV = WSP(bf16_t, WS_WKV); bf16_t* WCAT = WSP(bf16_t, WS_WCAT); bf16_t* WMO = WSP(bf16_t, WS_WMO);
    bf16_t* WGU = WSP(bf16_t, WS_WGU); bf16_t* WD = WSP(bf16_t, WS_WD);
    constexpr int I0 = 16 * (W_IN_COLS / 32), I1 = 16 * 32, I4 = 32 * 32, I7 = 16 * (FF / 32), I9 = (FF / 64) * 32;
    constexpr int NITEMS = I0 + 2 * I1 + I1 + I4 + I1 + I1 + 2 * I7 + I9;
    for (int it = gw; it < NITEMS; it += NGW) {
        int r = it;
        if (r < I0) { const int nb = W_IN_COLS / 32, kb = r / nb, n0 = 32 * (r % nb); transpose_item(F.P->in[I_WIN], W_IN_COLS, 64 * kb, n0, WIN, 1024, win_dst_row(n0), 64 * kb, nullptr, scr, lane); continue; } r -= I0;
        if (r < I1) { const int kb = r / 32, n0 = 32 * (r % 32); transpose_item(F.P->in[I_WMK], 1024, 64 * kb, n0, WKV, 1024, n0, 64 * kb, nullptr, scr, lane); continue; } r -= I1;
        if (r < I1) { const int kb = r / 32, n0 = 32 * (r % 32); transpose_item(F.P->in[I_WMV], 1024, 64 * kb, n0, WKV, 1024, 1024 + n0, 64 * kb, nullptr, scr, lane); continue; } r -= I1;
        if (r < I1) { const int kb = r / 32, n0 = 32 * (r % 32); transpose_item(F.P->in[I_WSC], 1024, 64 * kb, n0, WCAT, 4096, n0, 64 * kb, nullptr, scr, lane); continue; } r -= I1;
        if (r < I4) { const int kb = r / 32, n0 = 32 * (r % 32); transpose_item(F.P->in[I_WSSM], 1024, 64 * kb, n0, WCAT, 4096, n0, 1024 + 64 * kb, nullptr, scr, lane); continue; } r -= I4;
        if (r < I1) { const int kb = r / 32, n0 = 32 * (r % 32); transpose_item(F.P->in[I_WAO], 1024, 64 * kb, n0, WCAT, 4096, n0, 3072 + 64 * kb, nullptr, scr, lane); continue; } r -= I1;
        if (r < I1) { const int kb = r / 32, n0 = 32 * (r % 32); transpose_item(F.P->in[I_WMO], 1024, 64 * kb, n0, WMO, 1024, n0, 64 * kb, nullptr, scr, lane); continue; } r -= I1;
        if (r < I7) { const int nb = FF / 32, kb = r / nb, n0 = 32 * (r % nb); transpose_item(F.P->in[I_WG], FF, 64 * kb, n0, WGU, 1024, 256 * (n0 >> 7) + (n0 & 127), 64 * kb, F.P->in[I_NFFN], scr, lane); continue; } r -= I7;
        if (r < I7) { const int nb = FF / 32, kb = r / nb, n0 = 32 * (r % nb); transpose_item(F.P->in[I_WU], FF, 64 * kb, n0, WGU, 1024, 256 * (n0 >> 7) + 128 + (n0 & 127), 64 * kb, F.P->in[I_NFFN], scr, lane); continue; } r -= I7;
        { const int kb = r / 32, n0 = 32 * (r % 32); transpose_item(F.P->in[I_WDN], 1024, 64 * kb, n0, WD, FF, n0, 64 * kb, nullptr, scr, lane); }
    }
    { u32x4* z = (u32x4*)(WIN + (size_t)12320 * 1024); const int nz = (NIN - 12320) * 1024 / 8;
      for (int i = F.bid * 512 + F.tid; i < nz; i += F.G * 512) z[i] = (u32x4){0u, 0u, 0u, 0u}; }
    bf16_t* XN = WSP(bf16_t, WS_XN); bf16_t* MEMN = WSP(bf16_t, WS_MEMN);
    for (int m = gw; m < M_ALL; m += NGW) {
        if (m < MP) rms_row_bf16(F.P->in[I_XP] + (size_t)m * D, F.P->in[I_NMIX], XN + (size_t)m * D, lane);
        else if (m < MP + DEC) rms_row_bf16(F.P->in[I_XS] + (size_t)(m - MP) * D, F.P->in[I_NMIX], XN + (size_t)m * D, lane);
        else { u32x4* z = (u32x4*)(XN + (size_t)m * D); z[lane] = (u32x4){0u, 0u, 0u, 0u}; z[lane + 64] = (u32x4){0u, 0u, 0u, 0u}; }
    }
    for (int m = gw; m < BATCH * MEM; m += NGW) rms_row_bf16(F.P->in[I_MEM] + (size_t)m * D, F.P->in[I_NMEM], MEMN + (size_t)m * D, lane);
}

struct SchedP1 {
    const char* XN; const char* WIN; const char* MEMN; const char* WKV; int G, c;
    DEVM bool next(int i, Unit& u) const {
        const int n1 = MT_P * IN_TILES, n2 = BATCH * 8; const long L = (long)i * G + c;
        if (L >= n1 + n2) return false;
        u.nt = 16;
        if (L < n1) { pg8::tile_of((int)L, MT_P, IN_TILES, u.pm, u.pn); u.kind = 0; u.A = XN + (size_t)u.pm * 256 * 1024 * 2; u.B = WIN + (size_t)u.pn * 256 * 1024 * 2; }
        else { pg8::tile_of((int)(L - n1), BATCH, 8, u.pm, u.pn); u.kind = 1; u.A = MEMN + (size_t)u.pm * 256 * 1024 * 2; u.B = WKV + (size_t)u.pn * 256 * 1024 * 2; }
        return true;
    }
};
struct EpiP1 {
    unsigned char* ws; float* out; const float* dtb;
    DEVM void operator()(const f32x4 (&acc)[2][2][4][2], const Unit& u, int wr, int wc, int fr, int fq) const {
        const int cb = wc * 32 + 8 * fq;
        if (u.kind == 1) {
            const int b = u.pm, h = u.pn & 3; const bool isv = u.pn >= 4;
            float* of = out + (isv ? O_MV : O_MK); bf16_t* KB = (bf16_t*)(ws + WS_KB); bf16_t* VT = (bf16_t*)(ws + WS_VT);
#pragma unroll
            for (int ai = 0; ai < 2; ++ai)
#pragma unroll
                for (int m = 0; m < 4; ++m) { const int key = ai * 128 + wr * 64 + m * 16 + fr;
#pragma unroll
                    for (int bj = 0; bj < 2; ++bj) { const int d = bj * 128 + cb; const f32x4 v0 = acc[ai][bj][m][0], v1 = acc[ai][bj][m][1];
                        float* o = of + ((size_t)(b * MEM + key) * HEADS + h) * HD + d; *(f32x4*)o = v0; *(f32x4*)(o + 4) = v1;
                        if (!isv) *(u32x4*)(KB + ((size_t)(b * HEADS + h) * MEM + key) * HD + d) = pack8(v0, v1);
                        else { bf16_t* vt = VT + ((size_t)(b * HEADS + h) * HD + d) * MEM + key;
#pragma unroll
                            for (int e = 0; e < 4; ++e) { vt[(size_t)e * MEM] = (bf16_t)f2bf(v0[e]); vt[(size_t)(e + 4) * MEM] = (bf16_t)f2bf(v1[e]); } } }
                    CFENCE(); }
            return;
        }
        const int pn = u.pn, row0 = u.pm * 256 + wr * 64 + fr;
        if (pn < 4 || (pn >= 12 && pn < 20) || (pn >= 32 && pn < 36)) {
            const int coff = pn < 4 ? pn * 256 : (pn < 20 ? 1024 + (pn - 12) * 256 : 3072 + (pn - 32) * 256);
            bf16_t* O = (bf16_t*)(ws + WS_ACAT);
#pragma unroll
            for (int ai = 0; ai < 2; ++ai)
#pragma unroll
                for (int m = 0; m < 4; ++m) { bf16_t* rp = O + (size_t)(row0 + ai * 128 + m * 16) * 4096 + coff + cb;
#pragma unroll
                    for (int bj = 0; bj < 2; ++bj) *(u32x4*)(rp + bj * 128) = pack8(acc[ai][bj][m][0], acc[ai][bj][m][1]);
                    CFENCE(); }
        } else if (pn < 12) {
            bf16_t* O = (bf16_t*)(ws + WS_U); const int j = pn - 4;
#pragma unroll
            for (int ai = 0; ai < 2; ++ai)
#pragma unroll
                for (int m = 0; m < 4; ++m) *(u32x4*)(O + (size_t)(row0 + ai * 128 + m * 16) * 1024 + 128 * j + cb) = pack8(acc[ai][0][m][0] * acc[ai][1][m][0], acc[ai][0][m][1] * acc[ai][1][m][1]);
        } else if (pn < 32) {
            bf16_t* O = (bf16_t*)(ws + WS_XBC);
#pragma unroll
            for (int ai = 0; ai < 2; ++ai)
#pragma unroll
                for (int m = 0; m < 4; ++m) { bf16_t* rp = O + (size_t)(row0 + ai * 128 + m * 16) * XBCW + (pn - 20) * 256 + cb;
#pragma unroll
                    for (int bj = 0; bj < 2; ++bj) *(u32x4*)(rp + bj * 128) = pack8(acc[ai][bj][m][0], acc[ai][bj][m][1]);
                    CFENCE(); }
        } else if (pn < 48) {
            bf16_t* O = (bf16_t*)(ws + WS_G);
#pragma unroll
            for (int ai = 0; ai < 2; ++ai)
#pragma unroll
                for (int m = 0; m < 4; ++m) { bf16_t* rp = O + (size_t)(row0 + ai * 128 + m * 16) * 3072 + (pn - 36) * 256 + cb;
#pragma unroll
                    for (int bj = 0; bj < 2; ++bj) { f32x4 v0 = acc[ai][bj][m][0], v1 = acc[ai][bj][m][1];
#pragma unroll
                        for (int e = 0; e < 4; ++e) { v0[e] = sigmoidf_(v0[e]); v1[e] = sigmoidf_(v1[e]); }
                        *(u32x4*)(rp + bj * 128) = pack8(v0, v1); }
                    CFENCE(); }
        } else {
            if (wc == 0) { float* O = (float*)(ws + WS_DT); const f32x4 b0 = *(const f32x4*)(dtb + cb), b1 = *(const f32x4*)(dtb + cb + 4);
#pragma unroll
                for (int ai = 0; ai < 2; ++ai)
#pragma unroll
                    for (int m = 0; m < 4; ++m) { f32x4 v0 = acc[ai][0][m][0] + b0, v1 = acc[ai][0][m][1] + b1;
#pragma unroll
                        for (int e = 0; e < 4; ++e) { v0[e] = softplusf_(v0[e]); v1[e] = softplusf_(v1[e]); }
                        float* o = O + (size_t)(row0 + ai * 128 + m * 16) * 32 + cb; *(f32x4*)o = v0; *(f32x4*)(o + 4) = v1; CFENCE(); } }
        }
    }
};
struct SchedP5 {
    const char* ACAT; const char* WCAT; int G, c;
    DEVM bool next(int i, Unit& u) const {
        const int su = i / 3, seg = i - 3 * su; const long L = (long)su * G + c;
        if (L >= MT_P * 4) return false;
        pg8::tile_of((int)L, MT_P, 4, u.pm, u.pn); u.kind = seg; u.nt = seg == 1 ? 32 : 16;
        const size_t koff = (seg == 0 ? 0 : (seg == 1 ? 1024 : 3072)) * 2;
        u.A = ACAT + (size_t)u.pm * 256 * 4096 * 2 + koff; u.B = WCAT + (size_t)u.pn * 256 * 4096 * 2 + koff; return true;
    }
};
struct EpiP5 {
    unsigned char* ws;
    DEVM void operator()(const f32x4 (&acc)[2][2][4][2], const Unit& u, int wr, int wc, int fr, int fq) const {
        const int row0 = u.pm * 256 + wr * 64 + fr, col0 = u.pn * 256 + wc * 32 + 8 * fq, seg = u.kind;
        const bf16_t* Gt = (const bf16_t*)(ws + WS_G) + seg * 1024; float* SC = (float*)(ws + WS_MSCR); bf16_t* MG = (bf16_t*)(ws + WS_MERGED);
#pragma unroll
        for (int ai = 0; ai < 2; ++ai)
#pragma unroll
            for (int m = 0; m < 4; ++m) { const size_t row = (size_t)(row0 + ai * 128 + m * 16);
#pragma unroll
                for (int bj = 0; bj < 2; ++bj) { const int col = col0 + bj * 128; float g[8]; unpack8(*(const u32x4*)(Gt + row * 3072 + col), g);
                    f32x4 v0 = acc[ai][bj][m][0], v1 = acc[ai][bj][m][1];
#pragma unroll
                    for (int e = 0; e < 4; ++e) { v0[e] *= g[e]; v1[e] *= g[4 + e]; }
                    float* sp = SC + row * 1024 + col;
                    if (seg > 0) { v0 += *(const f32x4*)sp; v1 += *(const f32x4*)(sp + 4); }
                    if (seg < 2) { *(f32x4*)sp = v0; *(f32x4*)(sp + 4) = v1; }
                    else *(u32x4*)(MG + row * 1024 + col) = pack8(v0, v1); } }
    }
};
struct SchedPlain {
    const char* A; const char* B; int nM, nN, nt, G, c; size_t pitchB;
    DEVM bool next(int i, Unit& u) const {
        const long L = (long)i * G + c; if (L >= nM * nN) return false;
        pg8::tile_of((int)L, nM, nN, u.pm, u.pn); u.kind = 0; u.nt = nt; u.A = A + (size_t)u.pm * 256 * pitchB; u.B = B + (size_t)u.pn * 256 * pitchB; return true;
    }
};
struct EpiP6 {
    unsigned char* ws; const float* xp; const float* xs;
    DEVM void operator()(const f32x4 (&acc)[2][2][4][2], const Unit& u, int wr, int wc, int fr, int fq) const {
        const int row0 = u.pm * 256 + wr * 64 + fr, col0 = u.pn * 256 + wc * 32 + 8 * fq;
        float* X2 = (float*)(ws + WS_XP2); bf16_t* X2B = (bf16_t*)(ws + WS_XP2B); float* SS = (float*)ws + CW_SS2;
#pragma unroll
        for (int ai = 0; ai < 2; ++ai)
#pragma unroll
            for (int m = 0; m < 4; ++m) { const int row = row0 + ai * 128 + m * 16; float s = 0.f;
                const float* xr = row < MP ? xp + (size_t)row * D : (row < MP + DEC ? xs + (size_t)(row - MP) * D : nullptr);
#pragma unroll
                for (int bj = 0; bj < 2; ++bj) { const int col = col0 + bj * 128; f32x4 v0 = acc[ai][bj][m][0], v1 = acc[ai][bj][m][1];
                    if (xr) { v0 += *(const f32x4*)(xr + col); v1 += *(const f32x4*)(xr + col + 4); }
                    s += (v0[0] * v0[0] + v0[1] * v0[1]) + (v0[2] * v0[2] + v0[3] * v0[3]) + (v1[0] * v1[0] + v1[1] * v1[1]) + (v1[2] * v1[2] + v1[3] * v1[3]);
                    float* o = X2 + (size_t)row * 1024 + col; *(f32x4*)o = v0; *(f32x4*)(o + 4) = v1;
                    *(u32x4*)(X2B + (size_t)row * 1024 + col) = pack8(v0, v1); }
                s += SHFL_XOR(s, 16); s += SHFL_XOR(s, 32);
                if (fq == 0) ATOMIC_ADD_F32(SS + row, s); }
    }
};
struct EpiP7 {
    unsigned char* ws;
    DEVM void operator()(const f32x4 (&acc)[2][2][4][2], const Unit& u, int wr, int wc, int fr, int fq) const {
        const int row0 = u.pm * 256 + wr * 64 + fr, col0 = u.pn * 128 + wc * 32 + 8 * fq;
        const float* SS2 = (const float*)ws + CW_SS2; bf16_t* H = (bf16_t*)(ws + WS_HID);
#pragma unroll
        for (int ai = 0; ai < 2; ++ai)
#pragma unroll
            for (int m = 0; m < 4; ++m) { const int row = row0 + ai * 128 + m * 16; const float rs = fast_rsqrt(SS2[row] * (1.f / 1024.f) + EPS);
                f32x4 h0, h1;
#pragma unroll
                for (int e = 0; e < 4; ++e) { h0[e] = siluf_(rs * acc[ai][0][m][0][e]) * (rs * acc[ai][1][m][0][e]); h1[e] = siluf_(rs * acc[ai][0][m][1][e]) * (rs * acc[ai][1][m][1][e]); }
                *(u32x4*)(H + (size_t)row * FF + col0) = pack8(h0, h1); }
    }
};
struct EpiP8 {
    unsigned char* ws; float* out;
    DEVM void operator()(const f32x4 (&acc)[2][2][4][2], const Unit& u, int wr, int wc, int fr, int fq) const {
        const int row0 = u.pm * 256 + wr * 64 + fr, col0 = u.pn * 256 + wc * 32 + 8 * fq;
        const float* X2 = (const float*)(ws + WS_XP2); float* SS = (float*)ws + CW_SS3;
#pragma unroll
        for (int ai = 0; ai < 2; ++ai)
#pragma unroll
            for (int m = 0; m < 4; ++m) { const int row = row0 + ai * 128 + m * 16; float s = 0.f;
                float* orow = row < MP + DEC ? out + O_YP + (size_t)row * D : (float*)(ws + WS_DUMP) + (size_t)(row - MP) * D;
#pragma unroll
                for (int bj = 0; bj < 2; ++bj) { const int col = col0 + bj * 128; const float* x = X2 + (size_t)row * 1024 + col;
                    const f32x4 v0 = acc[ai][bj][m][0] + *(const f32x4*)x, v1 = acc[ai][bj][m][1] + *(const f32x4*)(x + 4);
                    s += (v0[0] * v0[0] + v0[1] * v0[1]) + (v0[2] * v0[2] + v0[3] * v0[3]) + (v1[0] * v1[0] + v1[1] * v1[1]) + (v1[2] * v1[2] + v1[3] * v1[3]);
                    *(f32x4*)(orow + col) = v0; *(f32x4*)(orow + col + 4) = v1; }
                s += SHFL_XOR(s, 16); s += SHFL_XOR(s, 32);
                if (fq == 0) ATOMIC_ADD_F32(SS + row, s); }
    }
};


DEV void skinny_core(Frame& F, const bf16_t* A, size_t lda, const bf16_t* B, size_t ldb, int K, f32x4 (&acc)[2][2]) {
    const int tid = F.tid, w = F.wave, l15 = F.lane & 15, lq = F.lane >> 4;
    LAS bf16_t* BL = (LAS bf16_t*)F.lds;
    const bf16_t* ap = A + (size_t)(16 * w + l15) * lda + 8 * lq;
    const int r0 = tid >> 5, ch = tid & 31;
    const bf16_t* bp = B + (size_t)((r0 & 31) + (r0 >> 5) * 128) * ldb + 8 * ch;
    u32x4 st[4];
#pragma unroll
    for (int hf = 0; hf < 2; ++hf)
#pragma unroll
        for (int nf = 0; nf < 2; ++nf) acc[hf][nf] = (f32x4){0.f, 0.f, 0.f, 0.f};
    BLOCK_SYNC();
#pragma unroll
    for (int i = 0; i < 4; ++i) { const int r = r0 + 16 * i; st[i] = *(const u32x4*)(B + (size_t)((r & 31) + (r >> 5) * 128) * ldb + 8 * ch); }
#pragma unroll
    for (int i = 0; i < 4; ++i) *(LAS u32x4*)(BL + (r0 + 16 * i) * 264 + 8 * ch) = st[i];
    int cur = 0;
#pragma unroll 1
    for (int k0 = 0; k0 < K; k0 += 256) { bf16x8 a[8];
#pragma unroll
        for (int u = 0; u < 8; ++u) a[u] = *(const bf16x8*)(ap + k0 + 32 * u);
        const bool more = k0 + 256 < K;
        if (more) {
#pragma unroll
            for (int i = 0; i < 4; ++i) { const int r = r0 + 16 * i; st[i] = *(const u32x4*)(B + (size_t)((r & 31) + (r >> 5) * 128) * ldb + k0 + 256 + 8 * ch); } }
        BLOCK_SYNC();
        const LAS bf16_t* bl = BL + cur * (64 * 264);
#pragma unroll
        for (int u = 0; u < 8; ++u)
#pragma unroll
            for (int hf = 0; hf < 2; ++hf)
#pragma unroll
                for (int nf = 0; nf < 2; ++nf) { const bf16x8 x = *(const LAS bf16x8*)(bl + (32 * hf + 16 * nf + l15) * 264 + 32 * u + 8 * lq); acc[hf][nf] = MFMA16(x, a[u], acc[hf][nf]); }
        if (more) {
#pragma unroll
            for (int i = 0; i < 4; ++i) *(LAS u32x4*)(BL + (cur ^ 1) * (64 * 264) + (r0 + 16 * i) * 264 + 8 * ch) = st[i]; }
        cur ^= 1; }
    (void)bp;
}
DEV u32x2 pack4(const f32x4& v) { u32x2 o; o.x = cvt_pk_bf16(v[0], v[1]); o.y = cvt_pk_bf16(v[2], v[3]); return o; }
DEV void sk_inproj_item(Frame& F, int item) {
    const int pn = item >> 2, cg = item & 3, w = F.wave, l15 = F.lane & 15, lq = F.lane >> 4, row = MP + 16 * w + l15;
    f32x4 acc[2][2];
    skinny_core(F, WSP(const bf16_t, WS_XN) + (size_t)MP * 1024, 1024, WSP(const bf16_t, WS_WIN) + (size_t)(pn * 256 + 32 * cg) * 1024, 1024, 1024, acc);
#pragma unroll
    for (int nf = 0; nf < 2; ++nf) { const int cb = 32 * cg + 16 * nf + 4 * lq; f32x4 v0 = acc[0][nf], v1 = acc[1][nf];
        if (pn < 4 || (pn >= 12 && pn < 20) || (pn >= 32 && pn < 36)) { const int coff = pn < 4 ? pn * 256 : (pn < 20 ? 1024 + (pn - 12) * 256 : 3072 + (pn - 32) * 256);
            bf16_t* o = WSP(bf16_t, WS_ACAT) + (size_t)row * 4096 + coff + cb; *(u32x2*)o = pack4(v0); *(u32x2*)(o + 128) = pack4(v1); }
        else if (pn < 12) { *(u32x2*)(WSP(bf16_t, WS_U) + (size_t)row * 1024 + 128 * (pn - 4) + cb) = pack4(v0 * v1); }
        else if (pn < 32) { bf16_t* o = WSP(bf16_t, WS_XBC) + (size_t)row * XBCW + (pn - 20) * 256 + cb; *(u32x2*)o = pack4(v0); *(u32x2*)(o + 128) = pack4(v1); }
        else if (pn < 48) {
#pragma unroll
            for (int e = 0; e < 4; ++e) { v0[e] = sigmoidf_(v0[e]); v1[e] = sigmoidf_(v1[e]); }
            bf16_t* o = WSP(bf16_t, WS_G) + (size_t)row * 3072 + (pn - 36) * 256 + cb; *(u32x2*)o = pack4(v0); *(u32x2*)(o + 128) = pack4(v1); }
        else if (cg == 0) { const f32x4 b = *(const f32x4*)(F.P->in[I_DTB] + cb); f32x4 d;
#pragma unroll
            for (int e = 0; e < 4; ++e) d[e] = softplusf_(v0[e] + b[e]);
            *(f32x4*)(WSP(float, WS_DT) + (size_t)row * 32 + cb) = d; } }
}
DEV void sk_merge_item(Frame& F, int item) {
    const int pn = item >> 2, cg = item & 3, w = F.wave, l15 = F.lane & 15, lq = F.lane >> 4, row = MP + 16 * w + l15;
    const bf16_t* A = WSP(const bf16_t, WS_ACAT) + (size_t)MP * 4096; const bf16_t* W = WSP(const bf16_t, WS_WCAT) + (size_t)(pn * 256 + 32 * cg) * 4096;
    f32x4 m[2][2];
#pragma unroll
    for (int hf = 0; hf < 2; ++hf)
#pragma unroll
        for (int nf = 0; nf < 2; ++nf) m[hf][nf] = (f32x4){0.f, 0.f, 0.f, 0.f};
#pragma unroll 1
    for (int seg = 0; seg < 3; ++seg) { const int koff = seg == 0 ? 0 : (seg == 1 ? 1024 : 3072), K = seg == 1 ? 2048 : 1024;
        f32x4 acc[2][2];
        skinny_core(F, A + koff, 4096, W + koff, 4096, K, acc);
#pragma unroll
        for (int hf = 0; hf < 2; ++hf)
#pragma unroll
            for (int nf = 0; nf < 2; ++nf) { const u32x2 g = *(const u32x2*)(WSP(const bf16_t, WS_G) + (size_t)row * 3072 + seg * 1024 + pn * 256 + 128 * hf + 32 * cg + 16 * nf + 4 * lq);
                m[hf][nf][0] += bflo(g.x) * acc[hf][nf][0]; m[hf][nf][1] += bfhi(g.x) * acc[hf][nf][1]; m[hf][nf][2] += bflo(g.y) * acc[hf][nf][2]; m[hf][nf][3] += bfhi(g.y) * acc[hf][nf][3]; } }
#pragma unroll
    for (int hf = 0; hf < 2; ++hf)
#pragma unroll
        for (int nf = 0; nf < 2; ++nf) *(u32x2*)(WSP(bf16_t, WS_MERGED) + (size_t)row * 1024 + pn * 256 + 128 * hf + 32 * cg + 16 * nf + 4 * lq) = pack4(m[hf][nf]);
}
DEV void sk_mergeo_item(Frame& F, int item) {
    const int pn = item >> 2, cg = item & 3, w = F.wave, l15 = F.lane & 15, lq = F.lane >> 4, s = 16 * w + l15, row = MP + s;
    f32x4 acc[2][2];
    skinny_core(F, WSP(const bf16_t, WS_MERGED) + (size_t)MP * 1024, 1024, WSP(const bf16_t, WS_WMO) + (size_t)(pn * 256 + 32 * cg) * 1024, 1024, 1024, acc);
    float ss = 0.f;
#pragma unroll
    for (int hf = 0; hf < 2; ++hf)
#pragma unroll
        for (int nf = 0; nf < 2; ++nf) { const int col = pn * 256 + 128 * hf + 32 * cg + 16 * nf + 4 * lq; f32x4 v = acc[hf][nf];
            if (s < DEC) v += *(const f32x4*)(F.P->in[I_XS] + (size_t)s * D + col);
            *(f32x4*)(WSP(float, WS_XP2) + (size_t)row * 1024 + col) = v; *(u32x2*)(WSP(bf16_t, WS_XP2B) + (size_t)row * 1024 + col) = pack4(v);
            ss += (v[0] * v[0] + v[1] * v[1]) + (v[2] * v[2] + v[3] * v[3]); }
    ss += SHFL_XOR(ss, 16); ss += SHFL_XOR(ss, 32);
    if (lq == 0) ATOMIC_ADD_F32((float*)F.ws + CW_SS2 + row, ss);
}
DEV void sk_up_item(Frame& F, int item) {
    const int pn = item >> 2, cg = item & 3, w = F.wave, l15 = F.lane & 15, lq = F.lane >> 4, row = MP + 16 * w + l15;
    f32x4 acc[2][2];
    skinny_core(F, WSP(const bf16_t, WS_XP2B) + (size_t)MP * 1024, 1024, WSP(const bf16_t, WS_WGU) + (size_t)(pn * 256 + 32 * cg) * 1024, 1024, 1024, acc);
    const float rs = fast_rsqrt(((const float*)F.ws)[CW_SS2 + row] * (1.f / 1024.f) + EPS);
#pragma unroll
    for (int nf = 0; nf < 2; ++nf) { f32x4 h;
#pragma unroll
        for (int e = 0; e < 4; ++e) h[e] = siluf_(rs * acc[0][nf][e]) * (rs * acc[1][nf][e]);
        *(u32x2*)(WSP(bf16_t, WS_HID) + (size_t)row * FF + pn * 128 + 32 * cg + 16 * nf + 4 * lq) = pack4(h); }
}
DEV void sk_down_item(Frame& F, int item) {
    const int pn = item >> 2, cg = item & 3, w = F.wave, l15 = F.lane & 15, lq = F.lane >> 4, s = 16 * w + l15, row = MP + s;
    f32x4 acc[2][2];
    skinny_core(F, WSP(const bf16_t, WS_HID) + (size_t)MP * FF, FF, WSP(const bf16_t, WS_WD) + (size_t)(pn * 256 + 32 * cg) * FF, FF, FF, acc);
    float ss = 0.f; float* orow = s < DEC ? F.out + O_YS + (size_t)s * D : WSP(float, WS_DUMP) + (size_t)s * D;
#pragma unroll
    for (int hf = 0; hf < 2; ++hf)
#pragma unroll
        for (int nf = 0; nf < 2; ++nf) { const int col = pn * 256 + 128 * hf + 32 * cg + 16 * nf + 4 * lq;
            const f32x4 v = acc[hf][nf] + *(const f32x4*)(WSP(const float, WS_XP2) + (size_t)row * 1024 + col);
            *(f32x4*)(orow + col) = v; ss += (v[0] * v[0] + v[1] * v[1]) + (v[2] * v[2] + v[3] * v[3]); }
    ss += SHFL_XOR(ss, 16); ss += SHFL_XOR(ss, 32);
    if (lq == 0) ATOMIC_ADD_F32((float*)F.ws + CW_SS3 + row, ss);
}

DEV void conv8(const bf16_t* XBC, int rowbase, int t, int col, const float* cw, const float* cbias, float (&o)[8]) {
    const f32x4 b0 = *(const f32x4*)(cbias + col), b1 = *(const f32x4*)(cbias + col + 4);
    float a[8] = {b0[0], b0[1], b0[2], b0[3], b1[0], b1[1], b1[2], b1[3]};
#pragma unroll
    for (int k = 0; k < 4; ++k) { const int tt = t - 3 + k;
        if (tt >= 0) { float x[8]; unpack8(*(const u32x4*)(XBC + (size_t)(rowbase + tt) * XBCW + col), x);
            const f32x4 w0 = *(const f32x4*)(cw + k * XBCW + col), w1 = *(const f32x4*)(cw + k * XBCW + col + 4);
#pragma unroll
            for (int e = 0; e < 4; ++e) { a[e] += w0[e] * x[e]; a[4 + e] += w1[e] * x[4 + e]; } } }
#pragma unroll
    for (int e = 0; e < 8; ++e) o[e] = siluf_(a[e]);
}

DEV bf16x8 tr_frag(const LAS bf16_t* tile, int pitch, int kr0, int c0, int l15, int lq) {
    const LAS bf16_t* p = tile + (kr0 + 8 * lq + (l15 >> 2)) * pitch + c0 + 4 * (l15 & 3);
    const s16x4_t lo = LDS_TR(p), hi = LDS_TR(p + 4 * pitch);
    bf16x8 r; r[0] = lo[0]; r[1] = lo[1]; r[2] = lo[2]; r[3] = lo[3]; r[4] = hi[0]; r[5] = hi[1]; r[6] = hi[2]; r[7] = hi[3]; return r;
}
template <int N, bool SCALE>
DEV void conv_stage_rows(const bf16_t* XBC, int rowbase, int t0, int col, int ja, const float* cw, const float* cbias, LAS bf16_t* dst, int dpitch, const LAS float* rowscale, int hq) {
    float wk[4][8], bs[8], x0[8], x1[8], x2[8];
#pragma unroll
    for (int k = 0; k < 4; ++k) { const f32x4 a = *(const f32x4*)(cw + k * XBCW + col), b = *(const f32x4*)(cw + k * XBCW + col + 4);
#pragma unroll
        for (int e = 0; e < 4; ++e) { wk[k][e] = a[e]; wk[k][4 + e] = b[e]; } }
    { const f32x4 a = *(const f32x4*)(cbias + col), b = *(const f32x4*)(cbias + col + 4);
#pragma unroll
      for (int e = 0; e < 4; ++e) { bs[e] = a[e]; bs[4 + e] = b[e]; } }
    const bf16_t* src = XBC + (size_t)rowbase * XBCW + col; const int tb = t0 + ja;
#pragma unroll
    for (int e = 0; e < 8; ++e) { x0[e] = 0.f; x1[e] = 0.f; x2[e] = 0.f; }
    if (tb >= 3) unpack8(*(const u32x4*)(src + (size_t)(tb - 3) * XBCW), x0);
    if (tb >= 2) unpack8(*(const u32x4*)(src + (size_t)(tb - 2) * XBCW), x1);
    if (tb >= 1) unpack8(*(const u32x4*)(src + (size_t)(tb - 1) * XBCW), x2);
#pragma unroll 8
    for (int jj = 0; jj < N; ++jj) { float x3[8], o[8]; unpack8(*(const u32x4*)(src + (size_t)(tb + jj) * XBCW), x3);
        float sc = 1.f; if (SCALE) sc = rowscale[(ja + jj) * 8 + hq];
#pragma unroll
        for (int e = 0; e < 8; ++e) { o[e] = siluf_(bs[e] + wk[0][e] * x0[e] + wk[1][e] * x1[e] + wk[2][e] * x2[e] + wk[3][e] * x3[e]) * sc; x0[e] = x1[e]; x1[e] = x2[e]; x2[e] = x3[e]; }
        u32x4 pw; pw.x = pk2(o[0], o[1]); pw.y = pk2(o[2], o[3]); pw.z = pk2(o[4], o[5]); pw.w = pk2(o[6], o[7]);
        *(LAS u32x4*)(dst + (ja + jj) * dpitch) = pw; }
}
DEV void chunk_dt_acum(const float* DT, const float* alog, int row0, int g, int hq, int lane, LAS float* acum, LAS float* dtv) {
    const int h = 8 * g + hq; const float a = -expf(alog[h]);
    const float d0 = DT[(size_t)(row0 + 2 * lane) * 32 + h], d1 = DT[(size_t)(row0 + 2 * lane + 1) * 32 + h];
    const float v0 = d0 * a, v1 = v0 + d1 * a; float s = v1;
#pragma unroll
    for (int d = 1; d < 64; d <<= 1) { const float t = SHFL(s, (lane - d) & 63); if (lane >= d) s += t; }
    const float ex = s - v1;
    acum[(2 * lane) * 8 + hq] = ex + v0; acum[(2 * lane + 1) * 8 + hq] = s;
    dtv[(2 * lane) * 8 + hq] = d0; dtv[(2 * lane + 1) * 8 + hq] = d1;
}

DEV void ssd_states_item(Frame& F, int item) {
    const int g = item & 3, c = (item >> 2) % NCH, b = (item >> 2) / NCH;
    const int tid = F.tid, lane = F.lane, w = F.wave, l15 = lane & 15, lq = lane >> 4;
    LAS float* acum = (LAS float*)F.lds; LAS float* dtv = acum + 1024; LAS float* wgt = acum + 2048;
    LAS bf16_t* BL = (LAS bf16_t*)(F.lds + 12288);
    LAS bf16_t* XL = (LAS bf16_t*)(F.lds + 12288 + 34816);
    const bf16_t* XBC = WSP(const bf16_t, WS_XBC); const float* DT = WSP(const float, WS_DT);
    const float* cw = F.P->in[I_SSMCW]; const float* cbias = F.P->in[I_SSMCB];
    const int rowbase = b * SEQ, t0 = c * 128, row0 = rowbase + t0;
    BLOCK_SYNC();
    chunk_dt_acum(DT, F.P->in[I_ALOG], row0, g, w, lane, acum, dtv);
    BLOCK_SYNC();
    for (int i = tid; i < 1024; i += 512) wgt[i] = expf(acum[127 * 8 + (i & 7)] - acum[i]) * dtv[i];
    if (tid < 8) WSP(float, WS_CDEC)[(size_t)(b * NCH + c) * 32 + 8 * g + tid] = expf(acum[127 * 8 + tid]);
    BLOCK_SYNC();
    if (tid < 384) { const int cgI = tid % 48, seg = tid / 48;
        if (cgI < 16) conv_stage_rows<16, false>(XBC, rowbase, t0, DIN + g * 128 + 8 * cgI, 16 * seg, cw, cbias, BL + 8 * cgI, 136, wgt, 0);
        else { const int c2 = cgI - 16, hh = c2 >> 3; conv_stage_rows<16, true>(XBC, rowbase, t0, (8 * g + hh) * 64 + 8 * (c2 & 7), 16 * seg, cw, cbias, XL + 8 * c2, 264, wgt, hh); } }
    BLOCK_SYNC();
    bf16x8 afr[4];
#pragma unroll
    for (int ks = 0; ks < 4; ++ks) afr[ks] = tr_frag(BL, 136, 32 * ks, 16 * w, l15, lq);
    bf16_t* CH = WSP(bf16_t, WS_CHST);
#pragma unroll 1
    for (int hb = 0; hb < 2; ++hb) {
        if (hb) { BLOCK_SYNC();
            { const int c2 = tid & 31, seg = tid >> 5, hh = c2 >> 3; conv_stage_rows<8, true>(XBC, rowbase, t0, (8 * g + 4 + hh) * 64 + 8 * (c2 & 7), 8 * seg, cw, cbias, XL + 8 * c2, 264, wgt, 4 + hh); }
            BLOCK_SYNC(); }
#pragma unroll
        for (int hh = 0; hh < 4; ++hh) { const int h = 8 * g + 4 * hb + hh;
#pragma unroll
            for (int pf = 0; pf < 4; ++pf) { f32x4 a4 = (f32x4){0.f, 0.f, 0.f, 0.f};
#pragma unroll
                for (int ks = 0; ks < 4; ++ks) a4 = MFMA16(afr[ks], tr_frag(XL, 264, 32 * ks, hh * 64 + 16 * pf, l15, lq), a4);
                u32x2 o; o.x = pk2(a4[0], a4[1]); o.y = pk2(a4[2], a4[3]);
                *(u32x2*)(CH + ((size_t)(b * NCH + c) * 32 + h) * 8192 + (16 * pf + l15) * 128 + 16 * w + 4 * lq) = o; } }
    }
}

DEV void attn_item(Frame& F, int item) {
    const int qt = item % (SEQ / 128), h = (item / (SEQ / 128)) & 3, b = item / (SEQ / 128) / 4;
    const int tid = F.tid, lane = F.lane, w = F.wave, l15 = lane & 15, lq = lane >> 4;
    LAS bf16_t* KL = (LAS bf16_t*)F.lds;
    const bf16_t* KBh = WSP(const bf16_t, WS_KB) + (size_t)(b * HEADS + h) * MEM * HD;
    const bf16_t* VTh = WSP(const bf16_t, WS_VT) + (size_t)(b * HEADS + h) * MEM * HD;
    bf16_t* QO = WSP(bf16_t, WS_ACAT) + (size_t)(b * SEQ + qt * 128 + 16 * w + l15) * 4096 + 3072 + h * HD;
    BLOCK_SYNC();
#pragma unroll 4
    for (int it = 0; it < 16; ++it) { const int idx = tid + 512 * it, row = idx >> 5, ch = idx & 31; *(LAS u32x4*)(KL + row * 264 + 8 * ch) = *(const u32x4*)(KBh + row * 256 + 8 * ch); }
    bf16x8 qf[8];
#pragma unroll
    for (int ks = 0; ks < 8; ++ks) qf[ks] = *(const bf16x8*)(QO + 32 * ks + 8 * lq);
    BLOCK_SYNC();
    f32x4 st[16];
#pragma unroll
    for (int kf = 0; kf < 16; ++kf) { f32x4 a4 = (f32x4){0.f, 0.f, 0.f, 0.f};
#pragma unroll
        for (int ks = 0; ks < 8; ++ks) { const bf16x8 afr = *(const LAS bf16x8*)(KL + (16 * kf + l15) * 264 + 32 * ks + 8 * lq); a4 = MFMA16(afr, qf[ks], a4); }
        st[kf] = a4; }
    float mx = -3.0e38f;
#pragma unroll
    for (int kf = 0; kf < 16; ++kf) mx = fmaxf(fmaxf(fmaxf(st[kf][0], st[kf][1]), fmaxf(st[kf][2], st[kf][3])), mx);
    mx = fmaxf(mx, SHFL_XOR(mx, 16)); mx = fmaxf(mx, SHFL_XOR(mx, 32));
    float sum = 0.f;
#pragma unroll
    for (int kf = 0; kf < 16; ++kf)
#pragma unroll
        for (int r = 0; r < 4; ++r) { const float p = fast_exp((st[kf][r] - mx) * 0.0625f); st[kf][r] = p; sum += p; }
    sum += SHFL_XOR(sum, 16); sum += SHFL_XOR(sum, 32);
    const float inv = 1.0f / sum;
    u32x2 pk[16];
#pragma unroll
    for (int kf = 0; kf < 16; ++kf) { pk[kf].x = pk2(st[kf][0] * inv, st[kf][1] * inv); pk[kf].y = pk2(st[kf][2] * inv, st[kf][3] * inv); }
    BLOCK_SYNC();
#pragma unroll 4
    for (int it = 0; it < 16; ++it) { const int idx = tid + 512 * it, row = idx >> 5, ch = idx & 31; *(LAS u32x4*)(KL + row * 264 + 8 * ch) = *(const u32x4*)(VTh + row * 256 + 8 * ch); }
    BLOCK_SYNC();
#pragma unroll
    for (int df = 0; df < 16; ++df) { f32x4 a4 = (f32x4){0.f, 0.f, 0.f, 0.f};
#pragma unroll
        for (int s = 0; s < 8; ++s) { const LAS bf16_t* vp = KL + (16 * df + l15) * 264 + 32 * s + 4 * lq;
            const u32x2 lo = *(const LAS u32x2*)vp, hi = *(const LAS u32x2*)(vp + 16);
            u32x4 av; av.x = lo.x; av.y = lo.y; av.z = hi.x; av.w = hi.y;
            u32x4 bv; bv.x = pk[2 * s].x; bv.y = pk[2 * s].y; bv.z = pk[2 * s + 1].x; bv.w = pk[2 * s + 1].y;
            a4 = MFMA16(__builtin_bit_cast(bf16x8, av), __builtin_bit_cast(bf16x8, bv), a4); }
        u32x2 o; o.x = pk2(a4[0], a4[1]); o.y = pk2(a4[2], a4[3]);
        if (!F.dry) *(u32x2*)(QO + 16 * df + 4 * lq) = o; }
}

DEV void yain_item(Frame& F, int item) {
    const int row = item * 4 + (F.tid >> 7), col = 8 * (F.tid & 127), t = row % SEQ;
    const bf16_t* U = WSP(const bf16_t, WS_U); bf16_t* A = WSP(bf16_t, WS_ACAT) + (size_t)row * 4096 + col; const float* w = F.P->in[I_SCW];
    float u2[8], u1[8], u0[8], sb[8], y[8];
    unpack8(*(const u32x4*)(U + (size_t)row * 1024 + col), u2);
    if (t >= 1) unpack8(*(const u32x4*)(U + (size_t)(row - 1) * 1024 + col), u1); else {
#pragma unroll
        for (int e = 0; e < 8; ++e) u1[e] = 0.f; }
    if (t >= 2) unpack8(*(const u32x4*)(U + (size_t)(row - 2) * 1024 + col), u0); else {
#pragma unroll
        for (int e = 0; e < 8; ++e) u0[e] = 0.f; }
    unpack8(*(const u32x4*)A, sb);
#pragma unroll
    for (int e = 0; e < 8; ++e) y[e] = sb[e] * (w[col + e] * u0[e] + w[1024 + col + e] * u1[e] + w[2048 + col + e] * u2[e]);
    u32x4 o; o.x = pk2(y[0], y[1]); o.y = pk2(y[2], y[3]); o.z = pk2(y[4], y[5]); o.w = pk2(y[6], y[7]);
    if (!F.dry) *(u32x4*)A = o;
}
DEV void pstate_item(Frame& F, int b) {
    const bf16_t* U = WSP(const bf16_t, WS_U); const bf16_t* XBC = WSP(const bf16_t, WS_XBC);
    for (int i = F.tid; i < 2 * 1024; i += 512) { const int k = i >> 10, cc = i & 1023; F.out[O_PCONV + (size_t)(b * 2 + k) * 1024 + cc] = bf1(U[(size_t)(b * SEQ + SEQ - 2 + k) * 1024 + cc]); }
    for (int i = F.tid; i < 3 * XBCW; i += 512) { const int k = i / XBCW, cc = i - k * XBCW; F.out[O_PSSMC + (size_t)(b * 3 + k) * XBCW + cc] = bf1(XBC[(size_t)(b * SEQ + SEQ - 3 + k) * XBCW + cc]); }
}
DEV void s_sconv_item(Frame& F, int item) {
    const int s = item * 4 + (F.tid >> 7), col = 8 * (F.tid & 127), row = MP + s;
    const bf16_t* U = WSP(const bf16_t, WS_U); bf16_t* A = WSP(bf16_t, WS_ACAT) + (size_t)row * 4096 + col; const float* w = F.P->in[I_SCW];
    const float* h0 = F.P->in[I_SCONV] + (size_t)(s * 2) * 1024 + col; const float* h1 = h0 + 1024;
    float un[8], sb[8], y[8];
    unpack8(*(const u32x4*)(U + (size_t)row * 1024 + col), un); unpack8(*(const u32x4*)A, sb);
    float* oc = F.out + O_SCONV + (size_t)(s * 2) * 1024 + col;
#pragma unroll
    for (int e = 0; e < 8; ++e) { y[e] = sb[e] * (w[col + e] * h0[e] + w[1024 + col + e] * h1[e] + w[2048 + col + e] * un[e]); oc[e] = h1[e]; oc[1024 + e] = un[e]; }
    u32x4 o; o.x = pk2(y[0], y[1]); o.y = pk2(y[2], y[3]); o.z = pk2(y[4], y[5]); o.w = pk2(y[6], y[7]);
    if (!F.dry) *(u32x4*)A = o;
}
DEV void s_ssmconv_state_item(Frame& F, int s) {
    const bf16_t* XBC = WSP(const bf16_t, WS_XBC) + (size_t)(MP + s) * XBCW; const float* hist = F.P->in[I_SSMCONV] + (size_t)s * 3 * XBCW; float* o = F.out + O_SSSMC + (size_t)s * 3 * XBCW;
    for (int i = F.tid; i < XBCW; i += 512) { o[i] = hist[XBCW + i]; o[XBCW + i] = hist[2 * XBCW + i]; o[2 * XBCW + i] = bf1(XBC[i]); }
}
DEV void s_ssd_item(Frame& F, int item) {
    const int g = item & 3, s = item >> 2, tid = F.tid, row = MP + s;
    LAS float* xc = (LAS float*)F.lds;
    LAS float* yb = xc + 768;
    LAS float* red = yb + 512;
    const bf16_t* XBC = WSP(const bf16_t, WS_XBC) + (size_t)row * XBCW; const float* hist = F.P->in[I_SSMCONV] + (size_t)s * 3 * XBCW;
    const float* cw = F.P->in[I_SSMCW]; const float* cbias = F.P->in[I_SSMCB];
    const int n4 = (tid & 31) * 4, pb = tid >> 5;
    const float* s0 = F.P->in[I_SSM] + ((size_t)s * 32 + 8 * g) * 8192 + pb * 128 + n4; float* s1 = F.out + O_SSSM + ((size_t)s * 32 + 8 * g) * 8192 + pb * 128 + n4;
    f32x4 so[4];
#pragma unroll
    for (int k = 0; k < 4; ++k) so[k] = *(const f32x4*)(s0 + 16 * k * 128);
    BLOCK_SYNC();
    for (int i = tid; i < 768; i += 512) { const int col = i < 512 ? g * 512 + i : (i < 640 ? DIN + g * 128 + (i - 512) : DIN + 512 + g * 128 + (i - 640));
        const float v = cbias[col] + cw[col] * hist[col] + cw[XBCW + col] * hist[XBCW + col] + cw[2 * XBCW + col] * hist[2 * XBCW + col] + cw[3 * XBCW + col] * bf1(XBC[col]);
        xc[i] = siluf_(v); }
    BLOCK_SYNC();
    const f32x4 Bv = *(const LAS f32x4*)(xc + 512 + n4), Cv = *(const LAS f32x4*)(xc + 640 + n4);
    const bf16_t* Z = WSP(const bf16_t, WS_ACAT) + (size_t)row * 4096 + 1024;
#pragma unroll 1
    for (int hq = 0; hq < 8; ++hq) { const int h = 8 * g + hq; const float dt = WSP(const float, WS_DT)[(size_t)row * 32 + h];
        const float dA = expf(dt * (-expf(F.P->in[I_ALOG][h]))), Dh = F.P->in[I_SSMD][h];
        f32x4 sn_[4];
#pragma unroll
        for (int k = 0; k < 4; ++k) sn_[k] = so[k];
        if (hq < 7) {
#pragma unroll
            for (int k = 0; k < 4; ++k) so[k] = *(const f32x4*)(s0 + (size_t)(hq + 1) * 8192 + 16 * k * 128); }
#pragma unroll
        for (int k = 0; k < 4; ++k) { const int p = pb + 16 * k; const float xv = xc[hq * 64 + p], dx = dt * xv; f32x4 sn;
#pragma unroll
            for (int e = 0; e < 4; ++e) sn[e] = sn_[k][e] * dA + dx * Bv[e];
            *(f32x4*)(s1 + (size_t)hq * 8192 + 16 * k * 128) = sn;
            float y = (sn[0] * Cv[0] + sn[1] * Cv[1]) + (sn[2] * Cv[2] + sn[3] * Cv[3]);
            y += SHFL_XOR(y, 1); y += SHFL_XOR(y, 2); y += SHFL_XOR(y, 4); y += SHFL_XOR(y, 8); y += SHFL_XOR(y, 16);
            if ((tid & 31) == 0) { y += Dh * xv; yb[hq * 64 + p] = y * siluf_(bf1(Z[h * 64 + p])); } } }
    BLOCK_SYNC();
    const float yv = yb[tid]; const float ssw = wave_sum(yv * yv);
    if (F.lane == 0) red[F.wave] = ssw;
    BLOCK_SYNC();
    float tot = 0.f;
#pragma unroll
    for (int i = 0; i < 8; ++i) tot += red[i];
    const float rs = fast_rsqrt(tot * (1.f / 512.f) + EPS);
    if (!F.dry) WSP(bf16_t, WS_ACAT)[(size_t)row * 4096 + 1024 + g * 512 + tid] = (bf16_t)f2bf(yv * rs * F.P->in[I_SSMNW][g * 512 + tid]);
}
DEV void s_attn_item(Frame& F, int item) {
    const int h = item & 3, s = item >> 2, tid = F.tid, lane = F.lane, w = F.wave, row = MP + s;
    LAS float* sc = (LAS float*)F.lds;
    LAS float* part = sc + 256;
    bf16_t* QO = WSP(bf16_t, WS_ACAT) + (size_t)row * 4096 + 3072 + h * HD;
    const float* Kc = F.P->in[I_CK] + ((size_t)s * MEM * HEADS + h) * HD + 4 * lane; const float* Vc = F.P->in[I_CV] + ((size_t)s * MEM * HEADS + h) * HD + 4 * lane;
    BLOCK_SYNC();
    const u32x2 qw = *(const u32x2*)(QO + 4 * lane); const float q0 = bflo(qw.x), q1 = bfhi(qw.x), q2 = bflo(qw.y), q3 = bfhi(qw.y);
#pragma unroll 1
    for (int i0 = 0; i0 < 32; i0 += 8) { f32x4 kv[8];
#pragma unroll
        for (int u = 0; u < 8; ++u) kv[u] = *(const f32x4*)(Kc + (size_t)(32 * w + i0 + u) * (HEADS * HD));
#pragma unroll
        for (int u = 0; u < 8; ++u) { const float d = wave_sum((kv[u][0] * q0 + kv[u][1] * q1) + (kv[u][2] * q2 + kv[u][3] * q3)); if (lane == 0) sc[32 * w + i0 + u] = d * 0.0625f; } }
    BLOCK_SYNC();
    if (w == 0) { const f32x4 v = *(const LAS f32x4*)(sc + 4 * lane); float mx = fmaxf(fmaxf(v[0], v[1]), fmaxf(v[2], v[3]));
#pragma unroll
        for (int o = 1; o < 64; o <<= 1) mx = fmaxf(mx, SHFL_XOR(mx, o));
        f32x4 p; float sm = 0.f;
#pragma unroll
        for (int e = 0; e < 4; ++e) { p[e] = expf(v[e] - mx); sm += p[e]; }
        sm = wave_sum(sm); const float inv = 1.f / sm;
        *(LAS f32x4*)(sc + 4 * lane) = p * inv; }
    BLOCK_SYNC();
    f32x4 acc = (f32x4){0.f, 0.f, 0.f, 0.f};
#pragma unroll 1
    for (int i0 = 0; i0 < 32; i0 += 8) { f32x4 vv[8];
#pragma unroll
        for (int u = 0; u < 8; ++u) vv[u] = *(const f32x4*)(Vc + (size_t)(32 * w + i0 + u) * (HEADS * HD));
#pragma unroll
        for (int u = 0; u < 8; ++u) acc += vv[u] * sc[32 * w + i0 + u]; }
    *(LAS f32x4*)(part + w * 256 + 4 * lane) = acc;
    BLOCK_SYNC();
    if (tid < 256 && !F.dry) { float o = 0.f;
#pragma unroll
        for (int k = 0; k < 8; ++k) o += part[k * 256 + tid];
        QO[tid] = (bf16_t)f2bf(o); }
}

DEV void p3_scan(Frame& F) {
    bf16_t* CH = WSP(bf16_t, WS_CHST); const float* CDEC = WSP(const float, WS_CDEC);
    const int ntask = BATCH * 32 * 64 * 32;
    for (int i = F.bid * 512 + F.tid; i < ntask; i += F.G * 512) {
        const int n4 = (i & 31) * 4, p = (i >> 5) & 63, h = (i >> 11) & 31, b = i >> 16;
        f32x4 S = (f32x4){0.f, 0.f, 0.f, 0.f};
#pragma unroll 1
        for (int c = 0; c < NCH; ++c) { bf16_t* q = CH + ((size_t)(b * NCH + c) * 32 + h) * 8192 + p * 128 + n4; const u32x2 raw = *(const u32x2*)q; const float dec = CDEC[(size_t)(b * NCH + c) * 32 + h];
            u32x2 o; o.x = pk2(S[0], S[1]); o.y = pk2(S[2], S[3]); if (!F.dry) *(u32x2*)q = o;
            S[0] = S[0] * dec + bflo(raw.x); S[1] = S[1] * dec + bfhi(raw.x); S[2] = S[2] * dec + bflo(raw.y); S[3] = S[3] * dec + bfhi(raw.y); }
        *(f32x4*)(F.out + O_PSSM + ((size_t)(b * 32 + h) * 64 + p) * 128 + n4) = S;
    }
}

DEV void ssd_out_item(Frame& F, int item) {
    const int g = item & 3, c = (item >> 2) % NCH, b = (item >> 2) / NCH;
    const int tid = F.tid, lane = F.lane, w = F.wave, l15 = lane & 15, lq = lane >> 4;
    LAS float* acum = (LAS float*)F.lds; LAS float* dtv = acum + 1024;
    LAS bf16_t* CL = (LAS bf16_t*)(F.lds + 8192);
    LAS bf16_t* BL = (LAS bf16_t*)(F.lds + 8192 + 34816);
    LAS bf16_t* XL = (LAS bf16_t*)(F.lds + 8192);
    LAS bf16_t* SL = (LAS bf16_t*)(F.lds + 8192 + 69632);
    LAS bf16_t* MW = (LAS bf16_t*)(F.lds + 8192 + 69632 + 17408) + w * 2176;
    const bf16_t* XBC = WSP(const bf16_t, WS_XBC); const float* DT = WSP(const float, WS_DT);
    const float* cw = F.P->in[I_SSMCW]; const float* cbias = F.P->in[I_SSMCB];
    const int rowbase = b * SEQ, t0 = c * 128, row0 = rowbase + t0;
    BLOCK_SYNC();
    chunk_dt_acum(DT, F.P->in[I_ALOG], row0, g, w, lane, acum, dtv);
    { const int cgI = tid & 31, seg = tid >> 5, isC = cgI >> 4;
      conv_stage_rows<8, false>(XBC, rowbase, t0, DIN + isC * 512 + g * 128 + 8 * (cgI & 15), 8 * seg, cw, cbias, (isC ? CL : BL) + 8 * (cgI & 15), 136, acum, 0); }
    BLOCK_SYNC();
    bf16x8 cfr[4];
#pragma unroll
    for (int ks = 0; ks < 4; ++ks) cfr[ks] = *(const LAS bf16x8*)(CL + (16 * w + l15) * 136 + 32 * ks + 8 * lq);
    f32x4 cb[8];
#pragma unroll
    for (int jf = 0; jf < 8; ++jf) { f32x4 a4 = (f32x4){0.f, 0.f, 0.f, 0.f};
#pragma unroll
        for (int ks = 0; ks < 4; ++ks) { const bf16x8 bfr = *(const LAS bf16x8*)(BL + (16 * jf + l15) * 136 + 32 * ks + 8 * lq); a4 = MFMA16(bfr, cfr[ks], a4); }
        cb[jf] = a4; }
    const int il = 16 * w + l15;
    bf16_t* Zrow = WSP(bf16_t, WS_ACAT) + (size_t)(row0 + il) * 4096 + 1024;
    const bf16_t* SP = WSP(const bf16_t, WS_CHST);
    u32x2 ykeep[8][4]; float ss = 0.f;
#pragma unroll
    for (int a = 0; a < 8; ++a)
#pragma unroll
        for (int pf = 0; pf < 4; ++pf) ykeep[a][pf] = (u32x2){0u, 0u};
#pragma unroll 1
    for (int hq = 0; hq < 8; ++hq) { const int h = 8 * g + hq, hh = hq & 3;
        BLOCK_SYNC();
        if (hh == 0) { const int c2 = tid & 31, seg = tid >> 5;
            conv_stage_rows<8, false>(XBC, rowbase, t0, (8 * g + hq + (c2 >> 3)) * 64 + 8 * (c2 & 7), 8 * seg, cw, cbias, XL + 8 * c2, 264, acum, 0); }
#pragma unroll 1
        for (int it = 0; it < 2; ++it) { const int idx = tid + 512 * it, p = idx >> 4, ch = idx & 15;
            *(LAS u32x4*)(SL + p * 136 + 8 * ch) = *(const u32x4*)(SP + ((size_t)(b * NCH + c) * 32 + h) * 8192 + p * 128 + 8 * ch); }
        const float ai_ = acum[il * 8 + hq];
#pragma unroll
        for (int jf = 0; jf < 8; ++jf) { const int j0 = 16 * jf + 4 * lq; float mv[4];
#pragma unroll
            for (int r = 0; r < 4; ++r) { const int j = j0 + r; const float e = fast_exp(fminf(ai_ - acum[j * 8 + hq], 0.f)) * dtv[j * 8 + hq]; mv[r] = j <= il ? cb[jf][r] * e : 0.f; }
            u32x2 o; o.x = pk2(mv[0], mv[1]); o.y = pk2(mv[2], mv[3]); *(LAS u32x2*)(MW + l15 * 136 + j0) = o; }
        BLOCK_SYNC();
        f32x4 yd[4], yo[4];
#pragma unroll
        for (int pf = 0; pf < 4; ++pf) { yd[pf] = (f32x4){0.f, 0.f, 0.f, 0.f}; yo[pf] = (f32x4){0.f, 0.f, 0.f, 0.f}; }
#pragma unroll
        for (int ks = 0; ks < 4; ++ks) { const bf16x8 mfr = *(const LAS bf16x8*)(MW + l15 * 136 + 32 * ks + 8 * lq);
#pragma unroll
            for (int pf = 0; pf < 4; ++pf) yd[pf] = MFMA16(tr_frag(XL, 264, 32 * ks, hh * 64 + 16 * pf, l15, lq), mfr, yd[pf]); }
#pragma unroll
        for (int ks = 0; ks < 4; ++ks)
#pragma unroll
            for (int pf = 0; pf < 4; ++pf) { const bf16x8 sfr = *(const LAS bf16x8*)(SL + (16 * pf + l15) * 136 + 32 * ks + 8 * lq); yo[pf] = MFMA16(sfr, cfr[ks], yo[pf]); }
        const float ei = expf(ai_), Dh = F.P->in[I_SSMD][h];
#pragma unroll
        for (int pf = 0; pf < 4; ++pf) { const int p0 = 16 * pf + 4 * lq;
            const u32x2 xw = *(const LAS u32x2*)(XL + il * 264 + hh * 64 + p0); const u32x2 zw = *(const u32x2*)(Zrow + h * 64 + p0);
            const float xv[4] = {bflo(xw.x), bfhi(xw.x), bflo(xw.y), bfhi(xw.y)}, zv[4] = {bflo(zw.x), bfhi(zw.x), bflo(zw.y), bfhi(zw.y)}; float y[4];
#pragma unroll
            for (int r = 0; r < 4; ++r) { y[r] = (yd[pf][r] + ei * yo[pf][r] + Dh * xv[r]) * siluf_(zv[r]); ss += y[r] * y[r]; }
            u32x2 yn; yn.x = pk2(y[0], y[1]); yn.y = pk2(y[2], y[3]);
#pragma unroll
            for (int a = 0; a < 7; ++a) ykeep[a][pf] = ykeep[a + 1][pf];
            ykeep[7][pf] = yn; }
    }
    ss += SHFL_XOR(ss, 16); ss += SHFL_XOR(ss, 32);
    const float rs = fast_rsqrt(ss * (1.f / 512.f) + EPS); const float* nw = F.P->in[I_SSMNW] + g * 512;
#pragma unroll
    for (int hq = 0; hq < 8; ++hq)
#pragma unroll
        for (int pf = 0; pf < 4; ++pf) { const int cidx = hq * 64 + 16 * pf + 4 * lq; const f32x4 wv = *(const f32x4*)(nw + cidx); const u32x2 k = ykeep[hq][pf];
            u32x2 o; o.x = pk2(bflo(k.x) * rs * wv[0], bfhi(k.x) * rs * wv[1]); o.y = pk2(bflo(k.y) * rs * wv[2], bfhi(k.y) * rs * wv[3]);
            if (!F.dry) *(u32x2*)(Zrow + g * 512 + cidx) = o; }
}

DEV void p9_final(Frame& F) {
    const int gw = F.bid * 8 + F.wave, NGW = F.G * 8, lane = F.lane; const float* SS3 = (const float*)F.ws + CW_SS3; const f32x4* wv = (const f32x4*)F.P->in[I_NFIN] + lane;
    for (int m = gw; m < MP + DEC; m += NGW) { const float rs = fast_rsqrt(SS3[m] * (1.f / 1024.f) + EPS); f32x4* x = (f32x4*)(F.out + O_YP + (size_t)m * D) + lane;
#pragma unroll
        for (int j = 0; j < 4; ++j) { const f32x4 ww = wv[64 * j]; f32x4 v = x[64 * j]; v = v * rs; v = v * ww; x[64 * j] = v; } }
}

constexpr int N_PHASES = 10;
#ifndef PH_MASK
#define PH_MASK 0x3ff
#endif
#define PH_ON(k) ((PH_MASK >> (k)) & 1)
DEV void run_phase(const Frame& F0, int ph) {
    if (!((PH_MASK >> ph) & 1)) return;
    Frame F = F0;
    OPAQUE_V(F.tid); OPAQUE_S(F.bid); OPAQUE_S(F.G);
    F.lane = F.tid & 63; F.wave = RFL(F.tid >> 6);
    const int G = F.G, bid = F.bid;
    if (ph == 0) { p0_prep(F); }
    else if (ph == 1) {
        SchedP1 S{(const char*)(F.ws + WS_XN), (const char*)(F.ws + WS_WIN), (const char*)(F.ws + WS_MEMN), (const char*)(F.ws + WS_WKV), G, bid};
        EpiP1 E{F.ws, F.out, F.P->in[I_DTB]};
        { const int hb = G / 2; if (bid >= hb) for (int it = bid - hb; it < IN_TILES * 4; it += G - hb) sk_inproj_item(F, it); }
        BLOCK_SYNC();
        pg8::gemm_phase(F.lds, 1024, S, E);
    } else if (ph == 2) {
        constexpr int N_ATT = BATCH * HEADS * (SEQ / 128), N_ST = BATCH * NCH * 4, N_SATT = DEC * 4, N_YA = MP / 4, N_SSC = DEC / 4, N_SST = DEC, N_PST = BATCH;
        constexpr int TOT = N_ATT + N_ST + N_SATT + N_YA + N_SSC + N_SST + N_PST;
        const int nk = bid < TOT ? (TOT - 1 - bid) / G + 1 : 0;
        for (int k = 0; k < nk; ++k) { int r = bid + ((bid & 1) ? nk - 1 - k : k) * G;
            Frame Fi = F; OPAQUE_V(Fi.tid); Fi.lane = Fi.tid & 63;
            if (r < N_ATT) { if (F.sub & 1) attn_item(Fi, r); continue; } r -= N_ATT;
            if (r < N_ST) { if (F.sub & 2) ssd_states_item(Fi, r); continue; } r -= N_ST;
            if (r < N_SATT) { if (F.sub & 4) s_attn_item(Fi, r); continue; } r -= N_SATT;
            if (r < N_YA) { if (F.sub & 16) yain_item(Fi, r); continue; } r -= N_YA;
            if (r < N_SSC) { if (F.sub & 32) s_sconv_item(Fi, r); continue; } r -= N_SSC;
            if (r < N_SST) { if (F.sub & 32) s_ssmconv_state_item(Fi, r); continue; } r -= N_SST;
            if (F.sub & 32) pstate_item(Fi, r); }
    } else if (ph == 3) { p3_scan(F); }
    else if (ph == 4) {
        constexpr int N_OUT = BATCH * NCH * 4, TOT = N_OUT + DEC * 4;
        const int nk = bid < TOT ? (TOT - 1 - bid) / G + 1 : 0;
        for (int k = 0; k < nk; ++k) { const int r = bid + ((bid & 1) ? nk - 1 - k : k) * G; Frame Fi = F; OPAQUE_V(Fi.tid); Fi.lane = Fi.tid & 63;
            if (r < N_OUT) { if (F.sub & 1) ssd_out_item(Fi, r); } else { if (F.sub & 8) s_ssd_item(Fi, r - N_OUT); } }
    }
    else if (ph == 5) {
        SchedP5 S{(const char*)(F.ws + WS_ACAT), (const char*)(F.ws + WS_WCAT), G, bid}; EpiP5 E{F.ws};
        for (int it = bid; it < 16; it += G) sk_merge_item(F, it);
        BLOCK_SYNC();
        pg8::gemm_phase(F.lds, 4096, S, E);
    } else if (ph == 6) {
        SchedPlain S{(const char*)(F.ws + WS_MERGED), (const char*)(F.ws + WS_WMO), MT_P, 4, 16, G, bid, (size_t)1024 * 2}; EpiP6 E{F.ws, F.P->in[I_XP], F.P->in[I_XS]};
        for (int it = bid; it < 16; it += G) sk_mergeo_item(F, it);
        BLOCK_SYNC();
        pg8::gemm_phase(F.lds, 1024, S, E);
    } else if (ph == 7) {
        SchedPlain S{(const char*)(F.ws + WS_XP2B), (const char*)(F.ws + WS_WGU), MT_P, GU_TILES, 16, G, bid, (size_t)1024 * 2}; EpiP7 E{F.ws};
        { const int hb = G / 2; if (bid >= hb) for (int it = bid - hb; it < GU_TILES * 4; it += G - hb) sk_up_item(F, it); }
        BLOCK_SYNC();
        pg8::gemm_phase(F.lds, 1024, S, E);
    } else if (ph == 8) {
        SchedPlain S{(const char*)(F.ws + WS_HID), (const char*)(F.ws + WS_WD), MT_P, 4, FF / 64, G, bid, (size_t)FF * 2}; EpiP8 E{F.ws, F.out};
        for (int it = bid; it < 16; it += G) sk_down_item(F, it);
        BLOCK_SYNC();
        pg8::gemm_phase(F.lds, FF, S, E);
    } else if (ph == 9) { p9_final(F); }
}

#ifndef HOST_EMU
#define XB_TMO      128
#define XB_XCNT(j)  (256  + 64 * (j))
#define XB_XSUB(j)  (1280 + 64 * (j))
#define XB_XGEN(j)  (2304 + 64 * (j))
#define XB_TOP      3328
#define XB_TOPGEN   3392
#define XCD_BAR_WORDS 3456
#define XB_SPIN_CAP (1u << 18)
__device__ __forceinline__ unsigned xb_ld(unsigned* p)              { return __hip_atomic_load(p, __ATOMIC_RELAXED, __HIP_MEMORY_SCOPE_AGENT); }
__device__ __forceinline__ unsigned xb_add(unsigned* p, unsigned v) { return __hip_atomic_fetch_add(p, v, __ATOMIC_RELAXED, __HIP_MEMORY_SCOPE_AGENT); }
__device__ __forceinline__ unsigned xb_xcc_id() { return (unsigned)__builtin_amdgcn_s_getreg((3 << 11) | 20) & 0xFu; }
#define XB_SPIN(cond, bar) do { unsigned _sp = 0; while (cond) { __builtin_amdgcn_s_sleep(1); \
    if ((++_sp & 255u) == 0u) { if (xb_ld(&(bar)[XB_TMO])) break; if (_sp > XB_SPIN_CAP) { atomicAdd(&(bar)[XB_TMO], 1u); break; } } } } while (0)
struct XcdBarrier { unsigned* bar; unsigned x; volatile LAS unsigned* st; };
__device__ __forceinline__ XcdBarrier xcd_barrier_post(unsigned* bar, volatile LAS unsigned* st) {
    XcdBarrier b; b.bar = bar; b.x = xb_xcc_id(); b.st = st;
    if (threadIdx.x == 0) (void)xb_add(&bar[XB_XCNT(b.x)], 1u);
    return b;
}
__device__ __forceinline__ void xcd_barrier_complete(unsigned* bar, unsigned x, unsigned& nloc, unsigned& nx) {
    const unsigned G = gridDim.x * gridDim.y * gridDim.z;
    unsigned sum, cnt, mine, sp = 0u;
    for (;;) {
        sum = 0u; cnt = 0u; mine = 0u;
#pragma unroll
        for (unsigned j = 0; j < 16; ++j) { const unsigned c = xb_ld(&bar[XB_XCNT(j)]); sum += c; cnt += (c > 0u) ? 1u : 0u; mine = (j == x) ? c : mine; }
        if (sum == G) break;
        __builtin_amdgcn_s_sleep(1);
        if ((++sp & 255u) == 0u) { if (xb_ld(&bar[XB_TMO])) break; if (sp > XB_SPIN_CAP) { atomicAdd(&bar[XB_TMO], 1u); break; } }
    }
    nloc = mine > 0u ? mine : 1u; nx = cnt > 0u ? cnt : 1u;
}
__device__ __forceinline__ void xcd_barrier(const XcdBarrier& b) {
    asm volatile("s_waitcnt vmcnt(0)" ::: "memory");
    __syncthreads();
    if (threadIdx.x == 0) {
        unsigned* bar = b.bar;
        __builtin_amdgcn_s_waitcnt(0);
        unsigned nloc = b.st[0], nx = b.st[1];
        if (nloc == 0u) { xcd_barrier_complete(bar, b.x, nloc, nx); b.st[0] = nloc; b.st[1] = nx; }
        const unsigned old = xb_add(&bar[XB_XSUB(b.x)], 1u);
        const unsigned gen = old / nloc;
        if (old + 1u == (gen + 1u) * nloc) {
            __builtin_amdgcn_fence(__ATOMIC_RELEASE, "agent");
            asm volatile("s_waitcnt vmcnt(0)" ::: "memory");
            const unsigned og = xb_add(&bar[XB_TOP], 1u);
            const unsigned tg = og / nx;
            if (og + 1u == (tg + 1u) * nx) xb_add(&bar[XB_TOPGEN], 1u);
            else XB_SPIN(xb_ld(&bar[XB_TOPGEN]) == tg, bar);
            __builtin_amdgcn_fence(__ATOMIC_ACQUIRE, "agent");
            xb_add(&bar[XB_XGEN(b.x)], 1u);
            asm volatile("s_waitcnt vmcnt(0)" ::: "memory");
        } else {
            XB_SPIN(xb_ld(&bar[XB_XGEN(b.x)]) == gen, bar);
            __builtin_amdgcn_fence(__ATOMIC_ACQUIRE, "agent");
            asm volatile("s_waitcnt vmcnt(0)" ::: "memory");
        }
    }
    __syncthreads();
}

__global__ void __launch_bounds__(512, 2) fwd_kernel(Params P) {
    extern __shared__ __attribute__((aligned(16))) unsigned char lds_raw[];
    Frame F;
    F.lds = (LAS unsigned char*)lds_raw; F.ws = P.ws; F.out = P.out; F.P = &P;
    F.tid = threadIdx.x; F.lane = F.tid & 63; F.wave = __builtin_amdgcn_readfirstlane(F.tid >> 6); F.G = gridDim.x; F.bid = blockIdx.x; F.dry = 0; F.sub = 0xff;
    volatile LAS unsigned* MISC = (volatile LAS unsigned*)(F.lds + MISC_OFF);
    for (int u = F.tid; u < (LDS_BYTES - LDSCTL_OFF) / 4; u += 512) ((LAS unsigned*)(F.lds + LDSCTL_OFF))[u] = 0u;
    __syncthreads();
    const bool multi = (P.ph_hi - P.ph_lo) > 1;
    XcdBarrier bar; bar.bar = (unsigned*)(P.ws + WS_CTL) + CW_BAR; bar.x = 0; bar.st = nullptr;
    if (multi) bar = xcd_barrier_post((unsigned*)(P.ws + WS_CTL) + CW_BAR, MISC + 8);
#define RUN_PH(k) if (P.ph_lo <= (k) && (k) < P.ph_hi) { if ((k) == P.dup_ph) { F.dry = 1; F.sub = P.dup_sub; run_phase(F, (k)); xcd_barrier(bar); F.dry = 0; F.sub = 0xff; } run_phase(F, (k)); if ((k) + 1 < P.ph_hi) xcd_barrier(bar); }
    RUN_PH(0) RUN_PH(1) RUN_PH(2) RUN_PH(3) RUN_PH(4) RUN_PH(5) RUN_PH(6) RUN_PH(7) RUN_PH(8) RUN_PH(9)
#undef RUN_PH
}

#ifndef N_LAUNCH_MODE
#define N_LAUNCH_MODE 0
#endif
extern "C" void kernel_launch(void* const* d_in, const int* in_sizes, int n_in, void* d_out, int out_size, void* d_ws, size_t ws_size, hipStream_t stream) {
    static int grid = 0;
    if (grid == 0) {
        if (n_in != 29 || ws_size < WS_END) { fprintf(stderr, "kernel_launch: unexpected shapes (n_in %d out %d ws %zu need %zu)\n", n_in, out_size, ws_size, (size_t)WS_END); grid = -1; return; }
        int dev = 0, cus = 0;
        if (hipGetDevice(&dev) != hipSuccess || hipDeviceGetAttribute(&cus, hipDeviceAttributeMultiprocessorCount, dev) != hipSuccess) { grid = -1; return; }
        if (hipFuncSetAttribute((const void*)fwd_kernel, hipFuncAttributeMaxDynamicSharedMemorySize, LDS_BYTES) != hipSuccess) { fprintf(stderr, "kernel_launch: hipFuncSetAttribute failed\n"); grid = -1; return; }
        (void)hipGetLastError();
        grid = cus;
    }
    if (grid < 0) return;
    (void)hipMemsetAsync((char*)d_ws + WS_CTL, 0, CTL_BYTES, stream);
    Params P{};
    for (int i = 0; i < 29; ++i) P.in[i] = (const float*)d_in[i];
    P.out = (float*)d_out; P.ws = (unsigned char*)d_ws;
#ifndef DUP_PH
#define DUP_PH (-1)
#endif
#ifndef DUP_SUB
#define DUP_SUB 0xff
#endif
    P.dup_ph = DUP_PH; P.dup_sub = DUP_SUB;
#if N_LAUNCH_MODE == 0
    P.ph_lo = 0; P.ph_hi = N_PHASES;
    hipLaunchKernelGGL(fwd_kernel, dim3(grid), dim3(512), LDS_BYTES, stream, P);
#else
    for (int ph = 0; ph < N_PHASES; ++ph) { P.ph_lo = ph; P.ph_hi = ph + 1; hipLaunchKernelGGL(fwd_kernel, dim3(grid), dim3(512), LDS_BYTES, stream, P); }
#endif
}
#endif
```

```cpp
#ifndef HOST_EMU
#include <hip/hip_runtime.h>
#include <cstdio>
#include <cstdint>
#define DEV __device__ __forceinline__
#define DEVM __device__ __forceinline__
#define LAS __attribute__((address_space(3)))
#define GAS __attribute__((address_space(1)))
#endif

#ifndef CFG_BATCH
#define CFG_BATCH 8
#endif
#ifndef CFG_SEQ
#define CFG_SEQ 2048
#endif
#ifndef CFG_DEC
#define CFG_DEC 128
#endif
constexpr int D = 1024, BATCH = CFG_BATCH, SEQ = CFG_SEQ, DEC = CFG_DEC;
constexpr int MP = BATCH * SEQ;
constexpr int M_ALL = MP + 256;
constexpr int MT_ALL = M_ALL / 256, MT_P = MP / 256;
constexpr int MEM = 256, HEADS = 4, HD = 256;
constexpr int NCH = SEQ / 128;
constexpr int SSM_H = 32, SSM_P = 64, SSM_N = 128, SSM_G = 4, DIN = 2048, XBCW = 3072;
constexpr int W_IN_COLS = 12320, IN_TILES = 49, NIN = IN_TILES * 256;
constexpr int FF = 2816, NGU = 2 * FF, GU_TILES = NGU / 256;
constexpr float EPS = 1e-6f;
static_assert(SEQ % 256 == 0 && DEC <= 256 && DEC % 4 == 0, "shape");

constexpr size_t O_YP = 0;
constexpr size_t O_YS = O_YP + (size_t)MP * D;
constexpr size_t O_MK = O_YS + (size_t)DEC * D;
constexpr size_t O_MV = O_MK + (size_t)BATCH * MEM * D;
constexpr size_t O_PCONV = O_MV + (size_t)BATCH * MEM * D;
constexpr size_t O_PSSMC = O_PCONV + (size_t)BATCH * 2 * D;
constexpr size_t O_PSSM = O_PSSMC + (size_t)BATCH * 3 * XBCW;
constexpr size_t O_SCONV = O_PSSM + (size_t)BATCH * SSM_H * SSM_P * SSM_N;
constexpr size_t O_SSSMC = O_SCONV + (size_t)DEC * 2 * D;
constexpr size_t O_SSSM = O_SSSMC + (size_t)DEC * 3 * XBCW;
constexpr size_t O_END = O_SSSM + (size_t)DEC * SSM_H * SSM_P * SSM_N;

constexpr size_t al256(size_t x) { return (x + 255) & ~(size_t)255; }
constexpr size_t WS_CTL = 0, CTL_BYTES = 1u << 20;
constexpr size_t WS_WIN = WS_CTL + CTL_BYTES;
constexpr size_t WS_WKV = WS_WIN + (size_t)NIN * 1024 * 2;
constexpr size_t WS_WCAT = WS_WKV + (size_t)2048 * 1024 * 2;
constexpr size_t WS_WMO = WS_WCAT + (size_t)1024 * 4096 * 2;
constexpr size_t WS_WGU = WS_WMO + (size_t)1024 * 1024 * 2;
constexpr size_t WS_WD = WS_WGU + (size_t)NGU * 1024 * 2;
constexpr size_t WS_XN = WS_WD + (size_t)1024 * FF * 2;
constexpr size_t WS_MEMN = WS_XN + (size_t)M_ALL * 1024 * 2;
constexpr size_t WS_KB = WS_MEMN + (size_t)BATCH * MEM * 1024 * 2;
constexpr size_t WS_VT = WS_KB + (size_t)BATCH * MEM * 1024 * 2;
constexpr size_t WS_DT = WS_VT + (size_t)BATCH * MEM * 1024 * 2;
constexpr size_t WS_CDEC = WS_DT + (size_t)M_ALL * 32 * 4;
constexpr size_t WS_DUMP = al256(WS_CDEC + (size_t)BATCH * NCH * 32 * 4);
constexpr size_t WS_ACAT = WS_DUMP + (size_t)256 * 1024 * 4;
constexpr size_t WS_U = WS_ACAT + (size_t)M_ALL * 4096 * 2;
constexpr size_t WS_XBC = WS_U + (size_t)M_ALL * 1024 * 2;
constexpr size_t WS_G = WS_XBC + (size_t)M_ALL * 3072 * 2;
constexpr size_t WS_CHST = WS_G + (size_t)M_ALL * 3072 * 2;
constexpr size_t WS_END = WS_CHST + (size_t)BATCH * NCH * 32 * 64 * 128 * 2;
constexpr size_t WS_MERGED = WS_XN, WS_HID = WS_ACAT, WS_XP2B = WS_U, WS_MSCR = WS_XBC, WS_XP2 = WS_XBC;
static_assert((size_t)M_ALL * FF * 2 <= (size_t)M_ALL * 4096 * 2 && (size_t)M_ALL * 1024 * 4 <= (size_t)M_ALL * 3072 * 2, "overlays");
constexpr int CW_BAR = 4096;
constexpr int CW_SS2 = 16384;
constexpr int CW_SS3 = CW_SS2 + M_ALL;
constexpr int CW_SM = 65536;
static_assert(CW_SS3 + M_ALL <= CW_SM && (size_t)(CW_SM + 128 * 1024) * 4 <= CTL_BYTES, "ctl");

constexpr int RING_BYTES = 135168;
constexpr int LDSCTL_OFF = 139264, MISC_OFF = LDSCTL_OFF + 320, LDS_BYTES = 147456;

typedef unsigned short bf16_t;
typedef short bf16x8 __attribute__((ext_vector_type(8)));
typedef float f32x4 __attribute__((ext_vector_type(4)));
typedef float f32x2 __attribute__((ext_vector_type(2)));
typedef unsigned u32x4 __attribute__((ext_vector_type(4)));
typedef unsigned u32x2 __attribute__((ext_vector_type(2)));

#ifndef HOST_EMU
DEV f32x4 MFMA16(bf16x8 a, bf16x8 b, f32x4 c) { return __builtin_amdgcn_mfma_f32_16x16x32_bf16(a, b, c, 0, 0, 0); }
#define GLDS16(g, l) __builtin_amdgcn_global_load_lds((const unsigned*)(g), (LAS unsigned*)(l), 16, 0, 0)
#define SBAR() __builtin_amdgcn_s_barrier()
#define WAIT_V(n) asm volatile("s_waitcnt vmcnt(" #n ")" ::: "memory")
#define WAIT_L(n) asm volatile("s_waitcnt lgkmcnt(" #n ")" ::: "memory")
#define SETPRIO(n) __builtin_amdgcn_s_setprio(n)
#define SCHEDB() __builtin_amdgcn_sched_barrier(0)
#define WAVE_LDS_SYNC() asm volatile("s_waitcnt lgkmcnt(0)" ::: "memory")
#define BLOCK_SYNC() __syncthreads()
typedef short s16x4_t __attribute__((ext_vector_type(4)));
DEV s16x4_t LDS_TR(const LAS unsigned short* p) { return __builtin_amdgcn_ds_read_tr16_b64_v4i16((LAS s16x4_t*)p); }
#define CFENCE() asm volatile("" ::: "memory")
#define OPAQUE_V(x) asm volatile("" : "+v"(x))
#define OPAQUE_S(x) asm volatile("" : "+s"(x))
DEV int RFL(int v) { return __builtin_amdgcn_readfirstlane(v); }
DEV float SHFL_XOR(float v, int m) { return __shfl_xor(v, m); }
DEV float SHFL(float v, int src) { return __shfl(v, src); }
DEV void ATOMIC_ADD_F32(float* p, float v) { atomicAdd(p, v); }
typedef __bf16 bf16x2_t __attribute__((ext_vector_type(2)));
DEV unsigned cvt_pk_bf16(float lo, float hi) { const f32x2 v = {lo, hi}; return __builtin_bit_cast(unsigned, __builtin_convertvector(v, bf16x2_t)); }
DEV float fast_exp(float x) { return __expf(x); }
DEV float fast_rsqrt(float x) { return rsqrtf(x); }
DEV float fast_rcp(float x) { return __builtin_amdgcn_rcpf(x); }
#endif

DEV unsigned f2bf(float f) { unsigned u = __builtin_bit_cast(unsigned, f); return (u + 0x7fffu + ((u >> 16) & 1u)) >> 16; }
DEV unsigned pk2(float lo, float hi) { return cvt_pk_bf16(lo, hi); }
DEV float bflo(unsigned w) { return __builtin_bit_cast(float, w << 16); }
DEV float bfhi(unsigned w) { return __builtin_bit_cast(float, w & 0xffff0000u); }
DEV float bf1(bf16_t b) { return __builtin_bit_cast(float, (unsigned)b << 16); }
DEV float sigmoidf_(float x) { return fast_rcp(1.0f + fast_exp(-x)); }
DEV float siluf_(float x) { return x * fast_rcp(1.0f + fast_exp(-x)); }
DEV float softplusf_(float x) { return x > 20.f ? x : log1pf(expf(x)); }
DEV float wave_sum(float v) {
#pragma unroll
    for (int o = 1; o < 64; o <<= 1) v += SHFL_XOR(v, o);
    return v;
}
DEV u32x4 pack8(const f32x4& a, const f32x4& b) { u32x4 w; w.x = cvt_pk_bf16(a[0], a[1]); w.y = cvt_pk_bf16(a[2], a[3]); w.z = cvt_pk_bf16(b[0], b[1]); w.w = cvt_pk_bf16(b[2], b[3]); return w; }
DEV void unpack8(const u32x4& w, float (&o)[8]) { o[0] = bflo(w.x); o[1] = bfhi(w.x); o[2] = bflo(w.y); o[3] = bfhi(w.y); o[4] = bflo(w.z); o[5] = bfhi(w.z); o[6] = bflo(w.w); o[7] = bfhi(w.w); }

struct Params {
    const float* in[29];
    float* out;
    unsigned char* ws;
    int ph_lo, ph_hi, dup_ph, dup_sub;
};
enum { I_XP = 0, I_XS, I_MEM, I_CK, I_CV, I_SCONV, I_SSMCONV, I_SSM, I_NMIX, I_WIN, I_SCW, I_WSC, I_SSMCW, I_SSMCB, I_DTB, I_ALOG, I_SSMD, I_SSMNW, I_WSSM,
       I_NMEM, I_WMK, I_WMV, I_WAO, I_WMO, I_NFFN, I_WG, I_WU, I_WDN, I_NFIN };

namespace pg8 {
constexpr int BM = 256, BK = 64, HALF = 128, HTB = HALF * BK * 2, STAGE_BYTES = 8 * HTB, NXCD = 8, WGM = 8;
DEV int lds_byte(int r, int c) { const int st = (r >> 4) * 2 + (c >> 5), rr = r & 15, cc = c & 31, ob = rr * 64 + cc * 2; return st * 1024 + (ob ^ (((ob >> 9) & 1) << 5)); }
DEV void stage_rc(int b, int& R, int& C) { const int st = b / 1024, sb = b % 1024, swz = sb ^ (((sb >> 9) & 1) << 5); R = (st >> 1) * 16 + swz / 64; C = (st & 1) * 32 + (swz % 64) / 2; }
DEV int perm32(int rho) { const int n = rho >> 4, i = rho & 15; return 8 * (i >> 2) + 4 * n + (i & 3); }

struct Unit { const char* A; const char* B; int nt, kind, pm, pn; };
DEV void tile_of(int wgid, int nM, int nN, int& pm, int& pn) {
    const int nwg = nM * nN; { const int q = nwg / NXCD, r = nwg % NXCD, xcd = wgid % NXCD, off = wgid / NXCD; wgid = (xcd < r ? xcd * (q + 1) : r * (q + 1) + (xcd - r) * q) + off; }
    const int nig = WGM * nN, gid = wgid / nig, fm = gid * WGM, gsz = (nM - fm) < WGM ? (nM - fm) : WGM;
    pm = fm + ((wgid % nig) % gsz); pn = (wgid % nig) / gsz;
}

template <class Epi, class Sched>
DEV void gemm_phase(LAS unsigned char* lds, const int PITCH, const Sched& S, const Epi& E) {
    const int tid = threadIdx.x, wid = RFL(tid >> 6), lane = tid & 63, wr = wid >> 2, wc = wid & 3, fr = lane & 15, fq = lane >> 4;
    unsigned voffA[2], voffB[2];
#pragma unroll
    for (int i = 0; i < 2; ++i) { int R, C; stage_rc(tid * 16 + i * 8192, R, C); const int Rb = (R & ~31) + perm32(R & 31);
        voffA[i] = (unsigned)(R * PITCH + C) * 2u; voffB[i] = (unsigned)(Rb * PITCH + C) * 2u; }
    const size_t kstep = (size_t)(BK * 2);
    const size_t hstep = (size_t)HALF * PITCH * 2;
    const unsigned ldsw = (unsigned)wid * 1024u;
    const int aoff = lds_byte(wr * 64 + fr, fq * 8), boff = lds_byte(wc * 32 + fr, fq * 8);
#define PG8_SA(b, h) (((b) * 2 + (h)) * HTB)
#define PG8_SB(b, h) ((4 + (b) * 2 + (h)) * HTB)
#define PG8_STAGE(bufoff, gbase, voff) do { _Pragma("unroll") for (int _i = 0; _i < 2; ++_i) \
        GLDS16((const char*)(gbase) + (voff)[_i], lds + (bufoff) + ldsw + _i * 8192); } while (0)
#define PG8_LDA(dst, b, h) do { _Pragma("unroll") for (int m = 0; m < 4; ++m) _Pragma("unroll") for (int k = 0; k < 2; ++k) dst[m][k] = *(const LAS bf16x8*)(lds + PG8_SA(b, h) + aoff + m * 2048 + k * 1024); } while (0)
#define PG8_LDB(dst, b, h) do { _Pragma("unroll") for (int n = 0; n < 2; ++n) _Pragma("unroll") for (int k = 0; k < 2; ++k) dst[n][k] = *(const LAS bf16x8*)(lds + PG8_SB(b, h) + boff + n * 2048 + k * 1024); } while (0)
#define PG8_MMA(ai, bj, At, Bt) do { SETPRIO(1); _Pragma("unroll") for (int m = 0; m < 4; ++m) _Pragma("unroll") for (int n = 0; n < 2; ++n) _Pragma("unroll") for (int k = 0; k < 2; ++k) \
        acc[ai][bj][m][n] = MFMA16(Bt[n][k], At[m][k], acc[ai][bj][m][n]); SETPRIO(0); } while (0)
    Unit cur, nxt; int ui = 0;
    if (!S.next(0, cur)) return;
    f32x4 acc[2][2][4][2];
#pragma unroll
    for (int a = 0; a < 2; ++a)
#pragma unroll
        for (int b = 0; b < 2; ++b)
#pragma unroll
            for (int m = 0; m < 4; ++m)
#pragma unroll
                for (int n = 0; n < 2; ++n) acc[a][b][m][n] = (f32x4){0.f, 0.f, 0.f, 0.f};
    bf16x8 At[4][2], B0[2][2], B1[2][2];
    const char* cA = cur.A; const char* cB = cur.B;
    PG8_STAGE(PG8_SB(0, 0), cB, voffB); PG8_STAGE(PG8_SB(0, 1), cB + hstep, voffB); PG8_STAGE(PG8_SA(0, 0), cA, voffA); PG8_STAGE(PG8_SA(0, 1), cA + hstep, voffA);
    if (wr == 1) SBAR();
    WAIT_V(2); SBAR();
    PG8_STAGE(PG8_SB(1, 0), cB + kstep, voffB); PG8_STAGE(PG8_SA(1, 0), cA + kstep, voffA); PG8_STAGE(PG8_SB(1, 1), cB + hstep + kstep, voffB);
    WAIT_V(6); SBAR();
    for (;;) {
        const bool has_next = S.next(ui + 1, nxt);
        const char* nA = has_next ? nxt.A : cA; const char* nB = has_next ? nxt.B : cB;
        const int nt = cur.nt;
        for (int t = 0; t < nt; t += 2) {
            const bool last = (t == nt - 2);
            const char* a1 = cA + (size_t)(t + 1) * kstep;
            const char* a2 = last ? nA : cA + (size_t)(t + 2) * kstep; const char* b2 = last ? nB : cB + (size_t)(t + 2) * kstep;
            const char* a3 = a2 + kstep; const char* b3 = b2 + kstep;
            PG8_LDB(B0, 0, 0); PG8_LDB(B1, 0, 1); SCHEDB(); PG8_LDA(At, 0, 0); PG8_STAGE(PG8_SA(1, 1), a1 + hstep, voffA);
            WAIT_V(8); WAIT_L(0); SBAR(); PG8_MMA(0, 0, At, B0); PG8_MMA(0, 1, At, B1); SBAR(); SCHEDB();
            PG8_LDA(At, 0, 1); PG8_STAGE(PG8_SB(0, 0), b2, voffB); PG8_STAGE(PG8_SB(0, 1), b2 + hstep, voffB); PG8_STAGE(PG8_SA(0, 0), a2, voffA);
            WAIT_V(8); WAIT_L(0); SBAR(); PG8_MMA(1, 0, At, B0); PG8_MMA(1, 1, At, B1); SBAR(); SCHEDB();
            PG8_LDB(B0, 1, 0); PG8_LDB(B1, 1, 1); SCHEDB(); PG8_LDA(At, 1, 0); PG8_STAGE(PG8_SA(0, 1), a2 + hstep, voffA);
            WAIT_V(8); WAIT_L(0); SBAR(); PG8_MMA(0, 0, At, B0); PG8_MMA(0, 1, At, B1); SBAR(); SCHEDB();
            PG8_LDA(At, 1, 1); PG8_STAGE(PG8_SB(1, 0), b3, voffB); PG8_STAGE(PG8_SB(1, 1), b3 + hstep, voffB); PG8_STAGE(PG8_SA(1, 0), a3, voffA);
            WAIT_V(8); WAIT_L(0); SBAR(); PG8_MMA(1, 0, At, B0); PG8_MMA(1, 1, At, B1); SBAR(); SCHEDB();
        }
        if (wr == 0) SBAR();
        { int fr_ = fr, fq_ = fq; OPAQUE_V(fr_); OPAQUE_V(fq_); E(acc, cur, wr, wc, fr_, fq_); }
        if (!has_next) break;
#pragma unroll
        for (int a = 0; a < 2; ++a)
#pragma unroll
            for (int b = 0; b < 2; ++b)
#pragma unroll
                for (int m = 0; m < 4; ++m)
#pragma unroll
                    for (int n = 0; n < 2; ++n) acc[a][b][m][n] = (f32x4){0.f, 0.f, 0.f, 0.f};
        cur = nxt; cA = nA; cB = nB; ++ui;
        if (wr == 1) SBAR();
    }
    WAIT_V(0);
    SBAR();
#undef PG8_SA
#undef PG8_SB
#undef PG8_STAGE
#undef PG8_LDA
#undef PG8_LDB
#undef PG8_MMA
}
}
using pg8::Unit;

struct Frame {
    LAS unsigned char* lds;
    unsigned char* ws;
    const Params* P;
    float* out;
    int tid, lane, wave, G, bid;
    int dry, sub;
};
#define WSP(T, off) ((T*)(F.ws + (off)))

DEV void transpose_item(const float* W, int src_pitch, int k0, int n0, bf16_t* WT, size_t dst_pitch, int dst_row0, int dst_k, const float* kscale, LAS float* scr, int lane) {
    float v[32];
#pragma unroll
    for (int i = 0; i < 32; ++i) { const int kk = 2 * i + (lane >> 5); v[i] = W[(size_t)(k0 + kk) * src_pitch + n0 + (lane & 31)]; }
#pragma unroll
    for (int i = 0; i < 32; ++i) { const int kk = 2 * i + (lane >> 5); float x = v[i]; if (kscale) x *= kscale[k0 + kk]; scr[kk * 33 + (lane & 31)] = x; }
    WAVE_LDS_SYNC();
    const int c = lane & 7;
#pragma unroll
    for (int j = 0; j < 4; ++j) { const int n = (lane >> 3) + 8 * j; const LAS float* s = scr + (8 * c) * 33 + n;
        u32x4 o; o.x = pk2(s[0 * 33], s[1 * 33]); o.y = pk2(s[2 * 33], s[3 * 33]); o.z = pk2(s[4 * 33], s[5 * 33]); o.w = pk2(s[6 * 33], s[7 * 33]);
        *(u32x4*)(WT + (size_t)(dst_row0 + n) * dst_pitch + dst_k + 8 * c) = o; }
    WAVE_LDS_SYNC();
}
DEV int win_dst_row(int c) {
    if (c < 1024) return c;
    if (c < 2048) { const int j = (c - 1024) >> 7; return 1024 + 256 * j + ((c - 1024) & 127); }
    if (c < 3072) { const int j = (c - 2048) >> 7; return 1024 + 256 * j + 128 + ((c - 2048) & 127); }
    if (c < 8192) return c;
    if (c < 8224) return 12288 + (c - 8192);
    return c - 32;
}
DEV void rms_row_bf16(const float* xrow, const float* w, bf16_t* orow, int lane) {
    const f32x4* xr = (const f32x4*)xrow + lane; const f32x4* wr_ = (const f32x4*)w + lane;
    f32x4 v[4]; float s = 0.f;
#pragma unroll
    for (int j = 0; j < 4; ++j) { v[j] = xr[64 * j]; s += (v[j][0] * v[j][0] + v[j][1] * v[j][1]) + (v[j][2] * v[j][2] + v[j][3] * v[j][3]); }
    const float rs = fast_rsqrt(wave_sum(s) * (1.f / 1024.f) + EPS);
    u32x2* o8 = (u32x2*)orow + lane;
#pragma unroll
    for (int j = 0; j < 4; ++j) { const f32x4 ww = wr_[64 * j]; u32x2 o; o.x = pk2(v[j][0] * rs * ww[0], v[j][1] * rs * ww[1]); o.y = pk2(v[j][2] * rs * ww[2], v[j][3] * rs * ww[3]); o8[64 * j] = o; }
}
DEV void p0_prep(Frame& F) {
    LAS float* scr = (LAS float*)(F.lds + F.wave * 16384);
    const int gw = F.bid * 8 + F.wave, NGW = F.G * 8, lane = F.lane;
    bf16_t* WIN = WSP(bf16_t, WS_WIN); bf16_t* WKV = WSP(bf16_t, WS_WKV); bf16_t* WCAT = WSP(bf16_t, WS_WCAT); bf16_t* WMO = WSP(bf16_t, WS_WMO);
    bf16_t* WGU = WSP(bf16_t, WS_WGU); bf16_t* WD = WSP(bf16_t, WS_WD);
    constexpr int I0 = 16 * (W_IN_COLS / 32), I1 = 16 * 32, I4 = 32 * 32, I7 = 16 * (FF / 32), I9 = (FF / 64) * 32;
    constexpr int NITEMS = I0 + 2 * I1 + I1 + I4 + I1 + I1 + 2 * I7 + I9;
    for (int it = gw; it < NITEMS; it += NGW) {
        int r = it;
        if (r < I0) { const int nb = W_IN_COLS / 32, kb = r / nb, n0 = 32 * (r % nb); transpose_item(F.P->in[I_WIN], W_IN_COLS, 64 * kb, n0, WIN, 1024, win_dst_row(n0), 64 * kb, nullptr, scr, lane); continue; } r -= I0;
        if (r < I1) { const int kb = r / 32, n0 = 32 * (r % 32); transpose_item(F.P->in[I_WMK], 1024, 64 * kb, n0, WKV, 1024, n0, 64 * kb, nullptr, scr, lane); continue; } r -= I1;
        if (r < I1) { const int kb = r / 32, n0 = 32 * (r % 32); transpose_item(F.P->in[I_WMV], 1024, 64 * kb, n0, WKV, 1024, 1024 + n0, 64 * kb, nullptr, scr, lane); continue; } r -= I1;
        if (r < I1) { const int kb = r / 32, n0 = 32 * (r % 32); transpose_item(F.P->in[I_WSC], 1024, 64 * kb, n0, WCAT, 4096, n0, 64 * kb, nullptr, scr, lane); continue; } r -= I1;
        if (r < I4) { const int kb = r / 32, n0 = 32 * (r % 32); transpose_item(F.P->in[I_WSSM], 1024, 64 * kb, n0, WCAT, 4096, n0, 1024 + 64 * kb, nullptr, scr, lane); continue; } r -= I4;
        if (r < I1) { const int kb = r / 32, n0 = 32 * (r % 32); transpose_item(F.P->in[I_WAO], 1024, 64 * kb, n0, WCAT, 4096, n0, 3072 + 64 * kb, nullptr, scr, lane); continue; } r -= I1;
        if (r < I1) { const int kb = r / 32, n0 = 32 * (r % 32); transpose_item(F.P->in[I_WMO], 1024, 64 * kb, n0, WMO, 1024, n0, 64 * kb, nullptr, scr, lane); continue; } r -= I1;
        if (r < I7) { const int nb = FF / 32, kb = r / nb, n0 = 32 * (r % nb); transpose_item(F.P->in[I_WG], FF, 64 * kb, n0, WGU, 1024, 256 * (n0 >> 7) + (n0 & 127), 64 * kb, F.P->in[I_NFFN], scr, lane); continue; } r -= I7;
        if (r < I7) { const int nb = FF / 32, kb = r / nb, n0 = 32 * (r % nb); transpose_item(F.P->in[I_WU], FF, 64 * kb, n0, WGU, 1024, 256 * (n0 >> 7) + 128 + (n0 & 127), 64 * kb, F.P->in[I_NFFN], scr, lane); continue; } r -= I7;
        { const int kb = r / 32, n0 = 32 * (r % 32); transpose_item(F.P->in[I_WDN], 1024, 64 * kb, n0, WD, FF, n0, 64 * kb, nullptr, scr, lane); }
    }
    { u32x4* z = (u32x4*)(WIN + (size_t)12320 * 1024); const int nz = (NIN - 12320) * 1024 / 8;
      for (int i = F.bid * 512 + F.tid; i < nz; i += F.G * 512) z[i] = (u32x4){0u, 0u, 0u, 0u}; }
    bf16_t* XN = WSP(bf16_t, WS_XN); bf16_t* MEMN = WSP(bf16_t, WS_MEMN);
    for (int m = gw; m < M_ALL; m += NGW) {
        if (m < MP) rms_row_bf16(F.P->in[I_XP] + (size_t)m * D, F.P->in[I_NMIX], XN + (size_t)m * D, lane);
        else if (m < MP + DEC) rms_row_bf16(F.P->in[I_XS] + (size_t)(m - MP) * D, F.P->in[I_NMIX], XN + (size_t)m * D, lane);
        else { u32x4* z = (u32x4*)(XN + (size_t)m * D); z[lane] = (u32x4){0u, 0u, 0u, 0u}; z[lane + 64] = (u32x4){0u, 0u, 0u, 0u}; }
    }
    for (int m = gw; m < BATCH * MEM; m += NGW) rms_row_bf16(F.P->in[I_MEM] + (size_t)m * D, F.P->in[I_NMEM], MEMN + (size_t)m * D, lane);
}

struct SchedP1 {
    const char* XN; const char* WIN; const char* MEMN; const char* WKV; int G, c;
    DEVM bool next(int i, Unit& u) const {
        const int n1 = MT_P * IN_TILES, n2 = BATCH * 8; const long L = (long)i * G + c;
        if (L >= n1 + n2) return false;
        u.nt = 16;
        if (L < n1) { pg8::tile_of((int)L, MT_P, IN_TILES, u.pm, u.pn); u.kind = 0; u.A = XN + (size_t)u.pm * 256 * 1024 * 2; u.B = WIN + (size_t)u.pn * 256 * 1024 * 2; }
        else { pg8::tile_of((int)(L - n1), BATCH, 8, u.pm, u.pn); u.kind = 1; u.A = MEMN + (size_t)u.pm * 256 * 1024 * 2; u.B = WKV + (size_t)u.pn * 256 * 1024 * 2; }
        return true;
    }
};
struct EpiP1 {
    unsigned char* ws; float* out; const float* dtb;
    DEVM void operator()(const f32x4 (&acc)[2][2][4][2], const Unit& u, int wr, int wc, int fr, int fq) const {
        const int cb = wc * 32 + 8 * fq;
        if (u.kind == 1) {
            const int b = u.pm, h = u.pn & 3; const bool isv = u.pn >= 4;
            float* of = out + (isv ? O_MV : O_MK); bf16_t* KB = (bf16_t*)(ws + WS_KB); bf16_t* VT = (bf16_t*)(ws + WS_VT);
#pragma unroll
            for (int ai = 0; ai < 2; ++ai)
#pragma unroll
                for (int m = 0; m < 4; ++m) { const int key = ai * 128 + wr * 64 + m * 16 + fr;
#pragma unroll
                    for (int bj = 0; bj < 2; ++bj) { const int d = bj * 128 + cb; const f32x4 v0 = acc[ai][bj][m][0], v1 = acc[ai][bj][m][1];
                        float* o = of + ((size_t)(b * MEM + key) * HEADS + h) * HD + d; *(f32x4*)o = v0; *(f32x4*)(o + 4) = v1;
                        if (!isv) *(u32x4*)(KB + ((size_t)(b * HEADS + h) * MEM + key) * HD + d) = pack8(v0, v1);
                        else { bf16_t* vt = VT + ((size_t)(b * HEADS + h) * HD + d) * MEM + key;
#pragma unroll
                            for (int e = 0; e < 4; ++e) { vt[(size_t)e * MEM] = (bf16_t)f2bf(v0[e]); vt[(size_t)(e + 4) * MEM] = (bf16_t)f2bf(v1[e]); } } }
                    CFENCE(); }
            return;
        }
        const int pn = u.pn, row0 = u.pm * 256 + wr * 64 + fr;
        if (pn < 4 || (pn >= 12 && pn < 20) || (pn >= 32 && pn < 36)) {
            const int coff = pn < 4 ? pn * 256 : (pn < 20 ? 1024 + (pn - 12) * 256 : 3072 + (pn - 32) * 256);
            bf16_t* O = (bf16_t*)(ws + WS_ACAT);
#pragma unroll
            for (int ai = 0; ai < 2; ++ai)
#pragma unroll
                for (int m = 0; m < 4; ++m) { bf16_t* rp = O + (size_t)(row0 + ai * 128 + m * 16) * 4096 + coff + cb;
#pragma unroll
                    for (int bj = 0; bj < 2; ++bj) *(u32x4*)(rp + bj * 128) = pack8(acc[ai][bj][m][0], acc[ai][bj][m][1]);
                    CFENCE(); }
        } else if (pn < 12) {
            bf16_t* O = (bf16_t*)(ws + WS_U); const int j = pn - 4;
#pragma unroll
            for (int ai = 0; ai < 2; ++ai)
#pragma unroll
                for (int m = 0; m < 4; ++m) *(u32x4*)(O + (size_t)(row0 + ai * 128 + m * 16) * 1024 + 128 * j + cb) = pack8(acc[ai][0][m][0] * acc[ai][1][m][0], acc[ai][0][m][1] * acc[ai][1][m][1]);
        } else if (pn < 32) {
            bf16_t* O = (bf16_t*)(ws + WS_XBC);
#pragma unroll
            for (int ai = 0; ai < 2; ++ai)
#pragma unroll
                for (int m = 0; m < 4; ++m) { bf16_t* rp = O + (size_t)(row0 + ai * 128 + m * 16) * XBCW + (pn - 20) * 256 + cb;
#pragma unroll
                    for (int bj = 0; bj < 2; ++bj) *(u32x4*)(rp + bj * 128) = pack8(acc[ai][bj][m][0], acc[ai][bj][m][1]);
                    CFENCE(); }
        } else if (pn < 48) {
            bf16_t* O = (bf16_t*)(ws + WS_G);
#pragma unroll
            for (int ai = 0; ai < 2; ++ai)
#pragma unroll
                for (int m = 0; m < 4; ++m) { bf16_t* rp = O + (size_t)(row0 + ai * 128 + m * 16) * 3072 + (pn - 36) * 256 + cb;
#pragma unroll
                    for (int bj = 0; bj < 2; ++bj) { f32x4 v0 = acc[ai][bj][m][0], v1 = acc[ai][bj][m][1];
#pragma unroll
                        for (int e = 0; e < 4; ++e) { v0[e] = sigmoidf_(v0[e]); v1[e] = sigmoidf_(v1[e]); }
                        *(u32x4*)(rp + bj * 128) = pack8(v0, v1); }
                    CFENCE(); }
        } else {
            if (wc == 0) { float* O = (float*)(ws + WS_DT); const f32x4 b0 = *(const f32x4*)(dtb + cb), b1 = *(const f32x4*)(dtb + cb + 4);
#pragma unroll
                for (int ai = 0; ai < 2; ++ai)
#pragma unroll
                    for (int m = 0; m < 4; ++m) { f32x4 v0 = acc[ai][0][m][0] + b0, v1 = acc[ai][0][m][1] + b1;
#pragma unroll
                        for (int e = 0; e < 4; ++e) { v0[e] = softplusf_(v0[e]); v1[e] = softplusf_(v1[e]); }
                        float* o = O + (size_t)(row0 + ai * 128 + m * 16) * 32 + cb; *(f32x4*)o = v0; *(f32x4*)(o + 4) = v1; CFENCE(); } }
        }
    }
};
struct SchedP5 {
    const char* ACAT; const char* WCAT; int G, c;
    DEVM bool next(int i, Unit& u) const {
        const int su = i / 3, seg = i - 3 * su; const long L = (long)su * G + c;
        if (L >= MT_P * 4) return false;
        pg8::tile_of((int)L, MT_P, 4, u.pm, u.pn); u.kind = seg; u.nt = seg == 1 ? 32 : 16;
        const size_t koff = (seg == 0 ? 0 : (seg == 1 ? 1024 : 3072)) * 2;
        u.A = ACAT + (size_t)u.pm * 256 * 4096 * 2 + koff; u.B = WCAT + (size_t)u.pn * 256 * 4096 * 2 + koff; return true;
    }
};
struct EpiP5 {
    unsigned char* ws;
    DEVM void operator()(const f32x4 (&acc)[2][2][4][2], const Unit& u, int wr, int wc, int fr, int fq) const {
        const int row0 = u.pm * 256 + wr * 64 + fr, col0 = u.pn * 256 + wc * 32 + 8 * fq, seg = u.kind;
        const bf16_t* Gt = (const bf16_t*)(ws + WS_G) + seg * 1024; float* SC = (float*)(ws + WS_MSCR); bf16_t* MG = (bf16_t*)(ws + WS_MERGED);
#pragma unroll
        for (int ai = 0; ai < 2; ++ai)
#pragma unroll
            for (int m = 0; m < 4; ++m) { const size_t row = (size_t)(row0 + ai * 128 + m * 16);
#pragma unroll
                for (int bj = 0; bj < 2; ++bj) { const int col = col0 + bj * 128; float g[8]; unpack8(*(const u32x4*)(Gt + row * 3072 + col), g);
                    f32x4 v0 = acc[ai][bj][m][0], v1 = acc[ai][bj][m][1];
#pragma unroll
                    for (int e = 0; e < 4; ++e) { v0[e] *= g[e]; v1[e] *= g[4 + e]; }
                    float* sp = SC + row * 1024 + col;
                    if (seg > 0) { v0 += *(const f32x4*)sp; v1 += *(const f32x4*)(sp + 4); }
                    if (seg < 2) { *(f32x4*)sp = v0; *(f32x4*)(sp + 4) = v1; }
                    else *(u32x4*)(MG + row * 1024 + col) = pack8(v0, v1); } }
    }
};
struct SchedPlain {
    const char* A; const char* B; int nM, nN, nt, G, c; size_t pitchB;
    DEVM bool next(int i, Unit& u) const {
        const long L = (long)i * G + c; if (L >= nM * nN) return false;
        pg8::tile_of((int)L, nM, nN, u.pm, u.pn); u.kind = 0; u.nt = nt; u.A = A + (size_t)u.pm * 256 * pitchB; u.B = B + (size_t)u.pn * 256 * pitchB; return true;
    }
};
struct EpiP6 {
    unsigned char* ws; const float* xp; const float* xs;
    DEVM void operator()(const f32x4 (&acc)[2][2][4][2], const Unit& u, int wr, int wc, int fr, int fq) const {
        const int row0 = u.pm * 256 + wr * 64 + fr, col0 = u.pn * 256 + wc * 32 + 8 * fq;
        float* X2 = (float*)(ws + WS_XP2); bf16_t* X2B = (bf16_t*)(ws + WS_XP2B); float* SS = (float*)ws + CW_SS2;
#pragma unroll
        for (int ai = 0; ai < 2; ++ai)
#pragma unroll
            for (int m = 0; m < 4; ++m) { const int row = row0 + ai * 128 + m * 16; float s = 0.f;
                const float* xr = row < MP ? xp + (size_t)row * D : (row < MP + DEC ? xs + (size_t)(row - MP) * D : nullptr);
#pragma unroll
                for (int bj = 0; bj < 2; ++bj) { const int col = col0 + bj * 128; f32x4 v0 = acc[ai][bj][m][0], v1 = acc[ai][bj][m][1];
                    if (xr) { v0 += *(const f32x4*)(xr + col); v1 += *(const f32x4*)(xr + col + 4); }
                    s += (v0[0] * v0[0] + v0[1] * v0[1]) + (v0[2] * v0[2] + v0[3] * v0[3]) + (v1[0] * v1[0] + v1[1] * v1[1]) + (v1[2] * v1[2] + v1[3] * v1[3]);
                    float* o = X2 + (size_t)row * 1024 + col; *(f32x4*)o = v0; *(f32x4*)(o + 4) = v1;
                    *(u32x4*)(X2B + (size_t)row * 1024 + col) = pack8(v0, v1); }
                s += SHFL_XOR(s, 16); s += SHFL_XOR(s, 32);
                if (fq == 0) ATOMIC_ADD_F32(SS + row, s); }
    }
};
struct EpiP7 {
    unsigned char* ws;
    DEVM void operator()(const f32x4 (&acc)[2][2][4][2], const Unit& u, int wr, int wc, int fr, int fq) const {
        const int row0 = u.pm * 256 + wr * 64 + fr, col0 = u.pn * 128 + wc * 32 + 8 * fq;
        const float* SS2 = (const float*)ws + CW_SS2; bf16_t* H = (bf16_t*)(ws + WS_HID);
#pragma unroll
        for (int ai = 0; ai < 2; ++ai)
#pragma unroll
            for (int m = 0; m < 4; ++m) { const int row = row0 + ai * 128 + m * 16; const float rs = fast_rsqrt(SS2[row] * (1.f / 1024.f) + EPS);
                f32x4 h0, h1;
#pragma unroll
                for (int e = 0; e < 4; ++e) { h0[e] = siluf_(rs * acc[ai][0][m][0][e]) * (rs * acc[ai][1][m][0][e]); h1[e] = siluf_(rs * acc[ai][0][m][1][e]) * (rs * acc[ai][1][m][1][e]); }
                *(u32x4*)(H + (size_t)row * FF + col0) = pack8(h0, h1); }
    }
};
struct EpiP8 {
    unsigned char* ws; float* out;
    DEVM void operator()(const f32x4 (&acc)[2][2][4][2], const Unit& u, int wr, int wc, int fr, int fq) const {
        const int row0 = u.pm * 256 + wr * 64 + fr, col0 = u.pn * 256 + wc * 32 + 8 * fq;
        const float* X2 = (const float*)(ws + WS_XP2); float* SS = (float*)ws + CW_SS3;
#pragma unroll
        for (int ai = 0; ai < 2; ++ai)
#pragma unroll
            for (int m = 0; m < 4; ++m) { const int row = row0 + ai * 128 + m * 16; float s = 0.f;
                float* orow = row < MP + DEC ? out + O_YP + (size_t)row * D : (float*)(ws + WS_DUMP) + (size_t)(row - MP) * D;
#pragma unroll
                for (int bj = 0; bj < 2; ++bj) { const int col = col0 + bj * 128; const float* x = X2 + (size_t)row * 1024 + col;
                    const f32x4 v0 = acc[ai][bj][m][0] + *(const f32x4*)x, v1 = acc[ai][bj][m][1] + *(const f32x4*)(x + 4);
                    s += (v0[0] * v0[0] + v0[1] * v0[1]) + (v0[2] * v0[2] + v0[3] * v0[3]) + (v1[0] * v1[0] + v1[1] * v1[1]) + (v1[2] * v1[2] + v1[3] * v1[3]);
                    *(f32x4*)(orow + col) = v0; *(f32x4*)(orow + col + 4) = v1; }
                s += SHFL_XOR(s, 16); s += SHFL_XOR(s, 32);
                if (fq == 0) ATOMIC_ADD_F32(SS + row, s); }
    }
};


template <bool AF32, bool SUMSQ>
DEV void skinny_core(Frame& F, const void* A_, size_t lda, const bf16_t* B, size_t ldb, int K, f32x4 (&acc)[2][2], float& ssq) {
    const int tid = F.tid, w = F.wave, l15 = F.lane & 15, lq = F.lane >> 4;
    LAS bf16_t* BL = (LAS bf16_t*)F.lds;
    const bf16_t* ap = (const bf16_t*)A_ + (size_t)(16 * w + l15) * lda + 8 * lq;
    const float* apf = (const float*)A_ + (size_t)(16 * w + l15) * lda + 8 * lq;
    const int r0 = tid >> 5, ch = tid & 31;
    u32x4 st[4];
#pragma unroll
    for (int hf = 0; hf < 2; ++hf)
#pragma unroll
        for (int nf = 0; nf < 2; ++nf) acc[hf][nf] = (f32x4){0.f, 0.f, 0.f, 0.f};
    BLOCK_SYNC();
#pragma unroll
    for (int i = 0; i < 4; ++i) { const int r = r0 + 16 * i; st[i] = *(const u32x4*)(B + (size_t)((r & 31) + (r >> 5) * 128) * ldb + 8 * ch); }
#pragma unroll
    for (int i = 0; i < 4; ++i) *(LAS u32x4*)(BL + (r0 + 16 * i) * 264 + 8 * ch) = st[i];
    int cur = 0;
#pragma unroll 1
    for (int k0 = 0; k0 < K; k0 += 256) { bf16x8 a[8];
        if (AF32) { f32x4 lo[8], hi[8];
#pragma unroll
            for (int u = 0; u < 8; ++u) { lo[u] = *(const f32x4*)(apf + k0 + 32 * u); hi[u] = *(const f32x4*)(apf + k0 + 32 * u + 4); }
#pragma unroll
            for (int u = 0; u < 8; ++u) { a[u] = __builtin_bit_cast(bf16x8, pack8(lo[u], hi[u]));
                if (SUMSQ) ssq += (lo[u][0] * lo[u][0] + lo[u][1] * lo[u][1]) + (lo[u][2] * lo[u][2] + lo[u][3] * lo[u][3]) + (hi[u][0] * hi[u][0] + hi[u][1] * hi[u][1]) + (hi[u][2] * hi[u][2] + hi[u][3] * hi[u][3]); } }
        else {
#pragma unroll
            for (int u = 0; u < 8; ++u) a[u] = *(const bf16x8*)(ap + k0 + 32 * u); }
        const bool more = k0 + 256 < K;
        if (more) {
#pragma unroll
            for (int i = 0; i < 4; ++i) { const int r = r0 + 16 * i; st[i] = *(const u32x4*)(B + (size_t)((r & 31) + (r >> 5) * 128) * ldb + k0 + 256 + 8 * ch); } }
        BLOCK_SYNC();
        const LAS bf16_t* bl = BL + cur * (64 * 264);
#pragma unroll
        for (int u = 0; u < 8; ++u)
#pragma unroll
            for (int hf = 0; hf < 2; ++hf)
#pragma unroll
                for (int nf = 0; nf < 2; ++nf) { const bf16x8 x = *(const LAS bf16x8*)(bl + (32 * hf + 16 * nf + l15) * 264 + 32 * u + 8 * lq); acc[hf][nf] = MFMA16(x, a[u], acc[hf][nf]); }
        if (more) {
#pragma unroll
            for (int i = 0; i < 4; ++i) *(LAS u32x4*)(BL + (cur ^ 1) * (64 * 264) + (r0 + 16 * i) * 264 + 8 * ch) = st[i]; }
        cur ^= 1; }
}
DEV u32x2 pack4(const f32x4& v) { u32x2 o; o.x = cvt_pk_bf16(v[0], v[1]); o.y = cvt_pk_bf16(v[2], v[3]); return o; }
DEV void sk_inproj_item(Frame& F, int item) {
    const int pn = item >> 2, cg = item & 3, w = F.wave, l15 = F.lane & 15, lq = F.lane >> 4, row = MP + 16 * w + l15;
    f32x4 acc[2][2];
    float dummy = 0.f; skinny_core<false, false>(F, WSP(const bf16_t, WS_XN) + (size_t)MP * 1024, 1024, WSP(const bf16_t, WS_WIN) + (size_t)(pn * 256 + 32 * cg) * 1024, 1024, 1024, acc, dummy);
#pragma unroll
    for (int nf = 0; nf < 2; ++nf) { const int cb = 32 * cg + 16 * nf + 4 * lq; f32x4 v0 = acc[0][nf], v1 = acc[1][nf];
        if (pn < 4 || (pn >= 12 && pn < 20) || (pn >= 32 && pn < 36)) { const int coff = pn < 4 ? pn * 256 : (pn < 20 ? 1024 + (pn - 12) * 256 : 3072 + (pn - 32) * 256);
            bf16_t* o = WSP(bf16_t, WS_ACAT) + (size_t)row * 4096 + coff + cb; *(u32x2*)o = pack4(v0); *(u32x2*)(o + 128) = pack4(v1); }
        else if (pn < 12) { *(u32x2*)(WSP(bf16_t, WS_U) + (size_t)row * 1024 + 128 * (pn - 4) + cb) = pack4(v0 * v1); }
        else if (pn < 32) { bf16_t* o = WSP(bf16_t, WS_XBC) + (size_t)row * XBCW + (pn - 20) * 256 + cb; *(u32x2*)o = pack4(v0); *(u32x2*)(o + 128) = pack4(v1); }
        else if (pn < 48) {
#pragma unroll
            for (int e = 0; e < 4; ++e) { v0[e] = sigmoidf_(v0[e]); v1[e] = sigmoidf_(v1[e]); }
            bf16_t* o = WSP(bf16_t, WS_G) + (size_t)row * 3072 + (pn - 36) * 256 + cb; *(u32x2*)o = pack4(v0); *(u32x2*)(o + 128) = pack4(v1); }
        else if (cg == 0) { const f32x4 b = *(const f32x4*)(F.P->in[I_DTB] + cb); f32x4 d;
#pragma unroll
            for (int e = 0; e < 4; ++e) d[e] = softplusf_(v0[e] + b[e]);
            *(f32x4*)(WSP(float, WS_DT) + (size_t)row * 32 + cb) = d; } }
}
DEV void sk_merge_item(Frame& F, int item) {
    const int pc = item >> 3, kc = item & 7, pn = pc >> 2, cg = pc & 3, w = F.wave, l15 = F.lane & 15, lq = F.lane >> 4, s = 16 * w + l15, row = MP + s;
    const int seg = kc < 2 ? 0 : (kc < 6 ? 1 : 2), koff = 512 * kc;
    f32x4 acc[2][2]; float dummy = 0.f;
    skinny_core<false, false>(F, WSP(const bf16_t, WS_ACAT) + (size_t)MP * 4096 + koff, 4096, WSP(const bf16_t, WS_WCAT) + (size_t)(pn * 256 + 32 * cg) * 4096 + koff, 4096, 512, acc, dummy);
    if (s < DEC) { float* SM = (float*)F.ws + CW_SM + (size_t)s * 1024;
#pragma unroll
        for (int hf = 0; hf < 2; ++hf)
#pragma unroll
            for (int nf = 0; nf < 2; ++nf) { const int col = pn * 256 + 128 * hf + 32 * cg + 16 * nf + 4 * lq; const u32x2 g = *(const u32x2*)(WSP(const bf16_t, WS_G) + (size_t)row * 3072 + seg * 1024 + col);
                ATOMIC_ADD_F32(SM + col, bflo(g.x) * acc[hf][nf][0]); ATOMIC_ADD_F32(SM + col + 1, bfhi(g.x) * acc[hf][nf][1]);
                ATOMIC_ADD_F32(SM + col + 2, bflo(g.y) * acc[hf][nf][2]); ATOMIC_ADD_F32(SM + col + 3, bfhi(g.y) * acc[hf][nf][3]); } }
}
DEV void sk_mergeo_item(Frame& F, int item) {
    const int pc = item >> 2, kc = item & 3, pn = pc >> 2, cg = pc & 3, w = F.wave, l15 = F.lane & 15, lq = F.lane >> 4, s = 16 * w + l15;
    f32x4 acc[2][2]; float dummy = 0.f;
    skinny_core<true, false>(F, (const float*)F.ws + CW_SM + 256 * kc, 1024, WSP(const bf16_t, WS_WMO) + (size_t)(pn * 256 + 32 * cg) * 1024 + 256 * kc, 1024, 256, acc, dummy);
    if (s < DEC) { float* X = WSP(float, WS_XP2) + (size_t)(MP + s) * 1024;
#pragma unroll
        for (int hf = 0; hf < 2; ++hf)
#pragma unroll
            for (int nf = 0; nf < 2; ++nf) { const int col = pn * 256 + 128 * hf + 32 * cg + 16 * nf + 4 * lq;
#pragma unroll
                for (int e = 0; e < 4; ++e) ATOMIC_ADD_F32(X + col + e, acc[hf][nf][e]); } }
}
DEV void sk_up_item(Frame& F, int item) {
    const int pn = item >> 2, cg = item & 3, w = F.wave, l15 = F.lane & 15, lq = F.lane >> 4, row = MP + 16 * w + l15;
    f32x4 acc[2][2]; float ssq = 0.f;
    skinny_core<true, true>(F, WSP(const float, WS_XP2) + (size_t)MP * 1024, 1024, WSP(const bf16_t, WS_WGU) + (size_t)(pn * 256 + 32 * cg) * 1024, 1024, 1024, acc, ssq);
    ssq += SHFL_XOR(ssq, 16); ssq += SHFL_XOR(ssq, 32);
    const float rs = fast_rsqrt(ssq * (1.f / 1024.f) + EPS);
#pragma unroll
    for (int nf = 0; nf < 2; ++nf) { f32x4 h;
#pragma unroll
        for (int e = 0; e < 4; ++e) h[e] = siluf_(rs * acc[0][nf][e]) * (rs * acc[1][nf][e]);
        *(u32x2*)(WSP(bf16_t, WS_HID) + (size_t)row * FF + pn * 128 + 32 * cg + 16 * nf + 4 * lq) = pack4(h); }
}
DEV void sk_down_item(Frame& F, int item) {
    const int pc = item / 11, kc = item - 11 * pc, pn = pc >> 2, cg = pc & 3, w = F.wave, l15 = F.lane & 15, lq = F.lane >> 4, s = 16 * w + l15;
    f32x4 acc[2][2]; float dummy = 0.f;
    skinny_core<false, false>(F, WSP(const bf16_t, WS_HID) + (size_t)MP * FF + 256 * kc, FF, WSP(const bf16_t, WS_WD) + (size_t)(pn * 256 + 32 * cg) * FF + 256 * kc, FF, 256, acc, dummy);
    if (s < DEC) { float* O = F.out + O_YS + (size_t)s * D;
#pragma unroll
        for (int hf = 0; hf < 2; ++hf)
#pragma unroll
            for (int nf = 0; nf < 2; ++nf) { const int col = pn * 256 + 128 * hf + 32 * cg + 16 * nf + 4 * lq;
#pragma unroll
                for (int e = 0; e < 4; ++e) ATOMIC_ADD_F32(O + col + e, acc[hf][nf][e]); } }
}
DEV void copy_sample_rows(Frame& F, const float* src, float* dst) {
    for (int i = F.bid * 512 + F.tid; i < DEC * 256; i += F.G * 512) ((f32x4*)dst)[i] = ((const f32x4*)src)[i];
}

DEV void conv8(const bf16_t* XBC, int rowbase, int t, int col, const float* cw, const float* cbias, float (&o)[8]) {
    const f32x4 b0 = *(const f32x4*)(cbias + col), b1 = *(const f32x4*)(cbias + col + 4);
    float a[8] = {b0[0], b0[1], b0[2], b0[3], b1[0], b1[1], b1[2], b1[3]};
#pragma unroll
    for (int k = 0; k < 4; ++k) { const int tt = t - 3 + k;
        if (tt >= 0) { float x[8]; unpack8(*(const u32x4*)(XBC + (size_t)(rowbase + tt) * XBCW + col), x);
            const f32x4 w0 = *(const f32x4*)(cw + k * XBCW + col), w1 = *(const f32x4*)(cw + k * XBCW + col + 4);
#pragma unroll
            for (int e = 0; e < 4; ++e) { a[e] += w0[e] * x[e]; a[4 + e] += w1[e] * x[4 + e]; } } }
#pragma unroll
    for (int e = 0; e < 8; ++e) o[e] = siluf_(a[e]);
}

DEV bf16x8 tr_frag(const LAS bf16_t* tile, int pitch, int kr0, int c0, int l15, int lq) {
    const LAS bf16_t* p = tile + (kr0 + 8 * lq + (l15 >> 2)) * pitch + c0 + 4 * (l15 & 3);
    const s16x4_t lo = LDS_TR(p), hi = LDS_TR(p + 4 * pitch);
    bf16x8 r; r[0] = lo[0]; r[1] = lo[1]; r[2] = lo[2]; r[3] = lo[3]; r[4] = hi[0]; r[5] = hi[1]; r[6] = hi[2]; r[7] = hi[3]; return r;
}
template <int N, bool SCALE>
DEV void conv_stage_rows(const bf16_t* XBC, int rowbase, int t0, int col, int ja, const float* cw, const float* cbias, LAS bf16_t* dst, int dpitch, const LAS float* rowscale, int hq) {
    const bf16_t* src = XBC + (size_t)rowbase * XBCW + col; const int tb = t0 + ja;
    u32x4 raw[N + 3];
#pragma unroll
    for (int i = 0; i < N + 3; ++i) { raw[i] = (u32x4){0u, 0u, 0u, 0u}; if (tb - 3 + i >= 0) raw[i] = *(const u32x4*)(src + (size_t)(tb - 3 + i) * XBCW); }
    float wk[4][8], bs[8], x0[8], x1[8], x2[8];
#pragma unroll
    for (int k = 0; k < 4; ++k) { const f32x4 a = *(const f32x4*)(cw + k * XBCW + col), b = *(const f32x4*)(cw + k * XBCW + col + 4);
#pragma unroll
        for (int e = 0; e < 4; ++e) { wk[k][e] = a[e]; wk[k][4 + e] = b[e]; } }
    { const f32x4 a = *(const f32x4*)(cbias + col), b = *(const f32x4*)(cbias + col + 4);
#pragma unroll
      for (int e = 0; e < 4; ++e) { bs[e] = a[e]; bs[4 + e] = b[e]; } }
    SCHEDB();
    unpack8(raw[0], x0); unpack8(raw[1], x1); unpack8(raw[2], x2);
#pragma unroll
    for (int jj = 0; jj < N; ++jj) { float x3[8], o[8]; unpack8(raw[jj + 3], x3);
        float sc = 1.f; if (SCALE) sc = rowscale[(ja + jj) * 8 + hq];
#pragma unroll
        for (int e = 0; e < 8; ++e) { o[e] = siluf_(bs[e] + wk[0][e] * x0[e] + wk[1][e] * x1[e] + wk[2][e] * x2[e] + wk[3][e] * x3[e]) * sc; x0[e] = x1[e]; x1[e] = x2[e]; x2[e] = x3[e]; }
        u32x4 pw; pw.x = pk2(o[0], o[1]); pw.y = pk2(o[2], o[3]); pw.z = pk2(o[4], o[5]); pw.w = pk2(o[6], o[7]);
        *(LAS u32x4*)(dst + (ja + jj) * dpitch) = pw; }
}
DEV void chunk_dt_acum(const float* DT, const float* alog, int row0, int g, int hq, int lane, LAS float* acum, LAS float* dtv) {
    const int h = 8 * g + hq; const float a = -expf(alog[h]);
    const float d0 = DT[(size_t)(row0 + 2 * lane) * 32 + h], d1 = DT[(size_t)(row0 + 2 * lane + 1) * 32 + h];
    const float v0 = d0 * a, v1 = v0 + d1 * a; float s = v1;
#pragma unroll
    for (int d = 1; d < 64; d <<= 1) { const float t = SHFL(s, (lane - d) & 63); if (lane >= d) s += t; }
    const float ex = s - v1;
    acum[(2 * lane) * 8 + hq] = ex + v0; acum[(2 * lane + 1) * 8 + hq] = s;
    dtv[(2 * lane) * 8 + hq] = d0; dtv[(2 * lane + 1) * 8 + hq] = d1;
}

DEV void ssd_states_item(Frame& F, int item) {
    const int g = item & 3, c = (item >> 2) % NCH, b = (item >> 2) / NCH;
    const int tid = F.tid, lane = F.lane, w = F.wave, l15 = lane & 15, lq = lane >> 4;
    LAS float* acum = (LAS float*)F.lds; LAS float* dtv = acum + 1024; LAS float* wgt = acum + 2048;
    LAS bf16_t* BL = (LAS bf16_t*)(F.lds + 12288);
    LAS bf16_t* XL = (LAS bf16_t*)(F.lds + 12288 + 34816);
    const bf16_t* XBC = WSP(const bf16_t, WS_XBC); const float* DT = WSP(const float, WS_DT);
    const float* cw = F.P->in[I_SSMCW]; const float* cbias = F.P->in[I_SSMCB];
    const int rowbase = b * SEQ, t0 = c * 128, row0 = rowbase + t0;
    BLOCK_SYNC();
    chunk_dt_acum(DT, F.P->in[I_ALOG], row0, g, w, lane, acum, dtv);
    BLOCK_SYNC();
    for (int i = tid; i < 1024; i += 512) wgt[i] = expf(acum[127 * 8 + (i & 7)] - acum[i]) * dtv[i];
    if (tid < 8) WSP(float, WS_CDEC)[(size_t)(b * NCH + c) * 32 + 8 * g + tid] = expf(acum[127 * 8 + tid]);
    BLOCK_SYNC();
#pragma unroll 1
    for (int task = tid; task < 768; task += 512) { const int cgI = task % 48, seg = task / 48;
        if (cgI < 16) conv_stage_rows<8, false>(XBC, rowbase, t0, DIN + g * 128 + 8 * cgI, 8 * seg, cw, cbias, BL + 8 * cgI, 136, wgt, 0);
        else { const int c2 = cgI - 16, hh = c2 >> 3; conv_stage_rows<8, true>(XBC, rowbase, t0, (8 * g + hh) * 64 + 8 * (c2 & 7), 8 * seg, cw, cbias, XL + 8 * c2, 264, wgt, hh); } }
    BLOCK_SYNC();
    bf16x8 afr[4];
#pragma unroll
    for (int ks = 0; ks < 4; ++ks) afr[ks] = tr_frag(BL, 136, 32 * ks, 16 * w, l15, lq);
    bf16_t* CH = WSP(bf16_t, WS_CHST);
#pragma unroll 1
    for (int hb = 0; hb < 2; ++hb) {
        if (hb) { BLOCK_SYNC();
            { const int c2 = tid & 31, seg = tid >> 5, hh = c2 >> 3; conv_stage_rows<8, true>(XBC, rowbase, t0, (8 * g + 4 + hh) * 64 + 8 * (c2 & 7), 8 * seg, cw, cbias, XL + 8 * c2, 264, wgt, 4 + hh); }
            BLOCK_SYNC(); }
#pragma unroll
        for (int hh = 0; hh < 4; ++hh) { const int h = 8 * g + 4 * hb + hh;
#pragma unroll
            for (int pf = 0; pf < 4; ++pf) { f32x4 a4 = (f32x4){0.f, 0.f, 0.f, 0.f};
#pragma unroll
                for (int ks = 0; ks < 4; ++ks) a4 = MFMA16(afr[ks], tr_frag(XL, 264, 32 * ks, hh * 64 + 16 * pf, l15, lq), a4);
                u32x2 o; o.x = pk2(a4[0], a4[1]); o.y = pk2(a4[2], a4[3]);
                *(u32x2*)(CH + ((size_t)(b * NCH + c) * 32 + h) * 8192 + (16 * pf + l15) * 128 + 16 * w + 4 * lq) = o; } }
    }
}

DEV void attn_item(Frame& F, int item) {
    const int qt = item % (SEQ / 128), h = (item / (SEQ / 128)) & 3, b = item / (SEQ / 128) / 4;
    const int tid = F.tid, lane = F.lane, w = F.wave, l15 = lane & 15, lq = lane >> 4;
    LAS bf16_t* KL = (LAS bf16_t*)F.lds;
    const bf16_t* KBh = WSP(const bf16_t, WS_KB) + (size_t)(b * HEADS + h) * MEM * HD;
    const bf16_t* VTh = WSP(const bf16_t, WS_VT) + (size_t)(b * HEADS + h) * MEM * HD;
    bf16_t* QO = WSP(bf16_t, WS_ACAT) + (size_t)(b * SEQ + qt * 128 + 16 * w + l15) * 4096 + 3072 + h * HD;
    BLOCK_SYNC();
#pragma unroll 4
    for (int it = 0; it < 16; ++it) { const int idx = tid + 512 * it, row = idx >> 5, ch = idx & 31; *(LAS u32x4*)(KL + row * 264 + 8 * ch) = *(const u32x4*)(KBh + row * 256 + 8 * ch); }
    bf16x8 qf[8];
#pragma unroll
    for (int ks = 0; ks < 8; ++ks) qf[ks] = *(const bf16x8*)(QO + 32 * ks + 8 * lq);
    BLOCK_SYNC();
    f32x4 st[16];
#pragma unroll
    for (int kf = 0; kf < 16; ++kf) { f32x4 a4 = (f32x4){0.f, 0.f, 0.f, 0.f};
#pragma unroll
        for (int ks = 0; ks < 8; ++ks) { const bf16x8 afr = *(const LAS bf16x8*)(KL + (16 * kf + l15) * 264 + 32 * ks + 8 * lq); a4 = MFMA16(afr, qf[ks], a4); }
        st[kf] = a4; }
    float mx = -3.0e38f;
#pragma unroll
    for (int kf = 0; kf < 16; ++kf) mx = fmaxf(fmaxf(fmaxf(st[kf][0], st[kf][1]), fmaxf(st[kf][2], st[kf][3])), mx);
    mx = fmaxf(mx, SHFL_XOR(mx, 16)); mx = fmaxf(mx, SHFL_XOR(mx, 32));
    float sum = 0.f;
#pragma unroll
    for (int kf = 0; kf < 16; ++kf)
#pragma unroll
        for (int r = 0; r < 4; ++r) { const float p = fast_exp((st[kf][r] - mx) * 0.0625f); st[kf][r] = p; sum += p; }
    sum += SHFL_XOR(sum, 16); sum += SHFL_XOR(sum, 32);
    const float inv = 1.0f / sum;
    u32x2 pk[16];
#pragma unroll
    for (int kf = 0; kf < 16; ++kf) { pk[kf].x = pk2(st[kf][0] * inv, st[kf][1] * inv); pk[kf].y = pk2(st[kf][2] * inv, st[kf][3] * inv); }
    BLOCK_SYNC();
#pragma unroll 4
    for (int it = 0; it < 16; ++it) { const int idx = tid + 512 * it, row = idx >> 5, ch = idx & 31; *(LAS u32x4*)(KL + row * 264 + 8 * ch) = *(const u32x4*)(VTh + row * 256 + 8 * ch); }
    BLOCK_SYNC();
#pragma unroll
    for (int df = 0; df < 16; ++df) { f32x4 a4 = (f32x4){0.f, 0.f, 0.f, 0.f};
#pragma unroll
        for (int s = 0; s < 8; ++s) { const LAS bf16_t* vp = KL + (16 * df + l15) * 264 + 32 * s + 4 * lq;
            const u32x2 lo = *(const LAS u32x2*)vp, hi = *(const LAS u32x2*)(vp + 16);
            u32x4 av; av.x = lo.x; av.y = lo.y; av.z = hi.x; av.w = hi.y;
            u32x4 bv; bv.x = pk[2 * s].x; bv.y = pk[2 * s].y; bv.z = pk[2 * s + 1].x; bv.w = pk[2 * s + 1].y;
            a4 = MFMA16(__builtin_bit_cast(bf16x8, av), __builtin_bit_cast(bf16x8, bv), a4); }
        u32x2 o; o.x = pk2(a4[0], a4[1]); o.y = pk2(a4[2], a4[3]);
        if (!F.dry) *(u32x2*)(QO + 16 * df + 4 * lq) = o; }
}

DEV void yain_item(Frame& F, int item) {
    const bf16_t* U = WSP(const bf16_t, WS_U); const float* w = F.P->in[I_SCW];
    const int col = 8 * (F.tid & 127), r0 = item * 16 + (F.tid >> 7);
    u32x4 ru[4][3], rs[4];
#pragma unroll
    for (int q = 0; q < 4; ++q) { const int row = r0 + 4 * q, t = row % SEQ;
#pragma unroll
        for (int k = 0; k < 3; ++k) { ru[q][k] = (u32x4){0u, 0u, 0u, 0u}; if (t - 2 + k >= 0) ru[q][k] = *(const u32x4*)(U + (size_t)(row - 2 + k) * 1024 + col); }
        rs[q] = *(const u32x4*)(WSP(const bf16_t, WS_ACAT) + (size_t)row * 4096 + col); }
    const f32x4 w0a = *(const f32x4*)(w + col), w0b = *(const f32x4*)(w + col + 4), w1a = *(const f32x4*)(w + 1024 + col), w1b = *(const f32x4*)(w + 1024 + col + 4),
                w2a = *(const f32x4*)(w + 2048 + col), w2b = *(const f32x4*)(w + 2048 + col + 4);
    const float w0[8] = {w0a[0], w0a[1], w0a[2], w0a[3], w0b[0], w0b[1], w0b[2], w0b[3]}, w1[8] = {w1a[0], w1a[1], w1a[2], w1a[3], w1b[0], w1b[1], w1b[2], w1b[3]},
                w2[8] = {w2a[0], w2a[1], w2a[2], w2a[3], w2b[0], w2b[1], w2b[2], w2b[3]};
#pragma unroll
    for (int q = 0; q < 4; ++q) { float u0[8], u1[8], u2[8], sb[8], y[8];
        unpack8(ru[q][0], u0); unpack8(ru[q][1], u1); unpack8(ru[q][2], u2); unpack8(rs[q], sb);
#pragma unroll
        for (int e = 0; e < 8; ++e) y[e] = sb[e] * (w0[e] * u0[e] + w1[e] * u1[e] + w2[e] * u2[e]);
        u32x4 o; o.x = pk2(y[0], y[1]); o.y = pk2(y[2], y[3]); o.z = pk2(y[4], y[5]); o.w = pk2(y[6], y[7]);
        if (!F.dry) *(u32x4*)(WSP(bf16_t, WS_ACAT) + (size_t)(r0 + 4 * q) * 4096 + col) = o; }
}
DEV void pstate_item(Frame& F, int b) {
    const bf16_t* U = WSP(const bf16_t, WS_U); const bf16_t* XBC = WSP(const bf16_t, WS_XBC);
    for (int i = F.tid; i < 2 * 1024; i += 512) { const int k = i >> 10, cc = i & 1023; F.out[O_PCONV + (size_t)(b * 2 + k) * 1024 + cc] = bf1(U[(size_t)(b * SEQ + SEQ - 2 + k) * 1024 + cc]); }
    for (int i = F.tid; i < 3 * XBCW; i += 512) { const int k = i / XBCW, cc = i - k * XBCW; F.out[O_PSSMC + (size_t)(b * 3 + k) * XBCW + cc] = bf1(XBC[(size_t)(b * SEQ + SEQ - 3 + k) * XBCW + cc]); }
}
DEV void s_sconv_item(Frame& F, int item) {
    const int s = item * 4 + (F.tid >> 7), col = 8 * (F.tid & 127), row = MP + s;
    const bf16_t* U = WSP(const bf16_t, WS_U); bf16_t* A = WSP(bf16_t, WS_ACAT) + (size_t)row * 4096 + col; const float* w = F.P->in[I_SCW];
    const float* h0 = F.P->in[I_SCONV] + (size_t)(s * 2) * 1024 + col; const float* h1 = h0 + 1024;
    float un[8], sb[8], y[8];
    unpack8(*(const u32x4*)(U + (size_t)row * 1024 + col), un); unpack8(*(const u32x4*)A, sb);
    float* oc = F.out + O_SCONV + (size_t)(s * 2) * 1024 + col;
#pragma unroll
    for (int e = 0; e < 8; ++e) { y[e] = sb[e] * (w[col + e] * h0[e] + w[1024 + col + e] * h1[e] + w[2048 + col + e] * un[e]); oc[e] = h1[e]; oc[1024 + e] = un[e]; }
    u32x4 o; o.x = pk2(y[0], y[1]); o.y = pk2(y[2], y[3]); o.z = pk2(y[4], y[5]); o.w = pk2(y[6], y[7]);
    if (!F.dry) *(u32x4*)A = o;
}
DEV void s_ssmconv_state_item(Frame& F, int s) {
    const bf16_t* XBC = WSP(const bf16_t, WS_XBC) + (size_t)(MP + s) * XBCW; const float* hist = F.P->in[I_SSMCONV] + (size_t)s * 3 * XBCW; float* o = F.out + O_SSSMC + (size_t)s * 3 * XBCW;
    for (int i = F.tid; i < XBCW; i += 512) { o[i] = hist[XBCW + i]; o[XBCW + i] = hist[2 * XBCW + i]; o[2 * XBCW + i] = bf1(XBC[i]); }
}
DEV void s_ssd_item(Frame& F, int item) {
    const int g = item & 3, s = item >> 2, tid = F.tid, row = MP + s;
    LAS float* xc = (LAS float*)F.lds;
    LAS float* yb = xc + 768;
    LAS float* red = yb + 512;
    const bf16_t* XBC = WSP(const bf16_t, WS_XBC) + (size_t)row * XBCW; const float* hist = F.P->in[I_SSMCONV] + (size_t)s * 3 * XBCW;
    const float* cw = F.P->in[I_SSMCW]; const float* cbias = F.P->in[I_SSMCB];
    const int n4 = (tid & 31) * 4, pb = tid >> 5;
    const float* s0 = F.P->in[I_SSM] + ((size_t)s * 32 + 8 * g) * 8192 + pb * 128 + n4; float* s1 = F.out + O_SSSM + ((size_t)s * 32 + 8 * g) * 8192 + pb * 128 + n4;
    f32x4 so[4];
#pragma unroll
    for (int k = 0; k < 4; ++k) so[k] = *(const f32x4*)(s0 + 16 * k * 128);
    BLOCK_SYNC();
    for (int i = tid; i < 768; i += 512) { const int col = i < 512 ? g * 512 + i : (i < 640 ? DIN + g * 128 + (i - 512) : DIN + 512 + g * 128 + (i - 640));
        const float v = cbias[col] + cw[col] * hist[col] + cw[XBCW + col] * hist[XBCW + col] + cw[2 * XBCW + col] * hist[2 * XBCW + col] + cw[3 * XBCW + col] * bf1(XBC[col]);
        xc[i] = siluf_(v); }
    BLOCK_SYNC();
    const f32x4 Bv = *(const LAS f32x4*)(xc + 512 + n4), Cv = *(const LAS f32x4*)(xc + 640 + n4);
    const bf16_t* Z = WSP(const bf16_t, WS_ACAT) + (size_t)row * 4096 + 1024;
#pragma unroll 1
    for (int hq = 0; hq < 8; ++hq) { const int h = 8 * g + hq; const float dt = WSP(const float, WS_DT)[(size_t)row * 32 + h];
        const float dA = expf(dt * (-expf(F.P->in[I_ALOG][h]))), Dh = F.P->in[I_SSMD][h];
        f32x4 sn_[4];
#pragma unroll
        for (int k = 0; k < 4; ++k) sn_[k] = so[k];
        if (hq < 7) {
#pragma unroll
            for (int k = 0; k < 4; ++k) so[k] = *(const f32x4*)(s0 + (size_t)(hq + 1) * 8192 + 16 * k * 128); }
#pragma unroll
        for (int k = 0; k < 4; ++k) { const int p = pb + 16 * k; const float xv = xc[hq * 64 + p], dx = dt * xv; f32x4 sn;
#pragma unroll
            for (int e = 0; e < 4; ++e) sn[e] = sn_[k][e] * dA + dx * Bv[e];
            *(f32x4*)(s1 + (size_t)hq * 8192 + 16 * k * 128) = sn;
            float y = (sn[0] * Cv[0] + sn[1] * Cv[1]) + (sn[2] * Cv[2] + sn[3] * Cv[3]);
            y += SHFL_XOR(y, 1); y += SHFL_XOR(y, 2); y += SHFL_XOR(y, 4); y += SHFL_XOR(y, 8); y += SHFL_XOR(y, 16);
            if ((tid & 31) == 0) { y += Dh * xv; yb[hq * 64 + p] = y * siluf_(bf1(Z[h * 64 + p])); } } }
    BLOCK_SYNC();
    const float yv = yb[tid]; const float ssw = wave_sum(yv * yv);
    if (F.lane == 0) red[F.wave] = ssw;
    BLOCK_SYNC();
    float tot = 0.f;
#pragma unroll
    for (int i = 0; i < 8; ++i) tot += red[i];
    const float rs = fast_rsqrt(tot * (1.f / 512.f) + EPS);
    if (!F.dry) WSP(bf16_t, WS_ACAT)[(size_t)row * 4096 + 1024 + g * 512 + tid] = (bf16_t)f2bf(yv * rs * F.P->in[I_SSMNW][g * 512 + tid]);
}
DEV void s_attn_item(Frame& F, int item) {
    const int h = item & 3, s = item >> 2, tid = F.tid, lane = F.lane, w = F.wave, row = MP + s;
    LAS float* sc = (LAS float*)F.lds;
    LAS float* part = sc + 256;
    bf16_t* QO = WSP(bf16_t, WS_ACAT) + (size_t)row * 4096 + 3072 + h * HD;
    const float* Kc = F.P->in[I_CK] + ((size_t)s * MEM * HEADS + h) * HD + 4 * lane; const float* Vc = F.P->in[I_CV] + ((size_t)s * MEM * HEADS + h) * HD + 4 * lane;
    BLOCK_SYNC();
    const u32x2 qw = *(const u32x2*)(QO + 4 * lane); const float q0 = bflo(qw.x), q1 = bfhi(qw.x), q2 = bflo(qw.y), q3 = bfhi(qw.y);
#pragma unroll 1
    for (int i0 = 0; i0 < 32; i0 += 8) { f32x4 kv[8];
#pragma unroll
        for (int u = 0; u < 8; ++u) kv[u] = *(const f32x4*)(Kc + (size_t)(32 * w + i0 + u) * (HEADS * HD));
#pragma unroll
        for (int u = 0; u < 8; ++u) { const float d = wave_sum((kv[u][0] * q0 + kv[u][1] * q1) + (kv[u][2] * q2 + kv[u][3] * q3)); if (lane == 0) sc[32 * w + i0 + u] = d * 0.0625f; } }
    BLOCK_SYNC();
    if (w == 0) { const f32x4 v = *(const LAS f32x4*)(sc + 4 * lane); float mx = fmaxf(fmaxf(v[0], v[1]), fmaxf(v[2], v[3]));
#pragma unroll
        for (int o = 1; o < 64; o <<= 1) mx = fmaxf(mx, SHFL_XOR(mx, o));
        f32x4 p; float sm = 0.f;
#pragma unroll
        for (int e = 0; e < 4; ++e) { p[e] = expf(v[e] - mx); sm += p[e]; }
        sm = wave_sum(sm); const float inv = 1.f / sm;
        *(LAS f32x4*)(sc + 4 * lane) = p * inv; }
    BLOCK_SYNC();
    f32x4 acc = (f32x4){0.f, 0.f, 0.f, 0.f};
#pragma unroll 1
    for (int i0 = 0; i0 < 32; i0 += 8) { f32x4 vv[8];
#pragma unroll
        for (int u = 0; u < 8; ++u) vv[u] = *(const f32x4*)(Vc + (size_t)(32 * w + i0 + u) * (HEADS * HD));
#pragma unroll
        for (int u = 0; u < 8; ++u) acc += vv[u] * sc[32 * w + i0 + u]; }
    *(LAS f32x4*)(part + w * 256 + 4 * lane) = acc;
    BLOCK_SYNC();
    if (tid < 256 && !F.dry) { float o = 0.f;
#pragma unroll
        for (int k = 0; k < 8; ++k) o += part[k * 256 + tid];
        QO[tid] = (bf16_t)f2bf(o); }
}

DEV void p3_scan(Frame& F) {
    bf16_t* CH = WSP(bf16_t, WS_CHST); const float* CDEC = WSP(const float, WS_CDEC);
    const int ntask = BATCH * 32 * 64 * 32;
    for (int i = F.bid * 512 + F.tid; i < ntask; i += F.G * 512) {
        const int n4 = (i & 31) * 4, p = (i >> 5) & 63, h = (i >> 11) & 31, b = i >> 16;
        f32x4 S = (f32x4){0.f, 0.f, 0.f, 0.f};
#pragma unroll 1
        for (int c = 0; c < NCH; ++c) { bf16_t* q = CH + ((size_t)(b * NCH + c) * 32 + h) * 8192 + p * 128 + n4; const u32x2 raw = *(const u32x2*)q; const float dec = CDEC[(size_t)(b * NCH + c) * 32 + h];
            u32x2 o; o.x = pk2(S[0], S[1]); o.y = pk2(S[2], S[3]); if (!F.dry) *(u32x2*)q = o;
            S[0] = S[0] * dec + bflo(raw.x); S[1] = S[1] * dec + bfhi(raw.x); S[2] = S[2] * dec + bflo(raw.y); S[3] = S[3] * dec + bfhi(raw.y); }
        *(f32x4*)(F.out + O_PSSM + ((size_t)(b * 32 + h) * 64 + p) * 128 + n4) = S;
    }
}

DEV void ssd_out_item(Frame& F, int item) {
    const int g = item & 3, c = (item >> 2) % NCH, b = (item >> 2) / NCH;
    const int tid = F.tid, lane = F.lane, w = F.wave, l15 = lane & 15, lq = lane >> 4;
    LAS float* acum = (LAS float*)F.lds; LAS float* dtv = acum + 1024;
    LAS bf16_t* CL = (LAS bf16_t*)(F.lds + 8192);
    LAS bf16_t* BL = (LAS bf16_t*)(F.lds + 8192 + 34816);
    LAS bf16_t* XL = (LAS bf16_t*)(F.lds + 8192);
    LAS bf16_t* SL = (LAS bf16_t*)(F.lds + 8192 + 69632);
    LAS bf16_t* MW = (LAS bf16_t*)(F.lds + 8192 + 69632 + 17408) + w * 2176;
    const bf16_t* XBC = WSP(const bf16_t, WS_XBC); const float* DT = WSP(const float, WS_DT);
    const float* cw = F.P->in[I_SSMCW]; const float* cbias = F.P->in[I_SSMCB];
    const int rowbase = b * SEQ, t0 = c * 128, row0 = rowbase + t0;
    BLOCK_SYNC();
    chunk_dt_acum(DT, F.P->in[I_ALOG], row0, g, w, lane, acum, dtv);
    { const int cgI = tid & 31, seg = tid >> 5, isC = cgI >> 4;
      conv_stage_rows<8, false>(XBC, rowbase, t0, DIN + isC * 512 + g * 128 + 8 * (cgI & 15), 8 * seg, cw, cbias, (isC ? CL : BL) + 8 * (cgI & 15), 136, acum, 0); }
    BLOCK_SYNC();
    bf16x8 cfr[4];
#pragma unroll
    for (int ks = 0; ks < 4; ++ks) cfr[ks] = *(const LAS bf16x8*)(CL + (16 * w + l15) * 136 + 32 * ks + 8 * lq);
    f32x4 cb[8];
#pragma unroll
    for (int jf = 0; jf < 8; ++jf) { f32x4 a4 = (f32x4){0.f, 0.f, 0.f, 0.f};
#pragma unroll
        for (int ks = 0; ks < 4; ++ks) { const bf16x8 bfr = *(const LAS bf16x8*)(BL + (16 * jf + l15) * 136 + 32 * ks + 8 * lq); a4 = MFMA16(bfr, cfr[ks], a4); }
        cb[jf] = a4; }
    const int il = 16 * w + l15;
    bf16_t* Zrow = WSP(bf16_t, WS_ACAT) + (size_t)(row0 + il) * 4096 + 1024;
    const bf16_t* SP = WSP(const bf16_t, WS_CHST);
    u32x2 ykeep[8][4]; float ss = 0.f;
#pragma unroll
    for (int a = 0; a < 8; ++a)
#pragma unroll
        for (int pf = 0; pf < 4; ++pf) ykeep[a][pf] = (u32x2){0u, 0u};
#pragma unroll 1
    for (int hq = 0; hq < 8; ++hq) { const int h = 8 * g + hq, hh = hq & 3;
        BLOCK_SYNC();
        if (hh == 0) { const int c2 = tid & 31, seg = tid >> 5;
            conv_stage_rows<8, false>(XBC, rowbase, t0, (8 * g + hq + (c2 >> 3)) * 64 + 8 * (c2 & 7), 8 * seg, cw, cbias, XL + 8 * c2, 264, acum, 0); }
#pragma unroll 1
        for (int it = 0; it < 2; ++it) { const int idx = tid + 512 * it, p = idx >> 4, ch = idx & 15;
            *(LAS u32x4*)(SL + p * 136 + 8 * ch) = *(const u32x4*)(SP + ((size_t)(b * NCH + c) * 32 + h) * 8192 + p * 128 + 8 * ch); }
        const float ai_ = acum[il * 8 + hq];
#pragma unroll
        for (int jf = 0; jf < 8; ++jf) { const int j0 = 16 * jf + 4 * lq; float mv[4];
#pragma unroll
            for (int r = 0; r < 4; ++r) { const int j = j0 + r; const float e = fast_exp(fminf(ai_ - acum[j * 8 + hq], 0.f)) * dtv[j * 8 + hq]; mv[r] = j <= il ? cb[jf][r] * e : 0.f; }
            u32x2 o; o.x = pk2(mv[0], mv[1]); o.y = pk2(mv[2], mv[3]); *(LAS u32x2*)(MW + l15 * 136 + j0) = o; }
        BLOCK_SYNC();
        f32x4 yd[4], yo[4];
#pragma unroll
        for (int pf = 0; pf < 4; ++pf) { yd[pf] = (f32x4){0.f, 0.f, 0.f, 0.f}; yo[pf] = (f32x4){0.f, 0.f, 0.f, 0.f}; }
#pragma unroll
        for (int ks = 0; ks < 4; ++ks) { const bf16x8 mfr = *(const LAS bf16x8*)(MW + l15 * 136 + 32 * ks + 8 * lq);
#pragma unroll
            for (int pf = 0; pf < 4; ++pf) yd[pf] = MFMA16(tr_frag(XL, 264, 32 * ks, hh * 64 + 16 * pf, l15, lq), mfr, yd[pf]); }
#pragma unroll
        for (int ks = 0; ks < 4; ++ks)
#pragma unroll
            for (int pf = 0; pf < 4; ++pf) { const bf16x8 sfr = *(const LAS bf16x8*)(SL + (16 * pf + l15) * 136 + 32 * ks + 8 * lq); yo[pf] = MFMA16(sfr, cfr[ks], yo[pf]); }
        const float ei = expf(ai_), Dh = F.P->in[I_SSMD][h];
#pragma unroll
        for (int pf = 0; pf < 4; ++pf) { const int p0 = 16 * pf + 4 * lq;
            const u32x2 xw = *(const LAS u32x2*)(XL + il * 264 + hh * 64 + p0); const u32x2 zw = *(const u32x2*)(Zrow + h * 64 + p0);
            const float xv[4] = {bflo(xw.x), bfhi(xw.x), bflo(xw.y), bfhi(xw.y)}, zv[4] = {bflo(zw.x), bfhi(zw.x), bflo(zw.y), bfhi(zw.y)}; float y[4];
#pragma unroll
            for (int r = 0; r < 4; ++r) { y[r] = (yd[pf][r] + ei * yo[pf][r] + Dh * xv[r]) * siluf_(zv[r]); ss += y[r] * y[r]; }
            u32x2 yn; yn.x = pk2(y[0], y[1]); yn.y = pk2(y[2], y[3]);
#pragma unroll
            for (int a = 0; a < 7; ++a) ykeep[a][pf] = ykeep[a + 1][pf];
            ykeep[7][pf] = yn; }
    }
    ss += SHFL_XOR(ss, 16); ss += SHFL_XOR(ss, 32);
    const float rs = fast_rsqrt(ss * (1.f / 512.f) + EPS); const float* nw = F.P->in[I_SSMNW] + g * 512;
#pragma unroll
    for (int hq = 0; hq < 8; ++hq)
#pragma unroll
        for (int pf = 0; pf < 4; ++pf) { const int cidx = hq * 64 + 16 * pf + 4 * lq; const f32x4 wv = *(const f32x4*)(nw + cidx); const u32x2 k = ykeep[hq][pf];
            u32x2 o; o.x = pk2(bflo(k.x) * rs * wv[0], bfhi(k.x) * rs * wv[1]); o.y = pk2(bflo(k.y) * rs * wv[2], bfhi(k.y) * rs * wv[3]);
            if (!F.dry) *(u32x2*)(Zrow + g * 512 + cidx) = o; }
}

DEV void p9_final(Frame& F) {
    const int gw = F.bid * 8 + F.wave, NGW = F.G * 8, lane = F.lane; const float* SS3 = (const float*)F.ws + CW_SS3; const f32x4* wv = (const f32x4*)F.P->in[I_NFIN] + lane;
    for (int m = gw; m < MP + DEC; m += NGW) { f32x4* x = (f32x4*)(F.out + O_YP + (size_t)m * D) + lane; f32x4 v[4]; float rs;
#pragma unroll
        for (int j = 0; j < 4; ++j) v[j] = x[64 * j];
        if (m < MP) rs = fast_rsqrt(SS3[m] * (1.f / 1024.f) + EPS);
        else { float s = 0.f;
#pragma unroll
            for (int j = 0; j < 4; ++j) s += (v[j][0] * v[j][0] + v[j][1] * v[j][1]) + (v[j][2] * v[j][2] + v[j][3] * v[j][3]);
            rs = fast_rsqrt(wave_sum(s) * (1.f / 1024.f) + EPS); }
#pragma unroll
        for (int j = 0; j < 4; ++j) { const f32x4 ww = wv[64 * j]; f32x4 o = v[j] * rs; o = o * ww; x[64 * j] = o; } }
}

constexpr int N_PHASES = 10;
#ifndef PH_MASK
#define PH_MASK 0x3ff
#endif
#define PH_ON(k) ((PH_MASK >> (k)) & 1)
DEV void run_phase(const Frame& F0, int ph) {
    if (!((PH_MASK >> ph) & 1)) return;
    Frame F = F0;
    OPAQUE_V(F.tid); OPAQUE_S(F.bid); OPAQUE_S(F.G);
    F.lane = F.tid & 63; F.wave = RFL(F.tid >> 6);
    const int G = F.G, bid = F.bid;
    if (ph == 0) { p0_prep(F); }
    else if (ph == 1) {
        SchedP1 S{(const char*)(F.ws + WS_XN), (const char*)(F.ws + WS_WIN), (const char*)(F.ws + WS_MEMN), (const char*)(F.ws + WS_WKV), G, bid};
        EpiP1 E{F.ws, F.out, F.P->in[I_DTB]};
        { const int hb = G / 2; if (bid >= hb) for (int it = bid - hb; it < IN_TILES * 4; it += G - hb) sk_inproj_item(F, it); }
        BLOCK_SYNC();
        pg8::gemm_phase(F.lds, 1024, S, E);
    } else if (ph == 2) {
        constexpr int N_ATT = BATCH * HEADS * (SEQ / 128), N_ST = BATCH * NCH * 4, N_SATT = DEC * 4, N_YA = MP / 16, N_SSC = DEC / 4, N_SST = DEC, N_PST = BATCH;
        constexpr int TOT = N_ATT + N_ST + N_SATT + N_YA + N_SSC + N_SST + N_PST;
        const int nk = bid < TOT ? (TOT - 1 - bid) / G + 1 : 0;
        for (int k = 0; k < nk; ++k) { int r = bid + ((bid & 1) ? nk - 1 - k : k) * G;
            Frame Fi = F; OPAQUE_V(Fi.tid); Fi.lane = Fi.tid & 63;
            if (r < N_ATT) { if (F.sub & 1) attn_item(Fi, r); continue; } r -= N_ATT;
            if (r < N_ST) { if (F.sub & 2) ssd_states_item(Fi, r); continue; } r -= N_ST;
            if (r < N_SATT) { if (F.sub & 4) s_attn_item(Fi, r); continue; } r -= N_SATT;
            if (r < N_YA) { if (F.sub & 16) yain_item(Fi, r); continue; } r -= N_YA;
            if (r < N_SSC) { if (F.sub & 32) s_sconv_item(Fi, r); continue; } r -= N_SSC;
            if (r < N_SST) { if (F.sub & 32) s_ssmconv_state_item(Fi, r); continue; } r -= N_SST;
            if (F.sub & 32) pstate_item(Fi, r); }
    } else if (ph == 3) { p3_scan(F); }
    else if (ph == 4) {
        constexpr int N_OUT = BATCH * NCH * 4, TOT = N_OUT + DEC * 4;
        const int nk = bid < TOT ? (TOT - 1 - bid) / G + 1 : 0;
        for (int k = 0; k < nk; ++k) { const int r = bid + ((bid & 1) ? nk - 1 - k : k) * G; Frame Fi = F; OPAQUE_V(Fi.tid); Fi.lane = Fi.tid & 63;
            if (r < N_OUT) { if (F.sub & 1) ssd_out_item(Fi, r); } else { if (F.sub & 8) s_ssd_item(Fi, r - N_OUT); } }
    }
    else if (ph == 5) {
        SchedP5 S{(const char*)(F.ws + WS_ACAT), (const char*)(F.ws + WS_WCAT), G, bid}; EpiP5 E{F.ws};
        copy_sample_rows(F, F.P->in[I_XS], WSP(float, WS_XP2) + (size_t)MP * 1024);
        for (int it = bid; it < 128; it += G) sk_merge_item(F, it);
        BLOCK_SYNC();
        pg8::gemm_phase(F.lds, 4096, S, E);
    } else if (ph == 6) {
        SchedPlain S{(const char*)(F.ws + WS_MERGED), (const char*)(F.ws + WS_WMO), MT_P, 4, 16, G, bid, (size_t)1024 * 2}; EpiP6 E{F.ws, F.P->in[I_XP], F.P->in[I_XS]};
        for (int it = bid; it < 64; it += G) sk_mergeo_item(F, it);
        BLOCK_SYNC();
        pg8::gemm_phase(F.lds, 1024, S, E);
    } else if (ph == 7) {
        SchedPlain S{(const char*)(F.ws + WS_XP2B), (const char*)(F.ws + WS_WGU), MT_P, GU_TILES, 16, G, bid, (size_t)1024 * 2}; EpiP7 E{F.ws};
        copy_sample_rows(F, WSP(const float, WS_XP2) + (size_t)MP * 1024, F.out + O_YS);
        { const int hb = G / 2; if (bid >= hb) for (int it = bid - hb; it < GU_TILES * 4; it += G - hb) sk_up_item(F, it); }
        BLOCK_SYNC();
        pg8::gemm_phase(F.lds, 1024, S, E);
    } else if (ph == 8) {
        SchedPlain S{(const char*)(F.ws + WS_HID), (const char*)(F.ws + WS_WD), MT_P, 4, FF / 64, G, bid, (size_t)FF * 2}; EpiP8 E{F.ws, F.out};
        for (int it = bid; it < 176; it += G) sk_down_item(F, it);
        BLOCK_SYNC();
        pg8::gemm_phase(F.lds, FF, S, E);
    } else if (ph == 9) { p9_final(F); }
}

#ifndef HOST_EMU
#define XB_TMO      128
#define XB_XCNT(j)  (256  + 64 * (j))
#define XB_XSUB(j)  (1280 + 64 * (j))
#define XB_XGEN(j)  (2304 + 64 * (j))
#define XB_TOP      3328
#define XB_TOPGEN   3392
#define XCD_BAR_WORDS 3456
#define XB_SPIN_CAP (1u << 18)
__device__ __forceinline__ unsigned xb_ld(unsigned* p)              { return __hip_atomic_load(p, __ATOMIC_RELAXED, __HIP_MEMORY_SCOPE_AGENT); }
__device__ __forceinline__ unsigned xb_add(unsigned* p, unsigned v) { return __hip_atomic_fetch_add(p, v, __ATOMIC_RELAXED, __HIP_MEMORY_SCOPE_AGENT); }
__device__ __forceinline__ unsigned xb_xcc_id() { return (unsigned)__builtin_amdgcn_s_getreg((3 << 11) | 20) & 0xFu; }
#define XB_SPIN(cond, bar) do { unsigned _sp = 0; while (cond) { __builtin_amdgcn_s_sleep(1); \
    if ((++_sp & 255u) == 0u) { if (xb_ld(&(bar)[XB_TMO])) break; if (_sp > XB_SPIN_CAP) { atomicAdd(&(bar)[XB_TMO], 1u); break; } } } } while (0)
struct XcdBarrier { unsigned* bar; unsigned x; volatile LAS unsigned* st; };
__device__ __forceinline__ XcdBarrier xcd_barrier_post(unsigned* bar, volatile LAS unsigned* st) {
    XcdBarrier b; b.bar = bar; b.x = xb_xcc_id(); b.st = st;
    if (threadIdx.x == 0) (void)xb_add(&bar[XB_XCNT(b.x)], 1u);
    return b;
}
__device__ __forceinline__ void xcd_barrier_complete(unsigned* bar, unsigned x, unsigned& nloc, unsigned& nx) {
    const unsigned G = gridDim.x * gridDim.y * gridDim.z;
    unsigned sum, cnt, mine, sp = 0u;
    for (;;) {
        sum = 0u; cnt = 0u; mine = 0u;
#pragma unroll
        for (unsigned j = 0; j < 16; ++j) { const unsigned c = xb_ld(&bar[XB_XCNT(j)]); sum += c; cnt += (c > 0u) ? 1u : 0u; mine = (j == x) ? c : mine; }
        if (sum == G) break;
        __builtin_amdgcn_s_sleep(1);
        if ((++sp & 255u) == 0u) { if (xb_ld(&bar[XB_TMO])) break; if (sp > XB_SPIN_CAP) { atomicAdd(&bar[XB_TMO], 1u); break; } }
    }
    nloc = mine > 0u ? mine : 1u; nx = cnt > 0u ? cnt : 1u;
}
__device__ __forceinline__ void xcd_barrier(const XcdBarrier& b) {
    asm volatile("s_waitcnt vmcnt(0)" ::: "memory");
    __syncthreads();
    if (threadIdx.x == 0) {
        unsigned* bar = b.bar;
        __builtin_amdgcn_s_waitcnt(0);
        unsigned nloc = b.st[0], nx = b.st[1];
        if (nloc == 0u) { xcd_barrier_complete(bar, b.x, nloc, nx); b.st[0] = nloc; b.st[1] = nx; }
        const unsigned old = xb_add(&bar[XB_XSUB(b.x)], 1u);
        const unsigned gen = old / nloc;
        if (old + 1u == (gen + 1u) * nloc) {
            __builtin_amdgcn_fence(__ATOMIC_RELEASE, "agent");
            asm volatile("s_waitcnt vmcnt(0)" ::: "memory");
            const unsigned og = xb_add(&bar[XB_TOP], 1u);
            const unsigned tg = og / nx;
            if (og + 1u == (tg + 1u) * nx) xb_add(&bar[XB_TOPGEN], 1u);
            else XB_SPIN(xb_ld(&bar[XB_TOPGEN]) == tg, bar);
            __builtin_amdgcn_fence(__ATOMIC_ACQUIRE, "agent");
            xb_add(&bar[XB_XGEN(b.x)], 1u);
            asm volatile("s_waitcnt vmcnt(0)" ::: "memory");
        } else {
            XB_SPIN(xb_ld(&bar[XB_XGEN(b.x)]) == gen, bar);
            __builtin_amdgcn_fence(__ATOMIC_ACQUIRE, "agent");
            asm volatile("s_waitcnt vmcnt(0)" ::: "memory");
        }
    }
    __syncthreads();
}

__global__ void __launch_bounds__(512, 2) fwd_kernel(Params P) {
    extern __shared__ __attribute__((aligned(16))) unsigned char lds_raw[];
    Frame F;
    F.lds = (LAS unsigned char*)lds_raw; F.ws = P.ws; F.out = P.out; F.P = &P;
    F.tid = threadIdx.x; F.lane = F.tid & 63; F.wave = __builtin_amdgcn_readfirstlane(F.tid >> 6); F.G = gridDim.x; F.bid = blockIdx.x; F.dry = 0; F.sub = 0xff;
    volatile LAS unsigned* MISC = (volatile LAS unsigned*)(F.lds + MISC_OFF);
    for (int u = F.tid; u < (LDS_BYTES - LDSCTL_OFF) / 4; u += 512) ((LAS unsigned*)(F.lds + LDSCTL_OFF))[u] = 0u;
    __syncthreads();
    const bool multi = (P.ph_hi - P.ph_lo) > 1;
    XcdBarrier bar; bar.bar = (unsigned*)(P.ws + WS_CTL) + CW_BAR; bar.x = 0; bar.st = nullptr;
    if (multi) bar = xcd_barrier_post((unsigned*)(P.ws + WS_CTL) + CW_BAR, MISC + 8);
#define RUN_PH(k) if (P.ph_lo <= (k) && (k) < P.ph_hi) { if ((k) == P.dup_ph) { F.dry = 1; F.sub = P.dup_sub; run_phase(F, (k)); xcd_barrier(bar); F.dry = 0; F.sub = 0xff; } run_phase(F, (k)); if ((k) + 1 < P.ph_hi) xcd_barrier(bar); }
    RUN_PH(0) RUN_PH(1) RUN_PH(2) RUN_PH(3) RUN_PH(4) RUN_PH(5) RUN_PH(6) RUN_PH(7) RUN_PH(8) RUN_PH(9)
#undef RUN_PH
}

#ifndef N_LAUNCH_MODE
#define N_LAUNCH_MODE 0
#endif
extern "C" void kernel_launch(void* const* d_in, const int* in_sizes, int n_in, void* d_out, int out_size, void* d_ws, size_t ws_size, hipStream_t stream) {
    static int grid = 0;
    if (grid == 0) {
        if (n_in != 29 || ws_size < WS_END) { fprintf(stderr, "kernel_launch: unexpected shapes (n_in %d out %d ws %zu need %zu)\n", n_in, out_size, ws_size, (size_t)WS_END); grid = -1; return; }
        int dev = 0, cus = 0;
        if (hipGetDevice(&dev) != hipSuccess || hipDeviceGetAttribute(&cus, hipDeviceAttributeMultiprocessorCount, dev) != hipSuccess) { grid = -1; return; }
        if (hipFuncSetAttribute((const void*)fwd_kernel, hipFuncAttributeMaxDynamicSharedMemorySize, LDS_BYTES) != hipSuccess) { fprintf(stderr, "kernel_launch: hipFuncSetAttribute failed\n"); grid = -1; return; }
        (void)hipGetLastError();
        grid = cus;
    }
    if (grid < 0) return;
    (void)hipMemsetAsync((char*)d_ws + WS_CTL, 0, CTL_BYTES, stream);
    Params P{};
    for (int i = 0; i < 29; ++i) P.in[i] = (const float*)d_in[i];
    P.out = (float*)d_out; P.ws = (unsigned char*)d_ws;
#ifndef DUP_PH
#define DUP_PH (-1)
#endif
#ifndef DUP_SUB
#define DUP_SUB 0xff
#endif
    P.dup_ph = DUP_PH; P.dup_sub = DUP_SUB;
#if N_LAUNCH_MODE == 0
    P.ph_lo = 0; P.ph_hi = N_PHASES;
    hipLaunchKernelGGL(fwd_kernel, dim3(grid), dim3(512), LDS_BYTES, stream, P);
#else
    for (int ph = 0; ph < N_PHASES; ++ph) { P.ph_lo = ph; P.ph_hi = ph + 1; hipLaunchKernelGGL(fwd_kernel, dim3(grid), dim3(512), LDS_BYTES, stream, P); }
#endif
}
#endif
```

```cpp
#ifndef HOST_EMU
#include <hip/hip_runtime.h>
#include <cstdio>
#include <cstdint>
#define DEV __device__ __forceinline__
#define DEVM __device__ __forceinline__
#define LAS __attribute__((address_space(3)))
#define GAS __attribute__((address_space(1)))
#endif

#ifndef CFG_BATCH
#define CFG_BATCH 8
#endif
#ifndef CFG_SEQ
#define CFG_SEQ 2048
#endif
#ifndef CFG_DEC
#define CFG_DEC 128
#endif
constexpr int D = 1024, BATCH = CFG_BATCH, SEQ = CFG_SEQ, DEC = CFG_DEC;
constexpr int MP = BATCH * SEQ;
constexpr int M_ALL = MP + 256;
constexpr int MT_ALL = M_ALL / 256, MT_P = MP / 256;
constexpr int MEM = 256, HEADS = 4, HD = 256;
constexpr int NCH = SEQ / 128;
constexpr int SSM_H = 32, SSM_P = 64, SSM_N = 128, SSM_G = 4, DIN = 2048, XBCW = 3072;
constexpr int W_IN_COLS = 12320, IN_TILES = 49, NIN = IN_TILES * 256;
constexpr int FF = 2816, NGU = 2 * FF, GU_TILES = NGU / 256;
constexpr float EPS = 1e-6f;
static_assert(SEQ % 256 == 0 && DEC <= 256 && DEC % 4 == 0, "shape");

constexpr size_t O_YP = 0;
constexpr size_t O_YS = O_YP + (size_t)MP * D;
constexpr size_t O_MK = O_YS + (size_t)DEC * D;
constexpr size_t O_MV = O_MK + (size_t)BATCH * MEM * D;
constexpr size_t O_PCONV = O_MV + (size_t)BATCH * MEM * D;
constexpr size_t O_PSSMC = O_PCONV + (size_t)BATCH * 2 * D;
constexpr size_t O_PSSM = O_PSSMC + (size_t)BATCH * 3 * XBCW;
constexpr size_t O_SCONV = O_PSSM + (size_t)BATCH * SSM_H * SSM_P * SSM_N;
constexpr size_t O_SSSMC = O_SCONV + (size_t)DEC * 2 * D;
constexpr size_t O_SSSM = O_SSSMC + (size_t)DEC * 3 * XBCW;
constexpr size_t O_END = O_SSSM + (size_t)DEC * SSM_H * SSM_P * SSM_N;

constexpr size_t al256(size_t x) { return (x + 255) & ~(size_t)255; }
constexpr size_t WS_CTL = 0, CTL_BYTES = 1u << 20;
constexpr size_t WS_WIN = WS_CTL + CTL_BYTES;
constexpr size_t WS_WKV = WS_WIN + (size_t)NIN * 1024 * 2;
constexpr size_t WS_WCAT = WS_WKV + (size_t)2048 * 1024 * 2;
constexpr size_t WS_WMO = WS_WCAT + (size_t)1024 * 4096 * 2;
constexpr size_t WS_WGU = WS_WMO + (size_t)1024 * 1024 * 2;
constexpr size_t WS_WD = WS_WGU + (size_t)NGU * 1024 * 2;
constexpr size_t WS_XN = WS_WD + (size_t)1024 * FF * 2;
constexpr size_t WS_MEMN = WS_XN + (size_t)M_ALL * 1024 * 2;
constexpr size_t WS_KB = WS_MEMN + (size_t)BATCH * MEM * 1024 * 2;
constexpr size_t WS_VT = WS_KB + (size_t)BATCH * MEM * 1024 * 2;
constexpr size_t WS_DT = WS_VT + (size_t)BATCH * MEM * 1024 * 2;
constexpr size_t WS_CDEC = WS_DT + (size_t)M_ALL * 32 * 4;
constexpr size_t WS_DUMP = al256(WS_CDEC + (size_t)BATCH * NCH * 32 * 4);
constexpr size_t WS_ACAT = WS_DUMP + (size_t)256 * 1024 * 4;
constexpr size_t WS_U = WS_ACAT + (size_t)M_ALL * 4096 * 2;
constexpr size_t WS_XBC = WS_U + (size_t)M_ALL * 1024 * 2;
constexpr size_t WS_G = WS_XBC + (size_t)M_ALL * 3072 * 2;
constexpr size_t WS_CHST = WS_G + (size_t)M_ALL * 3072 * 2;
constexpr size_t WS_END = WS_CHST + (size_t)BATCH * NCH * 32 * 64 * 128 * 2;
constexpr size_t WS_MERGED = WS_XN, WS_HID = WS_ACAT, WS_XP2B = WS_U, WS_MSCR = WS_XBC, WS_XP2 = WS_XBC;
static_assert((size_t)M_ALL * FF * 2 <= (size_t)M_ALL * 4096 * 2 && (size_t)M_ALL * 1024 * 4 <= (size_t)M_ALL * 3072 * 2, "overlays");
constexpr int CW_BAR = 4096;
constexpr int CW_SS2 = 16384;
constexpr int CW_SS3 = CW_SS2 + M_ALL;
constexpr int CW_SM = 65536;
static_assert(CW_SS3 + M_ALL <= CW_SM && (size_t)(CW_SM + 128 * 1024) * 4 <= CTL_BYTES, "ctl");

constexpr int RING_BYTES = 135168;
constexpr int LDSCTL_OFF = 139264, MISC_OFF = LDSCTL_OFF + 320, LDS_BYTES = 147456;

typedef unsigned short bf16_t;
typedef short bf16x8 __attribute__((ext_vector_type(8)));
typedef float f32x4 __attribute__((ext_vector_type(4)));
typedef float f32x2 __attribute__((ext_vector_type(2)));
typedef unsigned u32x4 __attribute__((ext_vector_type(4)));
typedef unsigned u32x2 __attribute__((ext_vector_type(2)));

#ifndef HOST_EMU
DEV f32x4 MFMA16(bf16x8 a, bf16x8 b, f32x4 c) { return __builtin_amdgcn_mfma_f32_16x16x32_bf16(a, b, c, 0, 0, 0); }
#define GLDS16(g, l) __builtin_amdgcn_global_load_lds((const unsigned*)(g), (LAS unsigned*)(l), 16, 0, 0)
#define SBAR() __builtin_amdgcn_s_barrier()
#define WAIT_V(n) asm volatile("s_waitcnt vmcnt(" #n ")" ::: "memory")
#define WAIT_L(n) asm volatile("s_waitcnt lgkmcnt(" #n ")" ::: "memory")
#define SETPRIO(n) __builtin_amdgcn_s_setprio(n)
#define SCHEDB() __builtin_amdgcn_sched_barrier(0)
#define WAVE_LDS_SYNC() asm volatile("s_waitcnt lgkmcnt(0)" ::: "memory")
#define BLOCK_SYNC() __syncthreads()
typedef short s16x4_t __attribute__((ext_vector_type(4)));
DEV s16x4_t LDS_TR(const LAS unsigned short* p) { return __builtin_amdgcn_ds_read_tr16_b64_v4i16((LAS s16x4_t*)p); }
#define CFENCE() asm volatile("" ::: "memory")
#define OPAQUE_V(x) asm volatile("" : "+v"(x))
#define OPAQUE_S(x) asm volatile("" : "+s"(x))
DEV int RFL(int v) { return __builtin_amdgcn_readfirstlane(v); }
DEV float SHFL_XOR(float v, int m) { return __shfl_xor(v, m); }
DEV float SHFL(float v, int src) { return __shfl(v, src); }
DEV void ATOMIC_ADD_F32(float* p, float v) { atomicAdd(p, v); }
typedef __bf16 bf16x2_t __attribute__((ext_vector_type(2)));
DEV unsigned cvt_pk_bf16(float lo, float hi) { const f32x2 v = {lo, hi}; return __builtin_bit_cast(unsigned, __builtin_convertvector(v, bf16x2_t)); }
DEV float fast_exp(float x) { return __expf(x); }
DEV float fast_rsqrt(float x) { return rsqrtf(x); }
DEV float fast_rcp(float x) { return __builtin_amdgcn_rcpf(x); }
#endif

DEV unsigned f2bf(float f) { unsigned u = __builtin_bit_cast(unsigned, f); return (u + 0x7fffu + ((u >> 16) & 1u)) >> 16; }
DEV unsigned pk2(float lo, float hi) { return cvt_pk_bf16(lo, hi); }
DEV float bflo(unsigned w) { return __builtin_bit_cast(float, w << 16); }
DEV float bfhi(unsigned w) { return __builtin_bit_cast(float, w & 0xffff0000u); }
DEV float bf1(bf16_t b) { return __builtin_bit_cast(float, (unsigned)b << 16); }
DEV float sigmoidf_(float x) { return fast_rcp(1.0f + fast_exp(-x)); }
DEV float siluf_(float x) { return x * fast_rcp(1.0f + fast_exp(-x)); }
DEV float softplusf_(float x) { return x > 20.f ? x : log1pf(expf(x)); }
DEV float wave_sum(float v) {
#pragma unroll
    for (int o = 1; o < 64; o <<= 1) v += SHFL_XOR(v, o);
    return v;
}
#ifndef HOST_EMU
DEV f32x4 ld_nt(const float* p) { return __builtin_nontemporal_load((const f32x4*)p); }
DEV float ld_nt1(const float* p) { return __builtin_nontemporal_load(p); }
DEV void st_nt_f(void* p, const f32x4& v) { __builtin_nontemporal_store(v, (f32x4*)p); }
#endif
DEV u32x4 pack8(const f32x4& a, const f32x4& b) { u32x4 w; w.x = cvt_pk_bf16(a[0], a[1]); w.y = cvt_pk_bf16(a[2], a[3]); w.z = cvt_pk_bf16(b[0], b[1]); w.w = cvt_pk_bf16(b[2], b[3]); return w; }
DEV void unpack8(const u32x4& w, float (&o)[8]) { o[0] = bflo(w.x); o[1] = bfhi(w.x); o[2] = bflo(w.y); o[3] = bfhi(w.y); o[4] = bflo(w.z); o[5] = bfhi(w.z); o[6] = bflo(w.w); o[7] = bfhi(w.w); }

struct Params {
    const float* in[29];
    float* out;
    unsigned char* ws;
    int ph_lo, ph_hi, dup_ph, dup_sub;
};
enum { I_XP = 0, I_XS, I_MEM, I_CK, I_CV, I_SCONV, I_SSMCONV, I_SSM, I_NMIX, I_WIN, I_SCW, I_WSC, I_SSMCW, I_SSMCB, I_DTB, I_ALOG, I_SSMD, I_SSMNW, I_WSSM,
       I_NMEM, I_WMK, I_WMV, I_WAO, I_WMO, I_NFFN, I_WG, I_WU, I_WDN, I_NFIN };

namespace pg8 {
constexpr int BM = 256, BK = 64, HALF = 128, HTB = HALF * BK * 2, STAGE_BYTES = 8 * HTB, NXCD = 8, WGM = 8;
DEV int lds_byte(int r, int c) { const int st = (r >> 4) * 2 + (c >> 5), rr = r & 15, cc = c & 31, ob = rr * 64 + cc * 2; return st * 1024 + (ob ^ (((ob >> 9) & 1) << 5)); }
DEV void stage_rc(int b, int& R, int& C) { const int st = b / 1024, sb = b % 1024, swz = sb ^ (((sb >> 9) & 1) << 5); R = (st >> 1) * 16 + swz / 64; C = (st & 1) * 32 + (swz % 64) / 2; }
DEV int perm32(int rho) { const int n = rho >> 4, i = rho & 15; return 8 * (i >> 2) + 4 * n + (i & 3); }

struct Unit { const char* A; const char* B; int nt, kind, pm, pn; };
DEV void tile_of(int wgid, int nM, int nN, int& pm, int& pn) {
    const int nwg = nM * nN; { const int q = nwg / NXCD, r = nwg % NXCD, xcd = wgid % NXCD, off = wgid / NXCD; wgid = (xcd < r ? xcd * (q + 1) : r * (q + 1) + (xcd - r) * q) + off; }
    const int nig = WGM * nN, gid = wgid / nig, fm = gid * WGM, gsz = (nM - fm) < WGM ? (nM - fm) : WGM;
    pm = fm + ((wgid % nig) % gsz); pn = (wgid % nig) / gsz;
}

template <class Epi, class Sched>
DEV void gemm_phase(LAS unsigned char* lds, const int PITCH, const Sched& S, const Epi& E) {
    const int tid = threadIdx.x, wid = RFL(tid >> 6), lane = tid & 63, wr = wid >> 2, wc = wid & 3, fr = lane & 15, fq = lane >> 4;
    unsigned voffA[2], voffB[2];
#pragma unroll
    for (int i = 0; i < 2; ++i) { int R, C; stage_rc(tid * 16 + i * 8192, R, C); const int Rb = (R & ~31) + perm32(R & 31);
        voffA[i] = (unsigned)(R * PITCH + C) * 2u; voffB[i] = (unsigned)(Rb * PITCH + C) * 2u; }
    const size_t kstep = (size_t)(BK * 2);
    const size_t hstep = (size_t)HALF * PITCH * 2;
    const unsigned ldsw = (unsigned)wid * 1024u;
    const int aoff = lds_byte(wr * 64 + fr, fq * 8), boff = lds_byte(wc * 32 + fr, fq * 8);
#define PG8_SA(b, h) (((b) * 2 + (h)) * HTB)
#define PG8_SB(b, h) ((4 + (b) * 2 + (h)) * HTB)
#define PG8_STAGE(bufoff, gbase, voff) do { _Pragma("unroll") for (int _i = 0; _i < 2; ++_i) \
        GLDS16((const char*)(gbase) + (voff)[_i], lds + (bufoff) + ldsw + _i * 8192); } while (0)
#define PG8_LDA(dst, b, h) do { _Pragma("unroll") for (int m = 0; m < 4; ++m) _Pragma("unroll") for (int k = 0; k < 2; ++k) dst[m][k] = *(const LAS bf16x8*)(lds + PG8_SA(b, h) + aoff + m * 2048 + k * 1024); } while (0)
#define PG8_LDB(dst, b, h) do { _Pragma("unroll") for (int n = 0; n < 2; ++n) _Pragma("unroll") for (int k = 0; k < 2; ++k) dst[n][k] = *(const LAS bf16x8*)(lds + PG8_SB(b, h) + boff + n * 2048 + k * 1024); } while (0)
#define PG8_MMA(ai, bj, At, Bt) do { SETPRIO(1); _Pragma("unroll") for (int m = 0; m < 4; ++m) _Pragma("unroll") for (int n = 0; n < 2; ++n) _Pragma("unroll") for (int k = 0; k < 2; ++k) \
        acc[ai][bj][m][n] = MFMA16(Bt[n][k], At[m][k], acc[ai][bj][m][n]); SETPRIO(0); } while (0)
    Unit cur, nxt; int ui = 0;
    if (!S.next(0, cur)) return;
    f32x4 acc[2][2][4][2];
#pragma unroll
    for (int a = 0; a < 2; ++a)
#pragma unroll
        for (int b = 0; b < 2; ++b)
#pragma unroll
            for (int m = 0; m < 4; ++m)
#pragma unroll
                for (int n = 0; n < 2; ++n) acc[a][b][m][n] = (f32x4){0.f, 0.f, 0.f, 0.f};
    bf16x8 At[4][2], B0[2][2], B1[2][2];
    const char* cA = cur.A; const char* cB = cur.B;
    PG8_STAGE(PG8_SB(0, 0), cB, voffB); PG8_STAGE(PG8_SB(0, 1), cB + hstep, voffB); PG8_STAGE(PG8_SA(0, 0), cA, voffA); PG8_STAGE(PG8_SA(0, 1), cA + hstep, voffA);
    if (wr == 1) SBAR();
    WAIT_V(2); SBAR();
    PG8_STAGE(PG8_SB(1, 0), cB + kstep, voffB); PG8_STAGE(PG8_SA(1, 0), cA + kstep, voffA); PG8_STAGE(PG8_SB(1, 1), cB + hstep + kstep, voffB);
    WAIT_V(6); SBAR();
    for (;;) {
        const bool has_next = S.next(ui + 1, nxt);
        const char* nA = has_next ? nxt.A : cA; const char* nB = has_next ? nxt.B : cB;
        const int nt = cur.nt;
        for (int t = 0; t < nt; t += 2) {
            const bool last = (t == nt - 2);
            const char* a1 = cA + (size_t)(t + 1) * kstep;
            const char* a2 = last ? nA : cA + (size_t)(t + 2) * kstep; const char* b2 = last ? nB : cB + (size_t)(t + 2) * kstep;
            const char* a3 = a2 + kstep; const char* b3 = b2 + kstep;
            PG8_LDB(B0, 0, 0); PG8_LDB(B1, 0, 1); SCHEDB(); PG8_LDA(At, 0, 0); PG8_STAGE(PG8_SA(1, 1), a1 + hstep, voffA);
            WAIT_V(8); WAIT_L(0); SBAR(); PG8_MMA(0, 0, At, B0); PG8_MMA(0, 1, At, B1); SBAR(); SCHEDB();
            PG8_LDA(At, 0, 1); PG8_STAGE(PG8_SB(0, 0), b2, voffB); PG8_STAGE(PG8_SB(0, 1), b2 + hstep, voffB); PG8_STAGE(PG8_SA(0, 0), a2, voffA);
            WAIT_V(8); WAIT_L(0); SBAR(); PG8_MMA(1, 0, At, B0); PG8_MMA(1, 1, At, B1); SBAR(); SCHEDB();
            PG8_LDB(B0, 1, 0); PG8_LDB(B1, 1, 1); SCHEDB(); PG8_LDA(At, 1, 0); PG8_STAGE(PG8_SA(0, 1), a2 + hstep, voffA);
            WAIT_V(8); WAIT_L(0); SBAR(); PG8_MMA(0, 0, At, B0); PG8_MMA(0, 1, At, B1); SBAR(); SCHEDB();
            PG8_LDA(At, 1, 1); PG8_STAGE(PG8_SB(1, 0), b3, voffB); PG8_STAGE(PG8_SB(1, 1), b3 + hstep, voffB); PG8_STAGE(PG8_SA(1, 0), a3, voffA);
            WAIT_V(8); WAIT_L(0); SBAR(); PG8_MMA(1, 0, At, B0); PG8_MMA(1, 1, At, B1); SBAR(); SCHEDB();
        }
        if (wr == 0) SBAR();
        { int fr_ = fr, fq_ = fq; OPAQUE_V(fr_); OPAQUE_V(fq_); E(acc, cur, wr, wc, fr_, fq_); }
        if (!has_next) break;
#pragma unroll
        for (int a = 0; a < 2; ++a)
#pragma unroll
            for (int b = 0; b < 2; ++b)
#pragma unroll
                for (int m = 0; m < 4; ++m)
#pragma unroll
                    for (int n = 0; n < 2; ++n) acc[a][b][m][n] = (f32x4){0.f, 0.f, 0.f, 0.f};
        cur = nxt; cA = nA; cB = nB; ++ui;
        if (wr == 1) SBAR();
    }
    WAIT_V(0);
    SBAR();
#undef PG8_SA
#undef PG8_SB
#undef PG8_STAGE
#undef PG8_LDA
#undef PG8_LDB
#undef PG8_MMA
}
}
using pg8::Unit;

struct Frame {
    LAS unsigned char* lds;
    unsigned char* ws;
    const Params* P;
    float* out;
    int tid, lane, wave, G, bid;
    int dry, sub;
};
#define WSP(T, off) ((T*)(F.ws + (off)))

DEV void transpose_item(const float* W, int src_pitch, int k0, int n0, bf16_t* WT, size_t dst_pitch, int dst_row0, int dst_k, const float* kscale, LAS float* scr, int lane) {
    float v[32];
#pragma unroll
    for (int i = 0; i < 32; ++i) { const int kk = 2 * i + (lane >> 5); v[i] = ld_nt1(W + (size_t)(k0 + kk) * src_pitch + n0 + (lane & 31)); }
#pragma unroll
    for (int i = 0; i < 32; ++i) { const int kk = 2 * i + (lane >> 5); float x = v[i]; if (kscale) x *= kscale[k0 + kk]; scr[kk * 33 + (lane & 31)] = x; }
    WAVE_LDS_SYNC();
    const int c = lane & 7;
#pragma unroll
    for (int j = 0; j < 4; ++j) { const int n = (lane >> 3) + 8 * j; const LAS float* s = scr + (8 * c) * 33 + n;
        u32x4 o; o.x = pk2(s[0 * 33], s[1 * 33]); o.y = pk2(s[2 * 33], s[3 * 33]); o.z = pk2(s[4 * 33], s[5 * 33]); o.w = pk2(s[6 * 33], s[7 * 33]);
        *(u32x4*)(WT + (size_t)(dst_row0 + n) * dst_pitch + dst_k + 8 * c) = o; }
    WAVE_LDS_SYNC();
}
DEV int win_dst_row(int c) {
    if (c < 1024) return c;
    if (c < 2048) { const int j = (c - 1024) >> 7; return 1024 + 256 * j + ((c - 1024) & 127); }
    if (c < 3072) { const int j = (c - 2048) >> 7; return 1024 + 256 * j + 128 + ((c - 2048) & 127); }
    if (c < 8192) return c;
    if (c < 8224) return 12288 + (c - 8192);
    return c - 32;
}
DEV void rms_row_bf16(const float* xrow, const float* w, bf16_t* orow, int lane) {
    const f32x4* xr = (const f32x4*)xrow + lane; const f32x4* wr_ = (const f32x4*)w + lane;
    f32x4 v[4]; float s = 0.f;
#pragma unroll
    for (int j = 0; j < 4; ++j) { v[j] = xr[64 * j]; s += (v[j][0] * v[j][0] + v[j][1] * v[j][1]) + (v[j][2] * v[j][2] + v[j][3] * v[j][3]); }
    const float rs = fast_rsqrt(wave_sum(s) * (1.f / 1024.f) + EPS);
    u32x2* o8 = (u32x2*)orow + lane;
#pragma unroll
    for (int j = 0; j < 4; ++j) { const f32x4 ww = wr_[64 * j]; u32x2 o; o.x = pk2(v[j][0] * rs * ww[0], v[j][1] * rs * ww[1]); o.y = pk2(v[j][2] * rs * ww[2], v[j][3] * rs * ww[3]); o8[64 * j] = o; }
}
DEV void p0_prep(Frame& F) {
    LAS float* scr = (LAS float*)(F.lds + F.wave * 16384);
    const int gw = F.bid * 8 + F.wave, NGW = F.G * 8, lane = F.lane;
    bf16_t* WIN = WSP(bf16_t, WS_WIN); bf16_t* WKV = WSP(bf16_t, WS_WKV); bf16_t* WCAT = WSP(bf16_t, WS_WCAT); bf16_t* WMO = WSP(bf16_t, WS_WMO);
    bf16_t* WGU = WSP(bf16_t, WS_WGU); bf16_t* WD = WSP(bf16_t, WS_WD);
    constexpr int I0 = 16 * (W_IN_COLS / 32), I1 = 16 * 32, I4 = 32 * 32, I7 = 16 * (FF / 32), I9 = (FF / 64) * 32;
    constexpr int NITEMS = I0 + 2 * I1 + I1 + I4 + I1 + I1 + 2 * I7 + I9;
    for (int it = gw; it < NITEMS; it += NGW) {
        int r = it;
        if (r < I0) { const int nb = W_IN_COLS / 32, kb = r / nb, n0 = 32 * (r % nb); transpose_item(F.P->in[I_WIN], W_IN_COLS, 64 * kb, n0, WIN, 1024, win_dst_row(n0), 64 * kb, nullptr, scr, lane); continue; } r -= I0;
        if (r < I1) { const int kb = r / 32, n0 = 32 * (r % 32); transpose_item(F.P->in[I_WMK], 1024, 64 * kb, n0, WKV, 1024, n0, 64 * kb, nullptr, scr, lane); continue; } r -= I1;
        if (r < I1) { const int kb = r / 32, n0 = 32 * (r % 32); transpose_item(F.P->in[I_WMV], 1024, 64 * kb, n0, WKV, 1024, 1024 + n0, 64 * kb, nullptr, scr, lane); continue; } r -= I1;
        if (r < I1) { const int kb = r / 32, n0 = 32 * (r % 32); transpose_item(F.P->in[I_WSC], 1024, 64 * kb, n0, WCAT, 4096, n0, 64 * kb, nullptr, scr, lane); continue; } r -= I1;
        if (r < I4) { const int kb = r / 32, n0 = 32 * (r % 32); transpose_item(F.P->in[I_WSSM], 1024, 64 * kb, n0, WCAT, 4096, n0, 1024 + 64 * kb, nullptr, scr, lane); continue; } r -= I4;
        if (r < I1) { const int kb = r / 32, n0 = 32 * (r % 32); transpose_item(F.P->in[I_WAO], 1024, 64 * kb, n0, WCAT, 4096, n0, 3072 + 64 * kb, nullptr, scr, lane); continue; } r -= I1;
        if (r < I1) { const int kb = r / 32, n0 = 32 * (r % 32); transpose_item(F.P->in[I_WMO], 1024, 64 * kb, n0, WMO, 1024, n0, 64 * kb, nullptr, scr, lane); continue; } r -= I1;
        if (r < I7) { const int nb = FF / 32, kb = r / nb, n0 = 32 * (r % nb); transpose_item(F.P->in[I_WG], FF, 64 * kb, n0, WGU, 1024, 256 * (n0 >> 7) + (n0 & 127), 64 * kb, F.P->in[I_NFFN], scr, lane); continue; } r -= I7;
        if (r < I7) { const int nb = FF / 32, kb = r / nb, n0 = 32 * (r % nb); transpose_item(F.P->in[I_WU], FF, 64 * kb, n0, WGU, 1024, 256 * (n0 >> 7) + 128 + (n0 & 127), 64 * kb, F.P->in[I_NFFN], scr, lane); continue; } r -= I7;
        { const int kb = r / 32, n0 = 32 * (r % 32); transpose_item(F.P->in[I_WDN], 1024, 64 * kb, n0, WD, FF, n0, 64 * kb, nullptr, scr, lane); }
    }
    { u32x4* z = (u32x4*)(WIN + (size_t)12320 * 1024); const int nz = (NIN - 12320) * 1024 / 8;
      for (int i = F.bid * 512 + F.tid; i < nz; i += F.G * 512) z[i] = (u32x4){0u, 0u, 0u, 0u}; }
    bf16_t* XN = WSP(bf16_t, WS_XN); bf16_t* MEMN = WSP(bf16_t, WS_MEMN);
    for (int m = gw; m < M_ALL; m += NGW) {
        if (m < MP) rms_row_bf16(F.P->in[I_XP] + (size_t)m * D, F.P->in[I_NMIX], XN + (size_t)m * D, lane);
        else if (m < MP + DEC) rms_row_bf16(F.P->in[I_XS] + (size_t)(m - MP) * D, F.P->in[I_NMIX], XN + (size_t)m * D, lane);
        else { u32x4* z = (u32x4*)(XN + (size_t)m * D); z[lane] = (u32x4){0u, 0u, 0u, 0u}; z[lane + 64] = (u32x4){0u, 0u, 0u, 0u}; }
    }
    for (int m = gw; m < BATCH * MEM; m += NGW) rms_row_bf16(F.P->in[I_MEM] + (size_t)m * D, F.P->in[I_NMEM], MEMN + (size_t)m * D, lane);
}

struct SchedP1 {
    const char* XN; const char* WIN; const char* MEMN; const char* WKV; int G, c;
    DEVM bool next(int i, Unit& u) const {
        const int n1 = MT_P * IN_TILES, n2 = BATCH * 8; const long L = (long)i * G + c;
        if (L >= n1 + n2) return false;
        u.nt = 16;
        if (L < n1) { pg8::tile_of((int)L, MT_P, IN_TILES, u.pm, u.pn); u.kind = 0; u.A = XN + (size_t)u.pm * 256 * 1024 * 2; u.B = WIN + (size_t)u.pn * 256 * 1024 * 2; }
        else { pg8::tile_of((int)(L - n1), BATCH, 8, u.pm, u.pn); u.kind = 1; u.A = MEMN + (size_t)u.pm * 256 * 1024 * 2; u.B = WKV + (size_t)u.pn * 256 * 1024 * 2; }
        return true;
    }
};
struct EpiP1 {
    unsigned char* ws; float* out; const float* dtb;
    DEVM void operator()(const f32x4 (&acc)[2][2][4][2], const Unit& u, int wr, int wc, int fr, int fq) const {
        const int cb = wc * 32 + 8 * fq;
        if (u.kind == 1) {
            const int b = u.pm, h = u.pn & 3; const bool isv = u.pn >= 4;
            float* of = out + (isv ? O_MV : O_MK); bf16_t* KB = (bf16_t*)(ws + WS_KB); bf16_t* VT = (bf16_t*)(ws + WS_VT);
#pragma unroll
            for (int ai = 0; ai < 2; ++ai)
#pragma unroll
                for (int m = 0; m < 4; ++m) { const int key = ai * 128 + wr * 64 + m * 16 + fr;
#pragma unroll
                    for (int bj = 0; bj < 2; ++bj) { const int d = bj * 128 + cb; const f32x4 v0 = acc[ai][bj][m][0], v1 = acc[ai][bj][m][1];
                        float* o = of + ((size_t)(b * MEM + key) * HEADS + h) * HD + d; *(f32x4*)o = v0; *(f32x4*)(o + 4) = v1;
                        if (!isv) *(u32x4*)(KB + ((size_t)(b * HEADS + h) * MEM + key) * HD + d) = pack8(v0, v1);
                        else { bf16_t* vt = VT + ((size_t)(b * HEADS + h) * HD + d) * MEM + key;
#pragma unroll
                            for (int e = 0; e < 4; ++e) { vt[(size_t)e * MEM] = (bf16_t)f2bf(v0[e]); vt[(size_t)(e + 4) * MEM] = (bf16_t)f2bf(v1[e]); } } }
                    CFENCE(); }
            return;
        }
        const int pn = u.pn, row0 = u.pm * 256 + wr * 64 + fr;
        if (pn < 4 || (pn >= 12 && pn < 20) || (pn >= 32 && pn < 36)) {
            const int coff = pn < 4 ? pn * 256 : (pn < 20 ? 1024 + (pn - 12) * 256 : 3072 + (pn - 32) * 256);
            bf16_t* O = (bf16_t*)(ws + WS_ACAT);
#pragma unroll
            for (int ai = 0; ai < 2; ++ai)
#pragma unroll
                for (int m = 0; m < 4; ++m) { bf16_t* rp = O + (size_t)(row0 + ai * 128 + m * 16) * 4096 + coff + cb;
#pragma unroll
                    for (int bj = 0; bj < 2; ++bj) *(u32x4*)(rp + bj * 128) = pack8(acc[ai][bj][m][0], acc[ai][bj][m][1]);
                    CFENCE(); }
        } else if (pn < 12) {
            bf16_t* O = (bf16_t*)(ws + WS_U); const int j = pn - 4;
#pragma unroll
            for (int ai = 0; ai < 2; ++ai)
#pragma unroll
                for (int m = 0; m < 4; ++m) *(u32x4*)(O + (size_t)(row0 + ai * 128 + m * 16) * 1024 + 128 * j + cb) = pack8(acc[ai][0][m][0] * acc[ai][1][m][0], acc[ai][0][m][1] * acc[ai][1][m][1]);
        } else if (pn < 32) {
            bf16_t* O = (bf16_t*)(ws + WS_XBC);
#pragma unroll
            for (int ai = 0; ai < 2; ++ai)
#pragma unroll
                for (int m = 0; m < 4; ++m) { bf16_t* rp = O + (size_t)(row0 + ai * 128 + m * 16) * XBCW + (pn - 20) * 256 + cb;
#pragma unroll
                    for (int bj = 0; bj < 2; ++bj) *(u32x4*)(rp + bj * 128) = pack8(acc[ai][bj][m][0], acc[ai][bj][m][1]);
                    CFENCE(); }
        } else if (pn < 48) {
            bf16_t* O = (bf16_t*)(ws + WS_G);
#pragma unroll
            for (int ai = 0; ai < 2; ++ai)
#pragma unroll
                for (int m = 0; m < 4; ++m) { bf16_t* rp = O + (size_t)(row0 + ai * 128 + m * 16) * 3072 + (pn - 36) * 256 + cb;
#pragma unroll
                    for (int bj = 0; bj < 2; ++bj) { f32x4 v0 = acc[ai][bj][m][0], v1 = acc[ai][bj][m][1];
#pragma unroll
                        for (int e = 0; e < 4; ++e) { v0[e] = sigmoidf_(v0[e]); v1[e] = sigmoidf_(v1[e]); }
                        *(u32x4*)(rp + bj * 128) = pack8(v0, v1); }
                    CFENCE(); }
        } else {
            if (wc == 0) { float* O = (float*)(ws + WS_DT); const f32x4 b0 = *(const f32x4*)(dtb + cb), b1 = *(const f32x4*)(dtb + cb + 4);
#pragma unroll
                for (int ai = 0; ai < 2; ++ai)
#pragma unroll
                    for (int m = 0; m < 4; ++m) { f32x4 v0 = acc[ai][0][m][0] + b0, v1 = acc[ai][0][m][1] + b1;
#pragma unroll
                        for (int e = 0; e < 4; ++e) { v0[e] = softplusf_(v0[e]); v1[e] = softplusf_(v1[e]); }
                        float* o = O + (size_t)(row0 + ai * 128 + m * 16) * 32 + cb; *(f32x4*)o = v0; *(f32x4*)(o + 4) = v1; CFENCE(); } }
        }
    }
};
struct SchedP5 {
    const char* ACAT; const char* WCAT; int G, c;
    DEVM bool next(int i, Unit& u) const {
        const int su = i / 3, seg = i - 3 * su; const long L = (long)su * G + c;
        if (L >= MT_P * 4) return false;
        pg8::tile_of((int)L, MT_P, 4, u.pm, u.pn); u.kind = seg; u.nt = seg == 1 ? 32 : 16;
        const size_t koff = (seg == 0 ? 0 : (seg == 1 ? 1024 : 3072)) * 2;
        u.A = ACAT + (size_t)u.pm * 256 * 4096 * 2 + koff; u.B = WCAT + (size_t)u.pn * 256 * 4096 * 2 + koff; return true;
    }
};
struct EpiP5 {
    unsigned char* ws;
    DEVM void operator()(const f32x4 (&acc)[2][2][4][2], const Unit& u, int wr, int wc, int fr, int fq) const {
        const int row0 = u.pm * 256 + wr * 64 + fr, col0 = u.pn * 256 + wc * 32 + 8 * fq, seg = u.kind;
        const bf16_t* Gt = (const bf16_t*)(ws + WS_G) + seg * 1024 + col0; bf16_t* SC = (bf16_t*)(ws + WS_MSCR) + col0; bf16_t* MG = (bf16_t*)(ws + WS_MERGED) + col0;
        u32x4 gq[2][2], sq[2][2];
#define P5_LOAD(st_, buf_) do { const size_t row_ = (size_t)(row0 + ((st_) >> 2) * 128 + ((st_) & 3) * 16); \
            gq[buf_][0] = *(const u32x4*)(Gt + row_ * 3072); gq[buf_][1] = *(const u32x4*)(Gt + row_ * 3072 + 128); \
            if (seg > 0) { sq[buf_][0] = *(const u32x4*)(SC + row_ * 1024); sq[buf_][1] = *(const u32x4*)(SC + row_ * 1024 + 128); } } while (0)
        P5_LOAD(0, 0);
#pragma unroll
        for (int st = 0; st < 8; ++st) { const int ai = st >> 2, m = st & 3, cb_ = st & 1; const size_t row = (size_t)(row0 + ai * 128 + m * 16);
            if (st < 7) P5_LOAD(st + 1, cb_ ^ 1);
#pragma unroll
            for (int bj = 0; bj < 2; ++bj) { float g[8]; unpack8(gq[cb_][bj], g);
                f32x4 v0 = acc[ai][bj][m][0], v1 = acc[ai][bj][m][1];
#pragma unroll
                for (int e = 0; e < 4; ++e) { v0[e] *= g[e]; v1[e] *= g[4 + e]; }
                if (seg > 0) { float p[8]; unpack8(sq[cb_][bj], p);
#pragma unroll
                    for (int e = 0; e < 4; ++e) { v0[e] += p[e]; v1[e] += p[4 + e]; } }
                *(u32x4*)((seg < 2 ? SC : MG) + row * 1024 + bj * 128) = pack8(v0, v1); } }
#undef P5_LOAD
    }
};
struct SchedPlain {
    const char* A; const char* B; int nM, nN, nt, G, c; size_t pitchB;
    DEVM bool next(int i, Unit& u) const {
        const long L = (long)i * G + c; if (L >= nM * nN) return false;
        pg8::tile_of((int)L, nM, nN, u.pm, u.pn); u.kind = 0; u.nt = nt; u.A = A + (size_t)u.pm * 256 * pitchB; u.B = B + (size_t)u.pn * 256 * pitchB; return true;
    }
};
struct EpiP6 {
    unsigned char* ws; const float* xp; const float* xs; int dry;
    DEVM void operator()(const f32x4 (&acc)[2][2][4][2], const Unit& u, int wr, int wc, int fr, int fq) const {
        const int row0 = u.pm * 256 + wr * 64 + fr, col0 = u.pn * 256 + wc * 32 + 8 * fq;
        bf16_t* X2B = (bf16_t*)(ws + WS_XP2B) + col0; float* SS = (float*)ws + CW_SS2; const float* xb = xp + col0;
        f32x4 xq[2][4];
#define P6_LOAD(st_, buf_) do { const float* xr_ = xb + (size_t)(row0 + ((st_) >> 2) * 128 + ((st_) & 3) * 16) * D; \
            xq[buf_][0] = *(const f32x4*)xr_; xq[buf_][1] = *(const f32x4*)(xr_ + 4); xq[buf_][2] = *(const f32x4*)(xr_ + 128); xq[buf_][3] = *(const f32x4*)(xr_ + 132); } while (0)
        P6_LOAD(0, 0);
#pragma unroll
        for (int st = 0; st < 8; ++st) { const int ai = st >> 2, m = st & 3, cb_ = st & 1, row = row0 + ai * 128 + m * 16; float sacc = 0.f;
            if (st < 7) P6_LOAD(st + 1, cb_ ^ 1);
#pragma unroll
            for (int bj = 0; bj < 2; ++bj) { const f32x4 v0 = acc[ai][bj][m][0] + xq[cb_][2 * bj], v1 = acc[ai][bj][m][1] + xq[cb_][2 * bj + 1];
                sacc += (v0[0] * v0[0] + v0[1] * v0[1]) + (v0[2] * v0[2] + v0[3] * v0[3]) + (v1[0] * v1[0] + v1[1] * v1[1]) + (v1[2] * v1[2] + v1[3] * v1[3]);
                *(u32x4*)(X2B + (size_t)row * 1024 + bj * 128) = pack8(v0, v1); }
            sacc += SHFL_XOR(sacc, 16); sacc += SHFL_XOR(sacc, 32);
            if (fq == 0 && !dry) ATOMIC_ADD_F32(SS + row, sacc); }
#undef P6_LOAD
        (void)xs;
    }
};
struct EpiP7 {
    unsigned char* ws;
    DEVM void operator()(const f32x4 (&acc)[2][2][4][2], const Unit& u, int wr, int wc, int fr, int fq) const {
        const int row0 = u.pm * 256 + wr * 64 + fr, col0 = u.pn * 128 + wc * 32 + 8 * fq;
        const float* SS2 = (const float*)ws + CW_SS2; bf16_t* H = (bf16_t*)(ws + WS_HID);
        float rsv[8];
#pragma unroll
        for (int st = 0; st < 8; ++st) rsv[st] = SS2[row0 + (st >> 2) * 128 + (st & 3) * 16];
#pragma unroll
        for (int st = 0; st < 8; ++st) { const int ai = st >> 2, m = st & 3, row = row0 + ai * 128 + m * 16; const float rs = fast_rsqrt(rsv[st] * (1.f / 1024.f) + EPS);
            f32x4 h0, h1;
#pragma unroll
            for (int e = 0; e < 4; ++e) { h0[e] = siluf_(rs * acc[ai][0][m][0][e]) * (rs * acc[ai][1][m][0][e]); h1[e] = siluf_(rs * acc[ai][0][m][1][e]) * (rs * acc[ai][1][m][1][e]); }
            *(u32x4*)(H + (size_t)row * FF + col0) = pack8(h0, h1); }
    }
};
struct EpiP8 {
    unsigned char* ws; float* out; int dry;
    DEVM void operator()(const f32x4 (&acc)[2][2][4][2], const Unit& u, int wr, int wc, int fr, int fq) const {
        const int row0 = u.pm * 256 + wr * 64 + fr, col0 = u.pn * 256 + wc * 32 + 8 * fq;
        const bf16_t* X2 = (const bf16_t*)(ws + WS_XP2B) + col0; float* SS = (float*)ws + CW_SS3; float* ob = out + O_YP + col0;
        u32x4 xq[2][2];
#define P8_LOAD(st_, buf_) do { const bf16_t* xr_ = X2 + (size_t)(row0 + ((st_) >> 2) * 128 + ((st_) & 3) * 16) * 1024; \
            xq[buf_][0] = *(const u32x4*)xr_; xq[buf_][1] = *(const u32x4*)(xr_ + 128); } while (0)
        P8_LOAD(0, 0);
#pragma unroll
        for (int st = 0; st < 8; ++st) { const int ai = st >> 2, m = st & 3, cb_ = st & 1, row = row0 + ai * 128 + m * 16; float sacc = 0.f;
            if (st < 7) P8_LOAD(st + 1, cb_ ^ 1);
#pragma unroll
            for (int bj = 0; bj < 2; ++bj) { float p[8]; unpack8(xq[cb_][bj], p); f32x4 v0 = acc[ai][bj][m][0], v1 = acc[ai][bj][m][1];
#pragma unroll
                for (int e = 0; e < 4; ++e) { v0[e] += p[e]; v1[e] += p[4 + e]; }
                sacc += (v0[0] * v0[0] + v0[1] * v0[1]) + (v0[2] * v0[2] + v0[3] * v0[3]) + (v1[0] * v1[0] + v1[1] * v1[1]) + (v1[2] * v1[2] + v1[3] * v1[3]);
                float* o = ob + (size_t)row * D + bj * 128; *(f32x4*)o = v0; *(f32x4*)(o + 4) = v1; }
            sacc += SHFL_XOR(sacc, 16); sacc += SHFL_XOR(sacc, 32);
            if (fq == 0 && !dry) ATOMIC_ADD_F32(SS + row, sacc); }
#undef P8_LOAD
    }
};

template <bool AF32, bool SUMSQ>
DEV void skinny_core(Frame& F, const void* A_, size_t lda, const bf16_t* B, size_t ldb, int K, f32x4 (&acc)[2][2], float& ssq) {
    const int tid = F.tid, w = F.wave, l15 = F.lane & 15, lq = F.lane >> 4;
    LAS bf16_t* BL = (LAS bf16_t*)F.lds;
    const bf16_t* ap = (const bf16_t*)A_ + (size_t)(16 * w + l15) * lda + 8 * lq;
    const float* apf = (const float*)A_ + (size_t)(16 * w + l15) * lda + 8 * lq;
    const int r0 = tid >> 5, ch = tid & 31;
    u32x4 st[4];
#pragma unroll
    for (int hf = 0; hf < 2; ++hf)
#pragma unroll
        for (int nf = 0; nf < 2; ++nf) acc[hf][nf] = (f32x4){0.f, 0.f, 0.f, 0.f};
    BLOCK_SYNC();
#pragma unroll
    for (int i = 0; i < 4; ++i) { const int r = r0 + 16 * i; st[i] = *(const u32x4*)(B + (size_t)((r & 31) + (r >> 5) * 128) * ldb + 8 * ch); }
#pragma unroll
    for (int i = 0; i < 4; ++i) *(LAS u32x4*)(BL + (r0 + 16 * i) * 264 + 8 * ch) = st[i];
    int cur = 0;
#pragma unroll 1
    for (int k0 = 0; k0 < K; k0 += 256) { bf16x8 a[8];
        if (AF32) { f32x4 lo[8], hi[8];
#pragma unroll
            for (int u = 0; u < 8; ++u) { lo[u] = *(const f32x4*)(apf + k0 + 32 * u); hi[u] = *(const f32x4*)(apf + k0 + 32 * u + 4); }
#pragma unroll
            for (int u = 0; u < 8; ++u) { a[u] = __builtin_bit_cast(bf16x8, pack8(lo[u], hi[u]));
                if (SUMSQ) ssq += (lo[u][0] * lo[u][0] + lo[u][1] * lo[u][1]) + (lo[u][2] * lo[u][2] + lo[u][3] * lo[u][3]) + (hi[u][0] * hi[u][0] + hi[u][1] * hi[u][1]) + (hi[u][2] * hi[u][2] + hi[u][3] * hi[u][3]); } }
        else {
#pragma unroll
            for (int u = 0; u < 8; ++u) a[u] = *(const bf16x8*)(ap + k0 + 32 * u); }
        const bool more = k0 + 256 < K;
        if (more) {
#pragma unroll
            for (int i = 0; i < 4; ++i) { const int r = r0 + 16 * i; st[i] = *(const u32x4*)(B + (size_t)((r & 31) + (r >> 5) * 128) * ldb + k0 + 256 + 8 * ch); } }
        BLOCK_SYNC();
        const LAS bf16_t* bl = BL + cur * (64 * 264);
#pragma unroll
        for (int u = 0; u < 8; ++u)
#pragma unroll
            for (int hf = 0; hf < 2; ++hf)
#pragma unroll
                for (int nf = 0; nf < 2; ++nf) { const bf16x8 x = *(const LAS bf16x8*)(bl + (32 * hf + 16 * nf + l15) * 264 + 32 * u + 8 * lq); acc[hf][nf] = MFMA16(x, a[u], acc[hf][nf]); }
        if (more) {
#pragma unroll
            for (int i = 0; i < 4; ++i) *(LAS u32x4*)(BL + (cur ^ 1) * (64 * 264) + (r0 + 16 * i) * 264 + 8 * ch) = st[i]; }
        cur ^= 1; }
}
DEV u32x2 pack4(const f32x4& v) { u32x2 o; o.x = cvt_pk_bf16(v[0], v[1]); o.y = cvt_pk_bf16(v[2], v[3]); return o; }
DEV void sk_inproj_item(Frame& F, int item) {
    const int pn = item >> 2, cg = item & 3, w = F.wave, l15 = F.lane & 15, lq = F.lane >> 4, row = MP + 16 * w + l15;
    f32x4 acc[2][2];
    float dummy = 0.f; skinny_core<false, false>(F, WSP(const bf16_t, WS_XN) + (size_t)MP * 1024, 1024, WSP(const bf16_t, WS_WIN) + (size_t)(pn * 256 + 32 * cg) * 1024, 1024, 1024, acc, dummy);
#pragma unroll
    for (int nf = 0; nf < 2; ++nf) { const int cb = 32 * cg + 16 * nf + 4 * lq; f32x4 v0 = acc[0][nf], v1 = acc[1][nf];
        if (pn < 4 || (pn >= 12 && pn < 20) || (pn >= 32 && pn < 36)) { const int coff = pn < 4 ? pn * 256 : (pn < 20 ? 1024 + (pn - 12) * 256 : 3072 + (pn - 32) * 256);
            bf16_t* o = WSP(bf16_t, WS_ACAT) + (size_t)row * 4096 + coff + cb; *(u32x2*)o = pack4(v0); *(u32x2*)(o + 128) = pack4(v1); }
        else if (pn < 12) { *(u32x2*)(WSP(bf16_t, WS_U) + (size_t)row * 1024 + 128 * (pn - 4) + cb) = pack4(v0 * v1); }
        else if (pn < 32) { bf16_t* o = WSP(bf16_t, WS_XBC) + (size_t)row * XBCW + (pn - 20) * 256 + cb; *(u32x2*)o = pack4(v0); *(u32x2*)(o + 128) = pack4(v1); }
        else if (pn < 48) {
#pragma unroll
            for (int e = 0; e < 4; ++e) { v0[e] = sigmoidf_(v0[e]); v1[e] = sigmoidf_(v1[e]); }
            bf16_t* o = WSP(bf16_t, WS_G) + (size_t)row * 3072 + (pn - 36) * 256 + cb; *(u32x2*)o = pack4(v0); *(u32x2*)(o + 128) = pack4(v1); }
        else if (cg == 0) { const f32x4 b = *(const f32x4*)(F.P->in[I_DTB] + cb); f32x4 d;
#pragma unroll
            for (int e = 0; e < 4; ++e) d[e] = softplusf_(v0[e] + b[e]);
            *(f32x4*)(WSP(float, WS_DT) + (size_t)row * 32 + cb) = d; } }
}
DEV void sk_merge_item(Frame& F, int item) {
    const int pc = item >> 3, kc = item & 7, pn = pc >> 2, cg = pc & 3, w = F.wave, l15 = F.lane & 15, lq = F.lane >> 4, s = 16 * w + l15, row = MP + s;
    const int seg = kc < 2 ? 0 : (kc < 6 ? 1 : 2), koff = 512 * kc;
    f32x4 acc[2][2]; float dummy = 0.f;
    skinny_core<false, false>(F, WSP(const bf16_t, WS_ACAT) + (size_t)MP * 4096 + koff, 4096, WSP(const bf16_t, WS_WCAT) + (size_t)(pn * 256 + 32 * cg) * 4096 + koff, 4096, 512, acc, dummy);
    if (s < DEC && !F.dry) { float* SM = (float*)F.ws + CW_SM + (size_t)s * 1024;
#pragma unroll
        for (int hf = 0; hf < 2; ++hf)
#pragma unroll
            for (int nf = 0; nf < 2; ++nf) { const int col = pn * 256 + 128 * hf + 32 * cg + 16 * nf + 4 * lq; const u32x2 g = *(const u32x2*)(WSP(const bf16_t, WS_G) + (size_t)row * 3072 + seg * 1024 + col);
                ATOMIC_ADD_F32(SM + col, bflo(g.x) * acc[hf][nf][0]); ATOMIC_ADD_F32(SM + col + 1, bfhi(g.x) * acc[hf][nf][1]);
                ATOMIC_ADD_F32(SM + col + 2, bflo(g.y) * acc[hf][nf][2]); ATOMIC_ADD_F32(SM + col + 3, bfhi(g.y) * acc[hf][nf][3]); } }
}
DEV void sk_mergeo_item(Frame& F, int item) {
    const int pc = item >> 2, kc = item & 3, pn = pc >> 2, cg = pc & 3, w = F.wave, l15 = F.lane & 15, lq = F.lane >> 4, s = 16 * w + l15;
    f32x4 acc[2][2]; float dummy = 0.f;
    skinny_core<true, false>(F, (const float*)F.ws + CW_SM + 256 * kc, 1024, WSP(const bf16_t, WS_WMO) + (size_t)(pn * 256 + 32 * cg) * 1024 + 256 * kc, 1024, 256, acc, dummy);
    if (s < DEC && !F.dry) { float* X = WSP(float, WS_XP2) + (size_t)(MP + s) * 1024;
#pragma unroll
        for (int hf = 0; hf < 2; ++hf)
#pragma unroll
            for (int nf = 0; nf < 2; ++nf) { const int col = pn * 256 + 128 * hf + 32 * cg + 16 * nf + 4 * lq;
#pragma unroll
                for (int e = 0; e < 4; ++e) ATOMIC_ADD_F32(X + col + e, acc[hf][nf][e]); } }
}
DEV void sk_up_item(Frame& F, int item) {
    const int pn = item >> 2, cg = item & 3, w = F.wave, l15 = F.lane & 15, lq = F.lane >> 4, row = MP + 16 * w + l15;
    f32x4 acc[2][2]; float ssq = 0.f;
    skinny_core<true, true>(F, WSP(const float, WS_XP2) + (size_t)MP * 1024, 1024, WSP(const bf16_t, WS_WGU) + (size_t)(pn * 256 + 32 * cg) * 1024, 1024, 1024, acc, ssq);
    ssq += SHFL_XOR(ssq, 16); ssq += SHFL_XOR(ssq, 32);
    const float rs = fast_rsqrt(ssq * (1.f / 1024.f) + EPS);
#pragma unroll
    for (int nf = 0; nf < 2; ++nf) { f32x4 h;
#pragma unroll
        for (int e = 0; e < 4; ++e) h[e] = siluf_(rs * acc[0][nf][e]) * (rs * acc[1][nf][e]);
        *(u32x2*)(WSP(bf16_t, WS_HID) + (size_t)row * FF + pn * 128 + 32 * cg + 16 * nf + 4 * lq) = pack4(h); }
}
DEV void sk_down_item(Frame& F, int item) {
    const int pc = item / 11, kc = item - 11 * pc, pn = pc >> 2, cg = pc & 3, w = F.wave, l15 = F.lane & 15, lq = F.lane >> 4, s = 16 * w + l15;
    f32x4 acc[2][2]; float dummy = 0.f;
    skinny_core<false, false>(F, WSP(const bf16_t, WS_HID) + (size_t)MP * FF + 256 * kc, FF, WSP(const bf16_t, WS_WD) + (size_t)(pn * 256 + 32 * cg) * FF + 256 * kc, FF, 256, acc, dummy);
    if (s < DEC && !F.dry) { float* O = F.out + O_YS + (size_t)s * D;
#pragma unroll
        for (int hf = 0; hf < 2; ++hf)
#pragma unroll
            for (int nf = 0; nf < 2; ++nf) { const int col = pn * 256 + 128 * hf + 32 * cg + 16 * nf + 4 * lq;
#pragma unroll
                for (int e = 0; e < 4; ++e) ATOMIC_ADD_F32(O + col + e, acc[hf][nf][e]); } }
}
DEV void copy_sample_rows(Frame& F, const float* src, float* dst) {
    for (int i = F.bid * 512 + F.tid; i < DEC * 256; i += F.G * 512) ((f32x4*)dst)[i] = ((const f32x4*)src)[i];
}

DEV void conv8(const bf16_t* XBC, int rowbase, int t, int col, const float* cw, const float* cbias, float (&o)[8]) {
    const f32x4 b0 = *(const f32x4*)(cbias + col), b1 = *(const f32x4*)(cbias + col + 4);
    float a[8] = {b0[0], b0[1], b0[2], b0[3], b1[0], b1[1], b1[2], b1[3]};
#pragma unroll
    for (int k = 0; k < 4; ++k) { const int tt = t - 3 + k;
        if (tt >= 0) { float x[8]; unpack8(*(const u32x4*)(XBC + (size_t)(rowbase + tt) * XBCW + col), x);
            const f32x4 w0 = *(const f32x4*)(cw + k * XBCW + col), w1 = *(const f32x4*)(cw + k * XBCW + col + 4);
#pragma unroll
            for (int e = 0; e < 4; ++e) { a[e] += w0[e] * x[e]; a[4 + e] += w1[e] * x[4 + e]; } } }
#pragma unroll
    for (int e = 0; e < 8; ++e) o[e] = siluf_(a[e]);
}

DEV bf16x8 tr_frag(const LAS bf16_t* tile, int pitch, int kr0, int c0, int l15, int lq) {
    const LAS bf16_t* p = tile + (kr0 + 8 * lq + (l15 >> 2)) * pitch + c0 + 4 * (l15 & 3);
    const s16x4_t lo = LDS_TR(p), hi = LDS_TR(p + 4 * pitch);
    bf16x8 r; r[0] = lo[0]; r[1] = lo[1]; r[2] = lo[2]; r[3] = lo[3]; r[4] = hi[0]; r[5] = hi[1]; r[6] = hi[2]; r[7] = hi[3]; return r;
}
template <int N, bool SCALE>
DEV void conv_stage_rows(const bf16_t* XBC, int rowbase, int t0, int col, int ja, const float* cw, const float* cbias, LAS bf16_t* dst, int dpitch, const LAS float* rowscale, int hq) {
    const bf16_t* src = XBC + (size_t)rowbase * XBCW + col; const int tb = t0 + ja;
    u32x4 raw[N + 3];
#pragma unroll
    for (int i = 0; i < N + 3; ++i) { raw[i] = (u32x4){0u, 0u, 0u, 0u}; if (tb - 3 + i >= 0) raw[i] = *(const u32x4*)(src + (size_t)(tb - 3 + i) * XBCW); }
    float wk[4][8], bs[8], x0[8], x1[8], x2[8];
#pragma unroll
    for (int k = 0; k < 4; ++k) { const f32x4 a = *(const f32x4*)(cw + k * XBCW + col), b = *(const f32x4*)(cw + k * XBCW + col + 4);
#pragma unroll
        for (int e = 0; e < 4; ++e) { wk[k][e] = a[e]; wk[k][4 + e] = b[e]; } }
    { const f32x4 a = *(const f32x4*)(cbias + col), b = *(const f32x4*)(cbias + col + 4);
#pragma unroll
      for (int e = 0; e < 4; ++e) { bs[e] = a[e]; bs[4 + e] = b[e]; } }
    SCHEDB();
    unpack8(raw[0], x0); unpack8(raw[1], x1); unpack8(raw[2], x2);
#pragma unroll
    for (int jj = 0; jj < N; ++jj) { float x3[8], o[8]; unpack8(raw[jj + 3], x3);
        float sc = 1.f; if (SCALE) sc = rowscale[(ja + jj) * 8 + hq];
#pragma unroll
        for (int e = 0; e < 8; ++e) { o[e] = siluf_(bs[e] + wk[0][e] * x0[e] + wk[1][e] * x1[e] + wk[2][e] * x2[e] + wk[3][e] * x3[e]) * sc; x0[e] = x1[e]; x1[e] = x2[e]; x2[e] = x3[e]; }
        u32x4 pw; pw.x = pk2(o[0], o[1]); pw.y = pk2(o[2], o[3]); pw.z = pk2(o[4], o[5]); pw.w = pk2(o[6], o[7]);
        *(LAS u32x4*)(dst + (ja + jj) * dpitch) = pw; }
}
DEV void chunk_dt_acum(const float* DT, const float* alog, int row0, int g, int hq, int lane, LAS float* acum, LAS float* dtv) {
    const int h = 8 * g + hq; const float a = -expf(alog[h]);
    const float d0 = DT[(size_t)(row0 + 2 * lane) * 32 + h], d1 = DT[(size_t)(row0 + 2 * lane + 1) * 32 + h];
    const float v0 = d0 * a, v1 = v0 + d1 * a; float s = v1;
#pragma unroll
    for (int d = 1; d < 64; d <<= 1) { const float t = SHFL(s, (lane - d) & 63); if (lane >= d) s += t; }
    const float ex = s - v1;
    acum[(2 * lane) * 8 + hq] = ex + v0; acum[(2 * lane + 1) * 8 + hq] = s;
    dtv[(2 * lane) * 8 + hq] = d0; dtv[(2 * lane + 1) * 8 + hq] = d1;
}

DEV void ssd_states_item(Frame& F, int item) {
    const int g = item & 3, c = (item >> 2) % NCH, b = (item >> 2) / NCH;
    const int tid = F.tid, lane = F.lane, w = F.wave, l15 = lane & 15, lq = lane >> 4;
    LAS float* acum = (LAS float*)F.lds; LAS float* dtv = acum + 1024; LAS float* wgt = acum + 2048;
    LAS bf16_t* BL = (LAS bf16_t*)(F.lds + 12288);
    LAS bf16_t* XL = (LAS bf16_t*)(F.lds + 12288 + 34816);
    const bf16_t* XBC = WSP(const bf16_t, WS_XBC); const float* DT = WSP(const float, WS_DT);
    const float* cw = F.P->in[I_SSMCW]; const float* cbias = F.P->in[I_SSMCB];
    const int rowbase = b * SEQ, t0 = c * 128, row0 = rowbase + t0;
    BLOCK_SYNC();
    chunk_dt_acum(DT, F.P->in[I_ALOG], row0, g, w, lane, acum, dtv);
    BLOCK_SYNC();
    for (int i = tid; i < 1024; i += 512) wgt[i] = expf(acum[127 * 8 + (i & 7)] - acum[i]) * dtv[i];
    if (tid < 8) WSP(float, WS_CDEC)[(size_t)(b * NCH + c) * 32 + 8 * g + tid] = expf(acum[127 * 8 + tid]);
    BLOCK_SYNC();
#pragma unroll 1
    for (int task = tid; task < 768; task += 512) { const int cgI = task % 48, seg = task / 48;
        if (cgI < 16) conv_stage_rows<8, false>(XBC, rowbase, t0, DIN + g * 128 + 8 * cgI, 8 * seg, cw, cbias, BL + 8 * cgI, 136, wgt, 0);
        else { const int c2 = cgI - 16, hh = c2 >> 3; conv_stage_rows<8, true>(XBC, rowbase, t0, (8 * g + hh) * 64 + 8 * (c2 & 7), 8 * seg, cw, cbias, XL + 8 * c2, 264, wgt, hh); } }
    BLOCK_SYNC();
    bf16x8 afr[4];
#pragma unroll
    for (int ks = 0; ks < 4; ++ks) afr[ks] = tr_frag(BL, 136, 32 * ks, 16 * w, l15, lq);
    bf16_t* CH = WSP(bf16_t, WS_CHST);
#pragma unroll 1
    for (int hb = 0; hb < 2; ++hb) {
        if (hb) { BLOCK_SYNC();
            { const int c2 = tid & 31, seg = tid >> 5, hh = c2 >> 3; conv_stage_rows<8, true>(XBC, rowbase, t0, (8 * g + 4 + hh) * 64 + 8 * (c2 & 7), 8 * seg, cw, cbias, XL + 8 * c2, 264, wgt, 4 + hh); }
            BLOCK_SYNC(); }
#pragma unroll
        for (int hh = 0; hh < 4; ++hh) { const int h = 8 * g + 4 * hb + hh;
#pragma unroll
            for (int pf = 0; pf < 4; ++pf) { f32x4 a4 = (f32x4){0.f, 0.f, 0.f, 0.f};
#pragma unroll
                for (int ks = 0; ks < 4; ++ks) a4 = MFMA16(afr[ks], tr_frag(XL, 264, 32 * ks, hh * 64 + 16 * pf, l15, lq), a4);
                u32x2 o; o.x = pk2(a4[0], a4[1]); o.y = pk2(a4[2], a4[3]);
                *(u32x2*)(CH + ((size_t)(b * NCH + c) * 32 + h) * 8192 + (16 * pf + l15) * 128 + 16 * w + 4 * lq) = o; } }
    }
}

DEV void attn_item(Frame& F, int item) {
    const int qt = item % (SEQ / 128), h = (item / (SEQ / 128)) & 3, b = item / (SEQ / 128) / 4;
    const int tid = F.tid, lane = F.lane, w = F.wave, l15 = lane & 15, lq = lane >> 4;
    LAS bf16_t* KL = (LAS bf16_t*)F.lds;
    const bf16_t* KBh = WSP(const bf16_t, WS_KB) + (size_t)(b * HEADS + h) * MEM * HD;
    const bf16_t* VTh = WSP(const bf16_t, WS_VT) + (size_t)(b * HEADS + h) * MEM * HD;
    bf16_t* QO = WSP(bf16_t, WS_ACAT) + (size_t)(b * SEQ + qt * 128 + 16 * w + l15) * 4096 + 3072 + h * HD;
    BLOCK_SYNC();
#pragma unroll 4
    for (int it = 0; it < 16; ++it) { const int idx = tid + 512 * it, row = idx >> 5, ch = idx & 31; *(LAS u32x4*)(KL + row * 264 + 8 * ch) = *(const u32x4*)(KBh + row * 256 + 8 * ch); }
    bf16x8 qf[8];
#pragma unroll
    for (int ks = 0; ks < 8; ++ks) qf[ks] = *(const bf16x8*)(QO + 32 * ks + 8 * lq);
    BLOCK_SYNC();
    f32x4 st[16];
#pragma unroll
    for (int kf = 0; kf < 16; ++kf) { f32x4 a4 = (f32x4){0.f, 0.f, 0.f, 0.f};
#pragma unroll
        for (int ks = 0; ks < 8; ++ks) { const bf16x8 afr = *(const LAS bf16x8*)(KL + (16 * kf + l15) * 264 + 32 * ks + 8 * lq); a4 = MFMA16(afr, qf[ks], a4); }
        st[kf] = a4; }
    float mx = -3.0e38f;
#pragma unroll
    for (int kf = 0; kf < 16; ++kf) mx = fmaxf(fmaxf(fmaxf(st[kf][0], st[kf][1]), fmaxf(st[kf][2], st[kf][3])), mx);
    mx = fmaxf(mx, SHFL_XOR(mx, 16)); mx = fmaxf(mx, SHFL_XOR(mx, 32));
    float sum = 0.f;
#pragma unroll
    for (int kf = 0; kf < 16; ++kf)
#pragma unroll
        for (int r = 0; r < 4; ++r) { const float p = fast_exp((st[kf][r] - mx) * 0.0625f); st[kf][r] = p; sum += p; }
    sum += SHFL_XOR(sum, 16); sum += SHFL_XOR(sum, 32);
    const float inv = 1.0f / sum;
    u32x2 pk[16];
#pragma unroll
    for (int kf = 0; kf < 16; ++kf) { pk[kf].x = pk2(st[kf][0] * inv, st[kf][1] * inv); pk[kf].y = pk2(st[kf][2] * inv, st[kf][3] * inv); }
    BLOCK_SYNC();
#pragma unroll 4
    for (int it = 0; it < 16; ++it) { const int idx = tid + 512 * it, row = idx >> 5, ch = idx & 31; *(LAS u32x4*)(KL + row * 264 + 8 * ch) = *(const u32x4*)(VTh + row * 256 + 8 * ch); }
    BLOCK_SYNC();
#pragma unroll
    for (int df = 0; df < 16; ++df) { f32x4 a4 = (f32x4){0.f, 0.f, 0.f, 0.f};
#pragma unroll
        for (int s = 0; s < 8; ++s) { const LAS bf16_t* vp = KL + (16 * df + l15) * 264 + 32 * s + 4 * lq;
            const u32x2 lo = *(const LAS u32x2*)vp, hi = *(const LAS u32x2*)(vp + 16);
            u32x4 av; av.x = lo.x; av.y = lo.y; av.z = hi.x; av.w = hi.y;
            u32x4 bv; bv.x = pk[2 * s].x; bv.y = pk[2 * s].y; bv.z = pk[2 * s + 1].x; bv.w = pk[2 * s + 1].y;
            a4 = MFMA16(__builtin_bit_cast(bf16x8, av), __builtin_bit_cast(bf16x8, bv), a4); }
        u32x2 o; o.x = pk2(a4[0], a4[1]); o.y = pk2(a4[2], a4[3]);
        if (!F.dry) *(u32x2*)(QO + 16 * df + 4 * lq) = o; }
}

DEV void yain_item(Frame& F, int item) {
    const bf16_t* U = WSP(const bf16_t, WS_U); const float* w = F.P->in[I_SCW];
    const int col = 8 * (F.tid & 127), r0 = item * 16 + (F.tid >> 7);
    u32x4 ru[4][3], rs[4];
#pragma unroll
    for (int q = 0; q < 4; ++q) { const int row = r0 + 4 * q, t = row % SEQ;
#pragma unroll
        for (int k = 0; k < 3; ++k) { ru[q][k] = (u32x4){0u, 0u, 0u, 0u}; if (t - 2 + k >= 0) ru[q][k] = *(const u32x4*)(U + (size_t)(row - 2 + k) * 1024 + col); }
        rs[q] = *(const u32x4*)(WSP(const bf16_t, WS_ACAT) + (size_t)row * 4096 + col); }
    const f32x4 w0a = *(const f32x4*)(w + col), w0b = *(const f32x4*)(w + col + 4), w1a = *(const f32x4*)(w + 1024 + col), w1b = *(const f32x4*)(w + 1024 + col + 4),
                w2a = *(const f32x4*)(w + 2048 + col), w2b = *(const f32x4*)(w + 2048 + col + 4);
    const float w0[8] = {w0a[0], w0a[1], w0a[2], w0a[3], w0b[0], w0b[1], w0b[2], w0b[3]}, w1[8] = {w1a[0], w1a[1], w1a[2], w1a[3], w1b[0], w1b[1], w1b[2], w1b[3]},
                w2[8] = {w2a[0], w2a[1], w2a[2], w2a[3], w2b[0], w2b[1], w2b[2], w2b[3]};
#pragma unroll
    for (int q = 0; q < 4; ++q) { float u0[8], u1[8], u2[8], sb[8], y[8];
        unpack8(ru[q][0], u0); unpack8(ru[q][1], u1); unpack8(ru[q][2], u2); unpack8(rs[q], sb);
#pragma unroll
        for (int e = 0; e < 8; ++e) y[e] = sb[e] * (w0[e] * u0[e] + w1[e] * u1[e] + w2[e] * u2[e]);
        u32x4 o; o.x = pk2(y[0], y[1]); o.y = pk2(y[2], y[3]); o.z = pk2(y[4], y[5]); o.w = pk2(y[6], y[7]);
        if (!F.dry) *(u32x4*)(WSP(bf16_t, WS_ACAT) + (size_t)(r0 + 4 * q) * 4096 + col) = o; }
}
DEV void pstate_item(Frame& F, int b) {
    const bf16_t* U = WSP(const bf16_t, WS_U); const bf16_t* XBC = WSP(const bf16_t, WS_XBC);
    for (int i = F.tid; i < 2 * 1024; i += 512) { const int k = i >> 10, cc = i & 1023; F.out[O_PCONV + (size_t)(b * 2 + k) * 1024 + cc] = bf1(U[(size_t)(b * SEQ + SEQ - 2 + k) * 1024 + cc]); }
    for (int i = F.tid; i < 3 * XBCW; i += 512) { const int k = i / XBCW, cc = i - k * XBCW; F.out[O_PSSMC + (size_t)(b * 3 + k) * XBCW + cc] = bf1(XBC[(size_t)(b * SEQ + SEQ - 3 + k) * XBCW + cc]); }
}
DEV void s_sconv_item(Frame& F, int item) {
    const int s = item * 4 + (F.tid >> 7), col = 8 * (F.tid & 127), row = MP + s;
    const bf16_t* U = WSP(const bf16_t, WS_U); bf16_t* A = WSP(bf16_t, WS_ACAT) + (size_t)row * 4096 + col; const float* w = F.P->in[I_SCW];
    const float* h0 = F.P->in[I_SCONV] + (size_t)(s * 2) * 1024 + col; const float* h1 = h0 + 1024;
    float un[8], sb[8], y[8];
    unpack8(*(const u32x4*)(U + (size_t)row * 1024 + col), un); unpack8(*(const u32x4*)A, sb);
    float* oc = F.out + O_SCONV + (size_t)(s * 2) * 1024 + col;
#pragma unroll
    for (int e = 0; e < 8; ++e) { y[e] = sb[e] * (w[col + e] * h0[e] + w[1024 + col + e] * h1[e] + w[2048 + col + e] * un[e]); oc[e] = h1[e]; oc[1024 + e] = un[e]; }
    u32x4 o; o.x = pk2(y[0], y[1]); o.y = pk2(y[2], y[3]); o.z = pk2(y[4], y[5]); o.w = pk2(y[6], y[7]);
    if (!F.dry) *(u32x4*)A = o;
}
DEV void s_ssmconv_state_item(Frame& F, int s) {
    const bf16_t* XBC = WSP(const bf16_t, WS_XBC) + (size_t)(MP + s) * XBCW; const float* hist = F.P->in[I_SSMCONV] + (size_t)s * 3 * XBCW; float* o = F.out + O_SSSMC + (size_t)s * 3 * XBCW;
    for (int i = F.tid; i < XBCW; i += 512) { o[i] = hist[XBCW + i]; o[XBCW + i] = hist[2 * XBCW + i]; o[2 * XBCW + i] = bf1(XBC[i]); }
}
DEV void s_ssd_item(Frame& F, int item) {
    const int g = item & 3, s = item >> 2, tid = F.tid, row = MP + s;
    LAS float* xc = (LAS float*)F.lds;
    LAS float* yb = xc + 768;
    LAS float* red = yb + 512;
    const bf16_t* XBC = WSP(const bf16_t, WS_XBC) + (size_t)row * XBCW; const float* hist = F.P->in[I_SSMCONV] + (size_t)s * 3 * XBCW;
    const float* cw = F.P->in[I_SSMCW]; const float* cbias = F.P->in[I_SSMCB];
    const int n4 = (tid & 31) * 4, pb = tid >> 5;
    const float* s0 = F.P->in[I_SSM] + ((size_t)s * 32 + 8 * g) * 8192 + pb * 128 + n4; float* s1 = F.out + O_SSSM + ((size_t)s * 32 + 8 * g) * 8192 + pb * 128 + n4;
    f32x4 so[4];
#pragma unroll
    for (int k = 0; k < 4; ++k) so[k] = ld_nt(s0 + 16 * k * 128);
    BLOCK_SYNC();
    for (int i = tid; i < 768; i += 512) { const int col = i < 512 ? g * 512 + i : (i < 640 ? DIN + g * 128 + (i - 512) : DIN + 512 + g * 128 + (i - 640));
        const float v = cbias[col] + cw[col] * hist[col] + cw[XBCW + col] * hist[XBCW + col] + cw[2 * XBCW + col] * hist[2 * XBCW + col] + cw[3 * XBCW + col] * bf1(XBC[col]);
        xc[i] = siluf_(v); }
    BLOCK_SYNC();
    const f32x4 Bv = *(const LAS f32x4*)(xc + 512 + n4), Cv = *(const LAS f32x4*)(xc + 640 + n4);
    const bf16_t* Z = WSP(const bf16_t, WS_ACAT) + (size_t)row * 4096 + 1024;
#pragma unroll 1
    for (int hq = 0; hq < 8; ++hq) { const int h = 8 * g + hq; const float dt = WSP(const float, WS_DT)[(size_t)row * 32 + h];
        const float dA = expf(dt * (-expf(F.P->in[I_ALOG][h]))), Dh = F.P->in[I_SSMD][h];
        f32x4 sn_[4];
#pragma unroll
        for (int k = 0; k < 4; ++k) sn_[k] = so[k];
        if (hq < 7) {
#pragma unroll
            for (int k = 0; k < 4; ++k) so[k] = ld_nt(s0 + (size_t)(hq + 1) * 8192 + 16 * k * 128); }
#pragma unroll
        for (int k = 0; k < 4; ++k) { const int p = pb + 16 * k; const float xv = xc[hq * 64 + p], dx = dt * xv; f32x4 sn;
#pragma unroll
            for (int e = 0; e < 4; ++e) sn[e] = sn_[k][e] * dA + dx * Bv[e];
            st_nt_f(s1 + (size_t)hq * 8192 + 16 * k * 128, sn);
            float y = (sn[0] * Cv[0] + sn[1] * Cv[1]) + (sn[2] * Cv[2] + sn[3] * Cv[3]);
            y += SHFL_XOR(y, 1); y += SHFL_XOR(y, 2); y += SHFL_XOR(y, 4); y += SHFL_XOR(y, 8); y += SHFL_XOR(y, 16);
            if ((tid & 31) == 0) { y += Dh * xv; yb[hq * 64 + p] = y * siluf_(bf1(Z[h * 64 + p])); } } }
    BLOCK_SYNC();
    const float yv = yb[tid]; const float ssw = wave_sum(yv * yv);
    if (F.lane == 0) red[F.wave] = ssw;
    BLOCK_SYNC();
    float tot = 0.f;
#pragma unroll
    for (int i = 0; i < 8; ++i) tot += red[i];
    const float rs = fast_rsqrt(tot * (1.f / 512.f) + EPS);
    if (!F.dry) WSP(bf16_t, WS_ACAT)[(size_t)row * 4096 + 1024 + g * 512 + tid] = (bf16_t)f2bf(yv * rs * F.P->in[I_SSMNW][g * 512 + tid]);
}
DEV void s_attn_item(Frame& F, int item) {
    const int h = item & 3, s = item >> 2, tid = F.tid, lane = F.lane, w = F.wave, row = MP + s;
    LAS float* sc = (LAS float*)F.lds;
    LAS float* part = sc + 256;
    bf16_t* QO = WSP(bf16_t, WS_ACAT) + (size_t)row * 4096 + 3072 + h * HD;
    const float* Kc = F.P->in[I_CK] + ((size_t)s * MEM * HEADS + h) * HD + 4 * lane; const float* Vc = F.P->in[I_CV] + ((size_t)s * MEM * HEADS + h) * HD + 4 * lane;
    BLOCK_SYNC();
    const u32x2 qw = *(const u32x2*)(QO + 4 * lane); const float q0 = bflo(qw.x), q1 = bfhi(qw.x), q2 = bflo(qw.y), q3 = bfhi(qw.y);
#pragma unroll 1
    for (int i0 = 0; i0 < 32; i0 += 8) { f32x4 kv[8];
#pragma unroll
        for (int u = 0; u < 8; ++u) kv[u] = ld_nt(Kc + (size_t)(32 * w + i0 + u) * (HEADS * HD));
#pragma unroll
        for (int u = 0; u < 8; ++u) { const float d = wave_sum((kv[u][0] * q0 + kv[u][1] * q1) + (kv[u][2] * q2 + kv[u][3] * q3)); if (lane == 0) sc[32 * w + i0 + u] = d * 0.0625f; } }
    BLOCK_SYNC();
    if (w == 0) { const f32x4 v = *(const LAS f32x4*)(sc + 4 * lane); float mx = fmaxf(fmaxf(v[0], v[1]), fmaxf(v[2], v[3]));
#pragma unroll
        for (int o = 1; o < 64; o <<= 1) mx = fmaxf(mx, SHFL_XOR(mx, o));
        f32x4 p; float sm = 0.f;
#pragma unroll
        for (int e = 0; e < 4; ++e) { p[e] = expf(v[e] - mx); sm += p[e]; }
        sm = wave_sum(sm); const float inv = 1.f / sm;
        *(LAS f32x4*)(sc + 4 * lane) = p * inv; }
    BLOCK_SYNC();
    f32x4 acc = (f32x4){0.f, 0.f, 0.f, 0.f};
#pragma unroll 1
    for (int i0 = 0; i0 < 32; i0 += 8) { f32x4 vv[8];
#pragma unroll
        for (int u = 0; u < 8; ++u) vv[u] = ld_nt(Vc + (size_t)(32 * w + i0 + u) * (HEADS * HD));
#pragma unroll
        for (int u = 0; u < 8; ++u) acc += vv[u] * sc[32 * w + i0 + u]; }
    *(LAS f32x4*)(part + w * 256 + 4 * lane) = acc;
    BLOCK_SYNC();
    if (tid < 256 && !F.dry) { float o = 0.f;
#pragma unroll
        for (int k = 0; k < 8; ++k) o += part[k * 256 + tid];
        QO[tid] = (bf16_t)f2bf(o); }
}

DEV void p3_scan(Frame& F) {
    bf16_t* CH = WSP(bf16_t, WS_CHST); const float* CDEC = WSP(const float, WS_CDEC);
    const int ntask = BATCH * 32 * 64 * 32;
    for (int i = F.bid * 512 + F.tid; i < ntask; i += F.G * 512) {
        const int n4 = (i & 31) * 4, p = (i >> 5) & 63, h = (i >> 11) & 31, b = i >> 16;
        f32x4 S = (f32x4){0.f, 0.f, 0.f, 0.f};
#pragma unroll 1
        for (int c = 0; c < NCH; ++c) { bf16_t* q = CH + ((size_t)(b * NCH + c) * 32 + h) * 8192 + p * 128 + n4; const u32x2 raw = *(const u32x2*)q; const float dec = CDEC[(size_t)(b * NCH + c) * 32 + h];
            u32x2 o; o.x = pk2(S[0], S[1]); o.y = pk2(S[2], S[3]); if (!F.dry) *(u32x2*)q = o;
            S[0] = S[0] * dec + bflo(raw.x); S[1] = S[1] * dec + bfhi(raw.x); S[2] = S[2] * dec + bflo(raw.y); S[3] = S[3] * dec + bfhi(raw.y); }
        *(f32x4*)(F.out + O_PSSM + ((size_t)(b * 32 + h) * 64 + p) * 128 + n4) = S;
    }
}

DEV void ssd_out_item(Frame& F, int item) {
    const int g = item & 3, c = (item >> 2) % NCH, b = (item >> 2) / NCH;
    const int tid = F.tid, lane = F.lane, w = F.wave, l15 = lane & 15, lq = lane >> 4;
    LAS float* acum = (LAS float*)F.lds; LAS float* dtv = acum + 1024;
    LAS bf16_t* CL = (LAS bf16_t*)(F.lds + 8192);
    LAS bf16_t* BL = (LAS bf16_t*)(F.lds + 8192 + 34816);
    LAS bf16_t* XL = (LAS bf16_t*)(F.lds + 8192);
    LAS bf16_t* SL = (LAS bf16_t*)(F.lds + 8192 + 69632);
    LAS bf16_t* MW = (LAS bf16_t*)(F.lds + 8192 + 69632 + 17408) + w * 2176;
    const bf16_t* XBC = WSP(const bf16_t, WS_XBC); const float* DT = WSP(const float, WS_DT);
    const float* cw = F.P->in[I_SSMCW]; const float* cbias = F.P->in[I_SSMCB];
    const int rowbase = b * SEQ, t0 = c * 128, row0 = rowbase + t0;
    BLOCK_SYNC();
    chunk_dt_acum(DT, F.P->in[I_ALOG], row0, g, w, lane, acum, dtv);
    { const int cgI = tid & 31, seg = tid >> 5, isC = cgI >> 4;
      conv_stage_rows<8, false>(XBC, rowbase, t0, DIN + isC * 512 + g * 128 + 8 * (cgI & 15), 8 * seg, cw, cbias, (isC ? CL : BL) + 8 * (cgI & 15), 136, acum, 0); }
    BLOCK_SYNC();
    bf16x8 cfr[4];
#pragma unroll
    for (int ks = 0; ks < 4; ++ks) cfr[ks] = *(const LAS bf16x8*)(CL + (16 * w + l15) * 136 + 32 * ks + 8 * lq);
    f32x4 cb[8];
#pragma unroll
    for (int jf = 0; jf < 8; ++jf) { f32x4 a4 = (f32x4){0.f, 0.f, 0.f, 0.f};
#pragma unroll
        for (int ks = 0; ks < 4; ++ks) { const bf16x8 bfr = *(const LAS bf16x8*)(BL + (16 * jf + l15) * 136 + 32 * ks + 8 * lq); a4 = MFMA16(bfr, cfr[ks], a4); }
        cb[jf] = a4; }
    const int il = 16 * w + l15;
    bf16_t* Zrow = WSP(bf16_t, WS_ACAT) + (size_t)(row0 + il) * 4096 + 1024;
    const bf16_t* SP = WSP(const bf16_t, WS_CHST);
    u32x2 ykeep[8][4]; float ss = 0.f;
#pragma unroll
    for (int a = 0; a < 8; ++a)
#pragma unroll
        for (int pf = 0; pf < 4; ++pf) ykeep[a][pf] = (u32x2){0u, 0u};
#pragma unroll 1
    for (int hq = 0; hq < 8; ++hq) { const int h = 8 * g + hq, hh = hq & 3;
        BLOCK_SYNC();
        if (hh == 0) { const int c2 = tid & 31, seg = tid >> 5;
            conv_stage_rows<8, false>(XBC, rowbase, t0, (8 * g + hq + (c2 >> 3)) * 64 + 8 * (c2 & 7), 8 * seg, cw, cbias, XL + 8 * c2, 264, acum, 0); }
#pragma unroll 1
        for (int it = 0; it < 2; ++it) { const int idx = tid + 512 * it, p = idx >> 4, ch = idx & 15;
            *(LAS u32x4*)(SL + p * 136 + 8 * ch) = *(const u32x4*)(SP + ((size_t)(b * NCH + c) * 32 + h) * 8192 + p * 128 + 8 * ch); }
        const float ai_ = acum[il * 8 + hq];
#pragma unroll
        for (int jf = 0; jf < 8; ++jf) { const int j0 = 16 * jf + 4 * lq; float mv[4];
#pragma unroll
            for (int r = 0; r < 4; ++r) { const int j = j0 + r; const float e = fast_exp(fminf(ai_ - acum[j * 8 + hq], 0.f)) * dtv[j * 8 + hq]; mv[r] = j <= il ? cb[jf][r] * e : 0.f; }
            u32x2 o; o.x = pk2(mv[0], mv[1]); o.y = pk2(mv[2], mv[3]); *(LAS u32x2*)(MW + l15 * 136 + j0) = o; }
        BLOCK_SYNC();
        f32x4 yd[4], yo[4];
#pragma unroll
        for (int pf = 0; pf < 4; ++pf) { yd[pf] = (f32x4){0.f, 0.f, 0.f, 0.f}; yo[pf] = (f32x4){0.f, 0.f, 0.f, 0.f}; }
#pragma unroll
        for (int ks = 0; ks < 4; ++ks) { const bf16x8 mfr = *(const LAS bf16x8*)(MW + l15 * 136 + 32 * ks + 8 * lq);
#pragma unroll
            for (int pf = 0; pf < 4; ++pf) yd[pf] = MFMA16(tr_frag(XL, 264, 32 * ks, hh * 64 + 16 * pf, l15, lq), mfr, yd[pf]); }
#pragma unroll
        for (int ks = 0; ks < 4; ++ks)
#pragma unroll
            for (int pf = 0; pf < 4; ++pf) { const bf16x8 sfr = *(const LAS bf16x8*)(SL + (16 * pf + l15) * 136 + 32 * ks + 8 * lq); yo[pf] = MFMA16(sfr, cfr[ks], yo[pf]); }
        const float ei = expf(ai_), Dh = F.P->in[I_SSMD][h];
#pragma unroll
        for (int pf = 0; pf < 4; ++pf) { const int p0 = 16 * pf + 4 * lq;
            const u32x2 xw = *(const LAS u32x2*)(XL + il * 264 + hh * 64 + p0); const u32x2 zw = *(const u32x2*)(Zrow + h * 64 + p0);
            const float xv[4] = {bflo(xw.x), bfhi(xw.x), bflo(xw.y), bfhi(xw.y)}, zv[4] = {bflo(zw.x), bfhi(zw.x), bflo(zw.y), bfhi(zw.y)}; float y[4];
#pragma unroll
            for (int r = 0; r < 4; ++r) { y[r] = (yd[pf][r] + ei * yo[pf][r] + Dh * xv[r]) * siluf_(zv[r]); ss += y[r] * y[r]; }
            u32x2 yn; yn.x = pk2(y[0], y[1]); yn.y = pk2(y[2], y[3]);
#pragma unroll
            for (int a = 0; a < 7; ++a) ykeep[a][pf] = ykeep[a + 1][pf];
            ykeep[7][pf] = yn; }
    }
    ss += SHFL_XOR(ss, 16); ss += SHFL_XOR(ss, 32);
    const float rs = fast_rsqrt(ss * (1.f / 512.f) + EPS); const float* nw = F.P->in[I_SSMNW] + g * 512;
#pragma unroll
    for (int hq = 0; hq < 8; ++hq)
#pragma unroll
        for (int pf = 0; pf < 4; ++pf) { const int cidx = hq * 64 + 16 * pf + 4 * lq; const f32x4 wv = *(const f32x4*)(nw + cidx); const u32x2 k = ykeep[hq][pf];
            u32x2 o; o.x = pk2(bflo(k.x) * rs * wv[0], bfhi(k.x) * rs * wv[1]); o.y = pk2(bflo(k.y) * rs * wv[2], bfhi(k.y) * rs * wv[3]);
            if (!F.dry) *(u32x2*)(Zrow + g * 512 + cidx) = o; }
}

DEV void p9_final(Frame& F) {
    const int gw = F.bid * 8 + F.wave, NGW = F.G * 8, lane = F.lane; const float* SS3 = (const float*)F.ws + CW_SS3; const f32x4* wv = (const f32x4*)F.P->in[I_NFIN] + lane;
    for (int m = gw; m < MP + DEC; m += NGW) { f32x4* x = (f32x4*)(F.out + O_YP + (size_t)m * D) + lane; f32x4 v[4]; float rs;
#pragma unroll
        for (int j = 0; j < 4; ++j) v[j] = x[64 * j];
        if (m < MP) rs = fast_rsqrt(SS3[m] * (1.f / 1024.f) + EPS);
        else { float s = 0.f;
#pragma unroll
            for (int j = 0; j < 4; ++j) s += (v[j][0] * v[j][0] + v[j][1] * v[j][1]) + (v[j][2] * v[j][2] + v[j][3] * v[j][3]);
            rs = fast_rsqrt(wave_sum(s) * (1.f / 1024.f) + EPS); }
#pragma unroll
        for (int j = 0; j < 4; ++j) { const f32x4 ww = wv[64 * j]; f32x4 o = v[j] * rs; o = o * ww; st_nt_f(x + 64 * j, o); } }
}

constexpr int N_PHASES = 10;
#ifndef PH_MASK
#define PH_MASK 0x3ff
#endif
#define PH_ON(k) ((PH_MASK >> (k)) & 1)
DEV void run_phase(const Frame& F0, int ph) {
    if (!((PH_MASK >> ph) & 1)) return;
    Frame F = F0;
    OPAQUE_V(F.tid); OPAQUE_S(F.bid); OPAQUE_S(F.G);
    F.lane = F.tid & 63; F.wave = RFL(F.tid >> 6);
    const int G = F.G, bid = F.bid;
    if (ph == 0) { p0_prep(F); }
    else if (ph == 1) {
        SchedP1 S{(const char*)(F.ws + WS_XN), (const char*)(F.ws + WS_WIN), (const char*)(F.ws + WS_MEMN), (const char*)(F.ws + WS_WKV), G, bid};
        EpiP1 E{F.ws, F.out, F.P->in[I_DTB]};
        { const int hb = G / 2; if (bid >= hb) for (int it = bid - hb; it < IN_TILES * 4; it += G - hb) sk_inproj_item(F, it); }
        BLOCK_SYNC();
        pg8::gemm_phase(F.lds, 1024, S, E);
    } else if (ph == 2) {
        constexpr int N_ATT = BATCH * HEADS * (SEQ / 128), N_ST = BATCH * NCH * 4, N_SATT = DEC * 4, N_YA = MP / 16, N_SSC = DEC / 4, N_SST = DEC, N_PST = BATCH;
        constexpr int TOT = N_ATT + N_ST + N_SATT + N_YA + N_SSC + N_SST + N_PST;
        const int nk = bid < TOT ? (TOT - 1 - bid) / G + 1 : 0;
        for (int k = 0; k < nk; ++k) { int r = bid + ((bid & 1) ? nk - 1 - k : k) * G;
            Frame Fi = F; OPAQUE_V(Fi.tid); Fi.lane = Fi.tid & 63;
            if (r < N_ATT) { if (F.sub & 1) attn_item(Fi, r); continue; } r -= N_ATT;
            if (r < N_ST) { if (F.sub & 2) ssd_states_item(Fi, r); continue; } r -= N_ST;
            if (r < N_SATT) { if (F.sub & 4) s_attn_item(Fi, r); continue; } r -= N_SATT;
            if (r < N_YA) { if (F.sub & 16) yain_item(Fi, r); continue; } r -= N_YA;
            if (r < N_SSC) { if (F.sub & 32) s_sconv_item(Fi, r); continue; } r -= N_SSC;
            if (r < N_SST) { if (F.sub & 32) s_ssmconv_state_item(Fi, r); continue; } r -= N_SST;
            if (F.sub & 32) pstate_item(Fi, r); }
    } else if (ph == 3) { p3_scan(F); }
    else if (ph == 4) {
        constexpr int N_OUT = BATCH * NCH * 4, TOT = N_OUT + DEC * 4;
        const int nk = bid < TOT ? (TOT - 1 - bid) / G + 1 : 0;
        for (int k = 0; k < nk; ++k) { const int r = bid + ((bid & 1) ? nk - 1 - k : k) * G; Frame Fi = F; OPAQUE_V(Fi.tid); Fi.lane = Fi.tid & 63;
            if (r < N_OUT) { if (F.sub & 1) ssd_out_item(Fi, r); } else { if (F.sub & 8) s_ssd_item(Fi, r - N_OUT); } }
    }
    else if (ph == 5) {
        SchedP5 S{(const char*)(F.ws + WS_ACAT), (const char*)(F.ws + WS_WCAT), G, bid}; EpiP5 E{F.ws};
        copy_sample_rows(F, F.P->in[I_XS], WSP(float, WS_XP2) + (size_t)MP * 1024);
        for (int it = bid; it < 128; it += G) sk_merge_item(F, it);
        BLOCK_SYNC();
        pg8::gemm_phase(F.lds, 4096, S, E);
    } else if (ph == 6) {
        SchedPlain S{(const char*)(F.ws + WS_MERGED), (const char*)(F.ws + WS_WMO), MT_P, 4, 16, G, bid, (size_t)1024 * 2}; EpiP6 E{F.ws, F.P->in[I_XP], F.P->in[I_XS], F.dry};
        for (int it = bid; it < 64; it += G) sk_mergeo_item(F, it);
        BLOCK_SYNC();
        pg8::gemm_phase(F.lds, 1024, S, E);
    } else if (ph == 7) {
        SchedPlain S{(const char*)(F.ws + WS_XP2B), (const char*)(F.ws + WS_WGU), MT_P, GU_TILES, 16, G, bid, (size_t)1024 * 2}; EpiP7 E{F.ws};
        copy_sample_rows(F, WSP(const float, WS_XP2) + (size_t)MP * 1024, F.out + O_YS);
        { const int hb = G / 2; if (bid >= hb) for (int it = bid - hb; it < GU_TILES * 4; it += G - hb) sk_up_item(F, it); }
        BLOCK_SYNC();
        pg8::gemm_phase(F.lds, 1024, S, E);
    } else if (ph == 8) {
        SchedPlain S{(const char*)(F.ws + WS_HID), (const char*)(F.ws + WS_WD), MT_P, 4, FF / 64, G, bid, (size_t)FF * 2}; EpiP8 E{F.ws, F.out, F.dry};
        for (int it = bid; it < 176; it += G) sk_down_item(F, it);
        BLOCK_SYNC();
        pg8::gemm_phase(F.lds, FF, S, E);
    } else if (ph == 9) { p9_final(F); }
}

#ifndef HOST_EMU
#define XB_TMO      128
#define XB_XCNT(j)  (256  + 64 * (j))
#define XB_XSUB(j)  (1280 + 64 * (j))
#define XB_XGEN(j)  (2304 + 64 * (j))
#define XB_TOP      3328
#define XB_TOPGEN   3392
#define XCD_BAR_WORDS 3456
#define XB_SPIN_CAP (1u << 18)
__device__ __forceinline__ unsigned xb_ld(unsigned* p)              { return __hip_atomic_load(p, __ATOMIC_RELAXED, __HIP_MEMORY_SCOPE_AGENT); }
__device__ __forceinline__ unsigned xb_add(unsigned* p, unsigned v) { return __hip_atomic_fetch_add(p, v, __ATOMIC_RELAXED, __HIP_MEMORY_SCOPE_AGENT); }
__device__ __forceinline__ unsigned xb_xcc_id() { return (unsigned)__builtin_amdgcn_s_getreg((3 << 11) | 20) & 0xFu; }
#define XB_SPIN(cond, bar) do { unsigned _sp = 0; while (cond) { __builtin_amdgcn_s_sleep(1); \
    if ((++_sp & 255u) == 0u) { if (xb_ld(&(bar)[XB_TMO])) break; if (_sp > XB_SPIN_CAP) { atomicAdd(&(bar)[XB_TMO], 1u); break; } } } } while (0)
struct XcdBarrier { unsigned* bar; unsigned x; volatile LAS unsigned* st; };
__device__ __forceinline__ XcdBarrier xcd_barrier_post(unsigned* bar, volatile LAS unsigned* st) {
    XcdBarrier b; b.bar = bar; b.x = xb_xcc_id(); b.st = st;
    if (threadIdx.x == 0) (void)xb_add(&bar[XB_XCNT(b.x)], 1u);
    return b;
}
__device__ __forceinline__ void xcd_barrier_complete(unsigned* bar, unsigned x, unsigned& nloc, unsigned& nx) {
    const unsigned G = gridDim.x * gridDim.y * gridDim.z;
    unsigned sum, cnt, mine, sp = 0u;
    for (;;) {
        sum = 0u; cnt = 0u; mine = 0u;
#pragma unroll
        for (unsigned j = 0; j < 16; ++j) { const unsigned c = xb_ld(&bar[XB_XCNT(j)]); sum += c; cnt += (c > 0u) ? 1u : 0u; mine = (j == x) ? c : mine; }
        if (sum == G) break;
        __builtin_amdgcn_s_sleep(1);
        if ((++sp & 255u) == 0u) { if (xb_ld(&bar[XB_TMO])) break; if (sp > XB_SPIN_CAP) { atomicAdd(&bar[XB_TMO], 1u); break; } }
    }
    nloc = mine > 0u ? mine : 1u; nx = cnt > 0u ? cnt : 1u;
}
__device__ __forceinline__ void xcd_barrier(const XcdBarrier& b) {
    asm volatile("s_waitcnt vmcnt(0)" ::: "memory");
    __syncthreads();
    if (threadIdx.x == 0) {
        unsigned* bar = b.bar;
        __builtin_amdgcn_s_waitcnt(0);
        unsigned nloc = b.st[0], nx = b.st[1];
        if (nloc == 0u) { xcd_barrier_complete(bar, b.x, nloc, nx); b.st[0] = nloc; b.st[1] = nx; }
        const unsigned old = xb_add(&bar[XB_XSUB(b.x)], 1u);
        const unsigned gen = old / nloc;
        if (old + 1u == (gen + 1u) * nloc) {
            __builtin_amdgcn_fence(__ATOMIC_RELEASE, "agent");
            asm volatile("s_waitcnt vmcnt(0)" ::: "memory");
            const unsigned og = xb_add(&bar[XB_TOP], 1u);
            const unsigned tg = og / nx;
            if (og + 1u == (tg + 1u) * nx) xb_add(&bar[XB_TOPGEN], 1u);
            else XB_SPIN(xb_ld(&bar[XB_TOPGEN]) == tg, bar);
            __builtin_amdgcn_fence(__ATOMIC_ACQUIRE, "agent");
            xb_add(&bar[XB_XGEN(b.x)], 1u);
            asm volatile("s_waitcnt vmcnt(0)" ::: "memory");
        } else {
            XB_SPIN(xb_ld(&bar[XB_XGEN(b.x)]) == gen, bar);
            __builtin_amdgcn_fence(__ATOMIC_ACQUIRE, "agent");
            asm volatile("s_waitcnt vmcnt(0)" ::: "memory");
        }
    }
    __syncthreads();
}

__global__ void __launch_bounds__(512, 2) fwd_kernel(Params P) {
    extern __shared__ __attribute__((aligned(16))) unsigned char lds_raw[];
    Frame F;
    F.lds = (LAS unsigned char*)lds_raw; F.ws = P.ws; F.out = P.out; F.P = &P;
    F.tid = threadIdx.x; F.lane = F.tid & 63; F.wave = __builtin_amdgcn_readfirstlane(F.tid >> 6); F.G = gridDim.x; F.bid = blockIdx.x; F.dry = 0; F.sub = 0xff;
    volatile LAS unsigned* MISC = (volatile LAS unsigned*)(F.lds + MISC_OFF);
    for (int u = F.tid; u < (LDS_BYTES - LDSCTL_OFF) / 4; u += 512) ((LAS unsigned*)(F.lds + LDSCTL_OFF))[u] = 0u;
    __syncthreads();
    const bool multi = (P.ph_hi - P.ph_lo) > 1;
    XcdBarrier bar; bar.bar = (unsigned*)(P.ws + WS_CTL) + CW_BAR; bar.x = 0; bar.st = nullptr;
    if (multi) bar = xcd_barrier_post((unsigned*)(P.ws + WS_CTL) + CW_BAR, MISC + 8);
#define RUN_PH(k) if (P.ph_lo <= (k) && (k) < P.ph_hi) { if ((k) == P.dup_ph) { F.dry = 1; F.sub = P.dup_sub; run_phase(F, (k)); xcd_barrier(bar); F.dry = 0; F.sub = 0xff; } run_phase(F, (k)); if ((k) + 1 < P.ph_hi) xcd_barrier(bar); }
    RUN_PH(0) RUN_PH(1) RUN_PH(2) RUN_PH(3) RUN_PH(4) RUN_PH(5) RUN_PH(6) RUN_PH(7) RUN_PH(8) RUN_PH(9)
#undef RUN_PH
}

#ifndef N_LAUNCH_MODE
#define N_LAUNCH_MODE 0
#endif
extern "C" void kernel_launch(void* const* d_in, const int* in_sizes, int n_in, void* d_out, int out_size, void* d_ws, size_t ws_size, hipStream_t stream) {
    static int grid = 0;
    if (grid == 0) {
        if (n_in != 29 || ws_size < WS_END) { fprintf(stderr, "kernel_launch: unexpected shapes (n_in %d out %d ws %zu need %zu)\n", n_in, out_size, ws_size, (size_t)WS_END); grid = -1; return; }
        int dev = 0, cus = 0;
        if (hipGetDevice(&dev) != hipSuccess || hipDeviceGetAttribute(&cus, hipDeviceAttributeMultiprocessorCount, dev) != hipSuccess) { grid = -1; return; }
        if (hipFuncSetAttribute((const void*)fwd_kernel, hipFuncAttributeMaxDynamicSharedMemorySize, LDS_BYTES) != hipSuccess) { fprintf(stderr, "kernel_launch: hipFuncSetAttribute failed\n"); grid = -1; return; }
        (void)hipGetLastError();
        grid = cus;
    }
    if (grid < 0) return;
    (void)hipMemsetAsync((char*)d_ws + WS_CTL, 0, CTL_BYTES, stream);
    Params P{};
    for (int i = 0; i < 29; ++i) P.in[i] = (const float*)d_in[i];
    P.out = (float*)d_out; P.ws = (unsigned char*)d_ws;
#ifndef DUP_PH
#define DUP_PH (-1)
#endif
#ifndef DUP_SUB
#define DUP_SUB 0xff
#endif
    P.dup_ph = DUP_PH; P.dup_sub = DUP_SUB;
#if N_LAUNCH_MODE == 0
    P.ph_lo = 0; P.ph_hi = N_PHASES;
    hipLaunchKernelGGL(fwd_kernel, dim3(grid), dim3(512), LDS_BYTES, stream, P);
#else
    for (int ph = 0; ph < N_PHASES; ++ph) { P.ph_lo = ph; P.ph_hi = ph + 1; hipLaunchKernelGGL(fwd_kernel, dim3(grid), dim3(512), LDS_BYTES, stream, P); }
#endif
}
#endif
```
